# Optimizing an MI355X kernel written in HIP

```python
import math
import jax, jax.numpy as jnp
from jax import lax
import numpy as np

D_MODEL = 2048
BATCH = 2
SEQ = 8192
DEPTH = 1

RET_HEADS = 8
RET_DK = 128
RET_DV = 256
RET_CHUNK = 128
POOL_WINDOWS = (2, 4, 8, 16)
POOL_GROUPS = len(POOL_WINDOWS)
POOL_DIM = 1024
POOL_GDIM = POOL_DIM // POOL_GROUPS
N_BRANCH = 2
PEER_HEADS = 8
PEER_NKEYS = 128
PEER_N_EXPERTS = PEER_NKEYS * PEER_NKEYS
PEER_DKEY = 256
PEER_DHALF = PEER_DKEY // 2
PEER_TOPK = 16
PEER_BLOCK = 128

ROPE_BASE = 10000.0
EPS = 1e-6

Q_DIM = RET_HEADS * RET_DK
V_DIM = RET_HEADS * RET_DV
SPLITS = (Q_DIM, Q_DIM, V_DIM, V_DIM, POOL_DIM, N_BRANCH * D_MODEL)
IN_COLS = sum(SPLITS)

kernel_name = "hybrid_retention_pool_peer_block"


def rmsnorm(x, w):
    xf = x.astype(jnp.float32)
    y = xf * lax.rsqrt(jnp.mean(xf * xf, axis=-1, keepdims=True) + EPS)
    return (y * w.astype(jnp.float32)).astype(x.dtype)


def rotary(x):
    S, d = x.shape[1], x.shape[-1]
    half = d // 2
    inv_freq = ROPE_BASE ** (-jnp.arange(half, dtype=jnp.float32) / half)
    ang = jnp.arange(S, dtype=jnp.float32)[:, None] * inv_freq[None, :]
    cos = jnp.cos(ang)[None, :, None, :]
    sin = jnp.sin(ang)[None, :, None, :]
    xf = x.astype(jnp.float32)
    x1, x2 = xf[..., :half], xf[..., half:]
    out = jnp.concatenate([x1 * cos - x2 * sin, x1 * sin + x2 * cos], axis=-1)
    return out.astype(x.dtype)


def retention_chunkwise(q, k, v):
    B, S, H, dk = q.shape
    dv = v.shape[-1]
    C = RET_CHUNK
    N = S // C
    log_g = jnp.log(1.0 - 2.0 ** (-5.0 - jnp.arange(H, dtype=jnp.float32)))
    i = jnp.arange(C, dtype=jnp.float32)
    diff = i[:, None] - i[None, :]
    dmask = jnp.where(diff[None] >= 0,
                      jnp.exp(log_g[:, None, None] * jnp.maximum(diff, 0.0)[None]), 0.0)
    xi = jnp.exp(log_g[None, :] * (i[:, None] + 1.0))
    zeta = jnp.exp(log_g[None, :] * (C - 1.0 - i)[:, None])
    g_chunk = jnp.exp(log_g * C)

    qc = q.reshape(B, N, C, H, dk).astype(jnp.float32)
    kc = k.reshape(B, N, C, H, dk).astype(jnp.float32)
    vc = v.reshape(B, N, C, H, dv).astype(jnp.float32)

    scores = jnp.einsum('bnihd,bnjhd->bnhij', qc, kc) * dmask[None, None]
    inner = jnp.einsum('bnhij,bnjhe->bnihe', scores, vc)

    qx = jnp.moveaxis(qc * xi[None, None, :, :, None], 1, 0)
    kz = jnp.moveaxis(kc * zeta[None, None, :, :, None], 1, 0)
    vn = jnp.moveaxis(vc, 1, 0)

    def step(R, inp):
        qi, ki, vi = inp
        cross = jnp.einsum('bihd,bhde->bihe', qi, R)
        R = g_chunk[None, :, None, None] * R + jnp.einsum('bjhd,bjhe->bhde', ki, vi)
        return R, cross

    R0 = jnp.zeros((B, H, dk, dv), jnp.float32)
    _, cross = lax.scan(step, R0, (qx, kz, vn))
    out = inner + jnp.moveaxis(cross, 0, 1)
    return out.reshape(B, S, H, dv)


def head_groupnorm(y):
    mu = jnp.mean(y, axis=-1, keepdims=True)
    var = jnp.mean((y - mu) ** 2, axis=-1, keepdims=True)
    return (y - mu) * lax.rsqrt(var + EPS)


def multiscale_pool(p):
    B, S, _ = p.shape
    pf = p.astype(jnp.float32)
    cs = jnp.cumsum(pf, axis=1)
    pos = jnp.arange(S, dtype=jnp.int32)
    outs = []
    for g, w in enumerate(POOL_WINDOWS):
        sl = slice(g * POOL_GDIM, (g + 1) * POOL_GDIM)
        csg = cs[..., sl]
        shifted = jnp.pad(csg, ((0, 0), (w, 0), (0, 0)))[:, :S]
        count = jnp.minimum(pos + 1, w).astype(jnp.float32)
        mean = (csg - shifted) / count[None, :, None]
        outs.append(mean - pf[..., sl])
    return jnp.stack(outs, axis=2).astype(p.dtype)


def peer_ffn(h, w_q, sub_keys, u, v):
    B, S, D = h.shape
    T = B * S
    xs = h.reshape(T // PEER_BLOCK, PEER_BLOCK, D)

    def block(xb):
        q = (xb @ w_q).reshape(PEER_BLOCK, PEER_HEADS, 2, PEER_DHALF)
        s = jnp.einsum('thpd,pkd->thpk', q, sub_keys).astype(jnp.float32)
        sv, si = lax.top_k(s, PEER_TOPK)
        cand = (sv[:, :, 0, :, None] + sv[:, :, 1, None, :]).reshape(PEER_BLOCK, PEER_HEADS, -1)
        cidx = (si[:, :, 0, :, None] * PEER_NKEYS + si[:, :, 1, None, :]).reshape(PEER_BLOCK, PEER_HEADS, -1)
        best, pos = lax.top_k(cand, PEER_TOPK)
        eidx = jnp.take_along_axis(cidx, pos, axis=-1)
        gate = jax.nn.softmax(best, axis=-1)
        u_sel = u[eidx]
        v_sel = v[eidx]
        a = jnp.einsum('thkd,td->thk', u_sel, xb).astype(jnp.float32)
        wgt = (jax.nn.gelu(a, approximate=False) * gate).astype(xb.dtype)
        return jnp.einsum('thk,thkd->td', wgt, v_sel)

    y = lax.map(block, xs)
    return y.reshape(B, S, D)


def setup_inputs(seed: int = 0) -> dict:
    key = jax.random.key(seed)
    ks = jax.random.split(key, 16)
    f32 = jnp.float32
    nrm = lambda k, shape, scale: jax.random.normal(k, shape, f32) * scale
    return {
        "x": nrm(ks[0], (BATCH, SEQ, D_MODEL), 1.0),
        "norm1_w": 1.0 + nrm(ks[1], (DEPTH, D_MODEL), 0.02),
        "w_in": nrm(ks[2], (DEPTH, D_MODEL, IN_COLS), D_MODEL ** -0.5),
        "w_ret_o": nrm(ks[3], (DEPTH, V_DIM, D_MODEL), V_DIM ** -0.5),
        "w_pool_lin": nrm(ks[4], (DEPTH, POOL_GROUPS, POOL_GDIM, POOL_GDIM), POOL_GDIM ** -0.5),
        "pool_scale": 1.0 + nrm(ks[5], (DEPTH, POOL_DIM), 0.1),
        "w_pool_o": nrm(ks[6], (DEPTH, POOL_DIM, D_MODEL), POOL_DIM ** -0.5),
        "w_out": nrm(ks[7], (DEPTH, D_MODEL, D_MODEL), D_MODEL ** -0.5),
        "norm2_w": 1.0 + nrm(ks[8], (DEPTH, D_MODEL), 0.02),
        "peer_w_q": nrm(ks[9], (DEPTH, D_MODEL, PEER_HEADS * PEER_DKEY), D_MODEL ** -0.5),
        "peer_sub_keys": nrm(ks[10], (DEPTH, 2, PEER_NKEYS, PEER_DHALF), PEER_DHALF ** -0.5),
        "peer_u": nrm(ks[11], (DEPTH, PEER_N_EXPERTS, D_MODEL), D_MODEL ** -0.5),
        "peer_v": nrm(ks[12], (DEPTH, PEER_N_EXPERTS, D_MODEL), 0.5),
        "final_norm_w": 1.0 + nrm(ks[13], (D_MODEL,), 0.02),
    }


def reference(x, norm1_w, w_in, w_ret_o, w_pool_lin, pool_scale, w_pool_o, w_out,
              norm2_w, peer_w_q, peer_sub_keys, peer_u, peer_v, final_norm_w):
    B, S, D = x.shape
    offsets = np.cumsum(SPLITS)[:-1].tolist()
    for l in range(DEPTH):
        h = rmsnorm(x, norm1_w[l])
        proj = h @ w_in[l]
        q, k, vr, gr, pin, gates = jnp.split(proj, offsets, axis=-1)
        q = rotary(q.reshape(B, S, RET_HEADS, RET_DK))
        k = rotary(k.reshape(B, S, RET_HEADS, RET_DK)) * (RET_DK ** -0.5)
        vr = vr.reshape(B, S, RET_HEADS, RET_DV)
        ret = head_groupnorm(retention_chunkwise(q, k, vr)).reshape(B, S, V_DIM)
        ret = (jax.nn.silu(gr.astype(jnp.float32)) * ret).astype(x.dtype)
        y_ret = ret @ w_ret_o[l]

        pooled = multiscale_pool(pin)
        pooled = jnp.einsum('bsgc,gcd->bsgd', pooled, w_pool_lin[l]).reshape(B, S, POOL_DIM)
        y_pool = (pooled * pool_scale[l]) @ w_pool_o[l]

        g_ret, g_pool = jnp.split(jax.nn.sigmoid(gates.astype(jnp.float32)), 2, axis=-1)
        mixed = (g_ret * y_ret + g_pool * y_pool).astype(x.dtype)
        x = x + mixed @ w_out[l]
        h2 = rmsnorm(x, norm2_w[l])
        x = x + peer_ffn(h2, peer_w_q[l], peer_sub_keys[l], peer_u[l], peer_v[l])
    return rmsnorm(x, final_norm_w)
```

```cpp
#include <hip/hip_runtime.h>
#define P8_X1_BF16 1
#define GATES_SC1 1
#include <cstdio>
#include <cstdint>
namespace pg8 {
#define PG8_LAS __attribute__((address_space(3)))
typedef unsigned short bf16_t;
typedef short bf16x8 __attribute__((ext_vector_type(8)));
typedef float f32x4 __attribute__((ext_vector_type(4)));
typedef unsigned u32x4 __attribute__((ext_vector_type(4)));
constexpr int BM = 256, BK = 64, HALF = 128, HTB = HALF * BK * 2  , STAGE_BYTES = 8 * HTB, NXCD = 8, WGM = 8;

__host__ __device__ __forceinline__ int lds_byte(int r, int c) { const int st = (r >> 4) * 2 + (c >> 5), rr = r & 15, cc = c & 31, ob = rr * 64 + cc * 2; return st * 1024 + (ob ^ (((ob >> 9) & 1) << 5)); }
__host__ __device__ __forceinline__ void stage_rc(int b, int& R, int& C) { const int st = b / 1024, sb = b % 1024, swz = sb ^ (((sb >> 9) & 1) << 5); R = (st >> 1) * 16 + swz / 64; C = (st & 1) * 32 + (swz % 64) / 2; }
__host__ __device__ __forceinline__ int perm32(int rho) { const int n = rho >> 4, i = rho & 15; return 8 * (i >> 2) + 4 * n + (i & 3); }

struct Unit { int pm, pn; };
struct Gemm { const bf16_t* A; const bf16_t* Bt; int M, N, K; };

struct StaticOrder {
    int nM, nN, nwg, G, c;
    __host__ __device__ void init(int M, int N, int G_, int c_) { nM = M / BM; nN = N / BM; nwg = nM * nN; G = G_; c = c_; }
    __host__ __device__ bool next(int i, Unit& u) const {
        const long L = (long)i * G + c; if (L >= nwg) return false;
        int wgid = (int)L; { const int q = nwg / NXCD, r = nwg % NXCD, xcd = wgid % NXCD, off = wgid / NXCD; wgid = (xcd < r ? xcd * (q + 1) : r * (q + 1) + (xcd - r) * q) + off; }
        const int nig = WGM * nN, gid = wgid / nig, fm = gid * WGM, gsz = (nM - fm) < WGM ? (nM - fm) : WGM;
        u.pm = fm + ((wgid % nig) % gsz); u.pn = (wgid % nig) / gsz; return true;
    }
    __device__ __forceinline__ void a_ready(const Unit&) const {}
    __device__ __forceinline__ void done(const Unit&) const {}
};
struct DiagOrder {
    int G, c;
    __device__ void init(int G_, int c_) { G = G_; c = c_; }
    __device__ bool next(int i, Unit& u) const { const int L = i * G + c; if (L >= 256) return false; u.pm = L; u.pn = L >> 6; return true; }
    __device__ __forceinline__ void a_ready(const Unit&) const {}
    __device__ __forceinline__ void done(const Unit&) const {}
};

__device__ __forceinline__ unsigned cvt_pk_bf16(float lo, float hi) { unsigned r; asm volatile("v_cvt_pk_bf16_f32 %0, %1, %2" : "=v"(r) : "v"(lo), "v"(hi)); return r; }
__device__ __forceinline__ u32x4 pack8(const f32x4 v0, const f32x4 v1) { u32x4 w; w.x = cvt_pk_bf16(v0[0], v0[1]); w.y = cvt_pk_bf16(v0[2], v0[3]); w.z = cvt_pk_bf16(v1[0], v1[1]); w.w = cvt_pk_bf16(v1[2], v1[3]); return w; }
__device__ __forceinline__ float bf_lo(unsigned u) { return __builtin_bit_cast(float, u << 16); }
__device__ __forceinline__ float bf_hi(unsigned u) { return __builtin_bit_cast(float, u & 0xffff0000u); }
__device__ __forceinline__ void unpack8(const u32x4 w, f32x4& v0, f32x4& v1) { v0 = (f32x4){bf_lo(w.x), bf_hi(w.x), bf_lo(w.y), bf_hi(w.y)}; v1 = (f32x4){bf_lo(w.z), bf_hi(w.z), bf_lo(w.w), bf_hi(w.w)}; }
__device__ __forceinline__ float fast_sigmoid(float v) { return __builtin_amdgcn_rcpf(1.0f + __builtin_amdgcn_exp2f(-1.4426950408889634f * v)); }
__device__ __forceinline__ float log2_gamma(int h) { const float x = __builtin_amdgcn_exp2f((float)(-5 - h)); return -1.4426950408889634f * x * (1.f + x * (0.5f + x * (0.33333333f + x * (0.25f + x * 0.2f)))); }
constexpr float ROPE_C = 0.20762050593046014f;
constexpr float INV_2PI = 0.15915494309189535f;
constexpr float DK_SCALE = 0.08838834764831845f;

struct EpiMain {
    static constexpr bool PERM = true, AFTER_DRAIN = false;
    bf16_t *q, *k, *gr, *pin;
    __device__ __forceinline__ void operator()(const f32x4 (&acc)[2][2][4][2], const Unit& u, int wr, int wc, int fr, int fq) const {
        const int row0 = u.pm * BM + wr * 64 + fr, cl = wc * 32 + 8 * fq;
        if (u.pn < 8) {
            const bool isk = u.pn >= 4; bf16_t* base = isk ? k : q; const float sc = isk ? DK_SCALE : 1.0f; const int pnl = u.pn & 3;
            float invf[4];
#pragma unroll
            for (int p = 0; p < 4; ++p) invf[p] = __builtin_amdgcn_exp2f(-(float)(16 * wc + 4 * fq + p) * ROPE_C) * INV_2PI;
#pragma unroll
            for (int ai = 0; ai < 2; ++ai)
#pragma unroll
                for (int m = 0; m < 4; ++m) {
                    const int row = row0 + ai * HALF + m * 16, s = row & 8191, b = row >> 13;
                    float cs[4], sn[4];
#pragma unroll
                    for (int p = 0; p < 4; ++p) { const float r = __builtin_amdgcn_fractf((float)s * invf[p]); cs[p] = __builtin_amdgcn_cosf(r) * sc; sn[p] = __builtin_amdgcn_sinf(r) * sc; }
#pragma unroll
                    for (int bj = 0; bj < 2; ++bj) {
                        const int hh = 2 * pnl + bj; const f32x4 v0 = acc[ai][bj][m][0], v1 = acc[ai][bj][m][1];
                        f32x4 o0, o1;
                        o0[0] = v0[0] * cs[0] - v0[1] * sn[0]; o0[1] = v0[0] * sn[0] + v0[1] * cs[0];
                        o0[2] = v0[2] * cs[1] - v0[3] * sn[1]; o0[3] = v0[2] * sn[1] + v0[3] * cs[1];
                        o1[0] = v1[0] * cs[2] - v1[1] * sn[2]; o1[1] = v1[0] * sn[2] + v1[1] * cs[2];
                        o1[2] = v1[2] * cs[3] - v1[3] * sn[3]; o1[3] = v1[2] * sn[3] + v1[3] * cs[3];
                        *(u32x4*)(base + ((size_t)((b * 8 + hh) * 8192 + s)) * 128 + cl) = pack8(o0, o1);
                    }
                }
        } else if (u.pn < 16) {
            const int c0 = (u.pn - 8) * BM + cl;
#pragma unroll
            for (int ai = 0; ai < 2; ++ai)
#pragma unroll
                for (int m = 0; m < 4; ++m) { bf16_t* rowp = gr + (size_t)(row0 + ai * HALF + m * 16) * 2048 + c0;
#pragma unroll
                    for (int bj = 0; bj < 2; ++bj) { f32x4 v0 = acc[ai][bj][m][0], v1 = acc[ai][bj][m][1];
#pragma unroll
                        for (int j = 0; j < 4; ++j) { v0[j] = v0[j] * fast_sigmoid(v0[j]); v1[j] = v1[j] * fast_sigmoid(v1[j]); }
                        *(u32x4*)(rowp + bj * HALF) = pack8(v0, v1); } }
        } else {
            const int c0 = (u.pn - 16) * BM + cl;
#pragma unroll
            for (int ai = 0; ai < 2; ++ai)
#pragma unroll
                for (int m = 0; m < 4; ++m) { bf16_t* rowp = pin + (size_t)(row0 + ai * HALF + m * 16) * 1024 + c0;
#pragma unroll
                    for (int bj = 0; bj < 2; ++bj) *(u32x4*)(rowp + bj * HALF) = pack8(acc[ai][bj][m][0], acc[ai][bj][m][1]); }
        }
    }
};
struct EpiGates {
    static constexpr bool PERM = true, AFTER_DRAIN = false;
    bf16_t* gates;
    __device__ __forceinline__ void operator()(const f32x4 (&acc)[2][2][4][2], const Unit& u, int wr, int wc, int fr, int fq) const {
        const int row0 = u.pm * BM + wr * 64 + fr, c0 = u.pn * BM + wc * 32 + 8 * fq;
#pragma unroll
        for (int ai_ = 0; ai_ < 2; ++ai_)
#pragma unroll
            for (int m_ = 0; m_ < 4; ++m_) {
#ifdef GATES_REV
                const int ai = 1 - ai_, m = 3 - m_;
#else
                const int ai = ai_, m = m_;
#endif
                bf16_t* rowp = gates + (size_t)(row0 + ai * HALF + m * 16) * 4096 + c0;
#pragma unroll
                for (int bj = 0; bj < 2; ++bj) { f32x4 v0 = acc[ai][bj][m][0], v1 = acc[ai][bj][m][1];
#pragma unroll
                    for (int j = 0; j < 4; ++j) { v0[j] = fast_sigmoid(v0[j]); v1[j] = fast_sigmoid(v1[j]); }
#ifdef GATES_SC1
                    { const u32x4 w = pack8(v0, v1); unsigned long long* p8 = (unsigned long long*)(rowp + bj * HALF);
                      __hip_atomic_store(p8, (unsigned long long)w.x | ((unsigned long long)w.y << 32), __ATOMIC_RELAXED, __HIP_MEMORY_SCOPE_AGENT);
                      __hip_atomic_store(p8 + 1, (unsigned long long)w.z | ((unsigned long long)w.w << 32), __ATOMIC_RELAXED, __HIP_MEMORY_SCOPE_AGENT); }
#else
                    *(u32x4*)(rowp + bj * HALF) = pack8(v0, v1);
#endif
                } }
    }
};

struct EpiKV {
    static constexpr bool PERM = true, AFTER_DRAIN = false;
    bf16_t *kzT, *vT;
    __device__ __forceinline__ void operator()(const f32x4 (&acc)[2][2][4][2], const Unit& u, int wr, int wc, int fr, int fq) const {
        const int b = u.pn >> 5, sl = wc * 32 + 8 * fq;
        const int sbase = (u.pn & 31) * BM;
        if (u.pm < 4) {
#pragma unroll
            for (int ai = 0; ai < 2; ++ai) {
                const int hh = 2 * u.pm + ai; const float lg = log2_gamma(hh);
#pragma unroll
                for (int m01 = 0; m01 < 2; ++m01) {
                    const int i = 32 * wr + 16 * m01 + fr; const float invf = __builtin_amdgcn_exp2f(-(float)i * ROPE_C) * INV_2PI;
                    bf16_t* r1 = kzT + ((size_t)((b * 8 + hh) * 128 + 2 * i)) * 8192 + sbase + sl;
#pragma unroll
                    for (int bj = 0; bj < 2; ++bj) {
                        f32x4 o1[2], o2[2];
#pragma unroll
                        for (int n = 0; n < 2; ++n)
#pragma unroll
                            for (int j = 0; j < 4; ++j) {
                                const int s = sbase + bj * HALF + sl + 4 * n + j;
                                const float r = __builtin_amdgcn_fractf((float)s * invf), zz = DK_SCALE * __builtin_amdgcn_exp2f((float)(127 - (s & 127)) * lg);
                                const float cs = __builtin_amdgcn_cosf(r) * zz, sn = __builtin_amdgcn_sinf(r) * zz;
                                const float a = acc[ai][bj][m01][n][j], bb = acc[ai][bj][m01 + 2][n][j];
                                o1[n][j] = a * cs - bb * sn; o2[n][j] = a * sn + bb * cs;
                            }
                        *(u32x4*)(r1 + bj * HALF) = pack8(o1[0], o1[1]);
                        *(u32x4*)(r1 + 8192 + bj * HALF) = pack8(o2[0], o2[1]);
                    }
                }
            }
        } else {
#pragma unroll
            for (int ai = 0; ai < 2; ++ai)
#pragma unroll
                for (int m = 0; m < 4; ++m) {
                    const int R = (u.pm - 4) * BM + ai * HALF + wr * 64 + m * 16 + fr;
                    bf16_t* rowp = vT + ((size_t)(b * 2048 + R)) * 8192 + sbase + sl;
#pragma unroll
                    for (int bj = 0; bj < 2; ++bj) *(u32x4*)(rowp + bj * HALF) = pack8(acc[ai][bj][m][0], acc[ai][bj][m][1]);
                }
        }
    }
};

struct EpiPool {
    static constexpr bool PERM = true, AFTER_DRAIN = false;
    bf16_t* out; const float* scale;
    __device__ __forceinline__ void operator()(const f32x4 (&acc)[2][2][4][2], const Unit& u, int wr, int wc, int fr, int fq) const {
        const int g = u.pm >> 6, tok0 = (u.pm & 63) * BM + wr * 64 + fr, c0 = g * 256 + wc * 32 + 8 * fq;
        f32x4 sv[2][2];
#pragma unroll
        for (int bj = 0; bj < 2; ++bj)
#pragma unroll
            for (int n = 0; n < 2; ++n) sv[bj][n] = *(const f32x4*)(scale + c0 + bj * HALF + 4 * n);
#pragma unroll
        for (int ai = 0; ai < 2; ++ai)
#pragma unroll
            for (int m = 0; m < 4; ++m) { bf16_t* rowp = out + (size_t)(tok0 + ai * HALF + m * 16) * 1024 + c0;
#pragma unroll
                for (int bj = 0; bj < 2; ++bj) *(u32x4*)(rowp + bj * HALF) = pack8(acc[ai][bj][m][0] * sv[bj][0], acc[ai][bj][m][1] * sv[bj][1]); }
    }
};

template <int PASS> struct EpiMix {
    static constexpr bool PERM = true, AFTER_DRAIN = false;
    bf16_t* mixed; const bf16_t* gates;
    __device__ __forceinline__ void operator()(const f32x4 (&acc)[2][2][4][2], const Unit& u, int wr, int wc, int fr, int fq) const {
        const int row0 = u.pm * BM + wr * 64 + fr, c0 = u.pn * BM + wc * 32 + 8 * fq;
#pragma unroll
        for (int ai = 0; ai < 2; ++ai)
#pragma unroll
            for (int m = 0; m < 4; ++m) { const size_t row = (size_t)(row0 + ai * HALF + m * 16);
#pragma unroll
                for (int bj = 0; bj < 2; ++bj) {
                    f32x4 g0, g1; unpack8(*(const u32x4*)(gates + row * 4096 + PASS * 2048 + c0 + bj * HALF), g0, g1);
                    f32x4 v0 = acc[ai][bj][m][0] * g0, v1 = acc[ai][bj][m][1] * g1;
                    bf16_t* p = mixed + row * 2048 + c0 + bj * HALF;
                    if (PASS == 1) { f32x4 t0, t1; unpack8(*(const u32x4*)p, t0, t1); v0 += t0; v1 += t1; }
                    *(u32x4*)p = pack8(v0, v1); } }
    }
};

struct EpiOut {
    static constexpr bool PERM = true, AFTER_DRAIN = false;
    const float* x; float* x1; bf16_t* x1b; float* sumsq;
    __device__ __forceinline__ void operator()(const f32x4 (&acc)[2][2][4][2], const Unit& u, int wr, int wc, int fr, int fq) const {
        const int row0 = u.pm * BM + wr * 64 + fr, c0 = u.pn * BM + wc * 32 + 8 * fq;
#pragma unroll
        for (int ai = 0; ai < 2; ++ai)
#pragma unroll
            for (int m = 0; m < 4; ++m) { const size_t row = (size_t)(row0 + ai * HALF + m * 16); float ss = 0.f;
#pragma unroll
                for (int bj = 0; bj < 2; ++bj) {
                    const size_t off = row * 2048 + c0 + bj * HALF;
                    const f32x4 v0 = acc[ai][bj][m][0] + *(const f32x4*)(x + off), v1 = acc[ai][bj][m][1] + *(const f32x4*)(x + off + 4);
                    *(f32x4*)(x1 + off) = v0; *(f32x4*)(x1 + off + 4) = v1; *(u32x4*)(x1b + off) = pack8(v0, v1);
                    ss += (v0[0] * v0[0] + v0[1] * v0[1]) + (v0[2] * v0[2] + v0[3] * v0[3]) + (v1[0] * v1[0] + v1[1] * v1[1]) + (v1[2] * v1[2] + v1[3] * v1[3]); }
                ss += __shfl_xor(ss, 16); ss += __shfl_xor(ss, 32);
                if (fq == 0) sumsq[row * 32 + u.pn * 4 + wc] = ss; }
    }
};

struct EpiQ {
    static constexpr bool PERM = true, AFTER_DRAIN = false;
    bf16_t* qp; const float* sumsq;
    __device__ __forceinline__ void operator()(const f32x4 (&acc)[2][2][4][2], const Unit& u, int wr, int wc, int fr, int fq) const {
        const int row0 = u.pm * BM + wr * 64 + fr, c0 = u.pn * BM + wc * 32 + 8 * fq;
#pragma unroll
        for (int ai = 0; ai < 2; ++ai)
#pragma unroll
            for (int m = 0; m < 4; ++m) { const size_t row = (size_t)(row0 + ai * HALF + m * 16);
                const f32x4 p0 = *(const f32x4*)(sumsq + row * 32 + fq * 8), p1 = *(const f32x4*)(sumsq + row * 32 + fq * 8 + 4);
                float st = ((p0[0] + p0[1]) + (p0[2] + p0[3])) + ((p1[0] + p1[1]) + (p1[2] + p1[3]));
                st += __shfl_xor(st, 16); st += __shfl_xor(st, 32);
                const float rs = __builtin_amdgcn_rsqf(st * (1.0f / 2048.0f) + 1e-6f);
#pragma unroll
                for (int bj = 0; bj < 2; ++bj) *(u32x4*)(qp + row * 2048 + c0 + bj * HALF) = pack8(acc[ai][bj][m][0] * rs, acc[ai][bj][m][1] * rs); }
    }
};

template <class Epi, class Sched, bool ALIGN_EPI = false, bool SP2 = false>
__device__ __forceinline__ void gemm_phase(PG8_LAS unsigned char* lds, const Gemm g, const Sched& S, const Epi& E) {
    const int tid = threadIdx.x, wid = __builtin_amdgcn_readfirstlane(tid >> 6), lane = tid & 63, wr = wid >> 2, wc = wid & 3, fr = lane & 15, fq = lane >> 4;
    int K_ = g.K; asm volatile("" : "+s"(K_));
    const int K = K_, nt = K / BK;
    unsigned voffA[2], voffB[2];
#pragma unroll
    for (int i = 0; i < 2; ++i) { int R, C; stage_rc(tid * 16 + i * 8192, R, C); const int Rb = Epi::PERM ? ((R & ~31) + perm32(R & 31)) : R;
        voffA[i] = (unsigned)(R * K + C) * 2u; voffB[i] = (unsigned)(Rb * K + C) * 2u; }
    const size_t kstep = (size_t)(BK * 2);
    const size_t hstep = (size_t)HALF * K * 2;
    const size_t tstep = 2 * hstep;
    const unsigned ldsw = (unsigned)wid * 1024u;
    const int aoff = lds_byte(wr * 64 + fr, fq * 8), boff = lds_byte(wc * 32 + fr, fq * 8);
#define PG8_SA(b, h) (((b) * 2 + (h)) * HTB)
#define PG8_SB(b, h) ((4 + (b) * 2 + (h)) * HTB)
#define PG8_STAGE(bufoff, gbase, voff) do { _Pragma("unroll") for (int _i = 0; _i < 2; ++_i) \
        __builtin_amdgcn_global_load_lds((const unsigned*)((const char*)(gbase) + (voff)[_i]), (PG8_LAS unsigned*)(lds + (bufoff) + ldsw + _i * 8192), 16, 0, 0); } while (0)
#define PG8_LDA(dst, b, h) do { _Pragma("unroll") for (int m = 0; m < 4; ++m) _Pragma("unroll") for (int k = 0; k < 2; ++k) dst[m][k] = *(const PG8_LAS bf16x8*)(lds + PG8_SA(b, h) + aoff + m * 2048 + k * 1024); } while (0)
#define PG8_LDB(dst, b, h) do { _Pragma("unroll") for (int n = 0; n < 2; ++n) _Pragma("unroll") for (int k = 0; k < 2; ++k) dst[n][k] = *(const PG8_LAS bf16x8*)(lds + PG8_SB(b, h) + boff + n * 2048 + k * 1024); } while (0)
#define PG8_MMA(ai, bj, At, Bt) do { __builtin_amdgcn_s_setprio(1); _Pragma("unroll") for (int m = 0; m < 4; ++m) _Pragma("unroll") for (int n = 0; n < 2; ++n) _Pragma("unroll") for (int k = 0; k < 2; ++k) \
        acc[ai][bj][m][n] = __builtin_amdgcn_mfma_f32_16x16x32_bf16(Bt[n][k], At[m][k], acc[ai][bj][m][n], 0, 0, 0); __builtin_amdgcn_s_setprio(0); } while (0)
#define PG8_WAIT_V(n) asm volatile("s_waitcnt vmcnt(" #n ")" ::: "memory")
#define PG8_WAIT_L(n) asm volatile("s_waitcnt lgkmcnt(" #n ")" ::: "memory")
#define PG8_BAR __builtin_amdgcn_s_barrier()
#define PG8_SCHED __builtin_amdgcn_sched_barrier(0)
#ifdef EPI_DRAIN
#define PG8_EPI_DRAIN PG8_WAIT_V(0)
#else
#define PG8_EPI_DRAIN do {} while (0)
#endif
    Unit cur, nxt; int ui = 0;
    if (!S.next(0, cur)) return;
    f32x4 acc[2][2][4][2];
#pragma unroll
    for (int a = 0; a < 2; ++a)
#pragma unroll
        for (int b = 0; b < 2; ++b)
#pragma unroll
            for (int m = 0; m < 4; ++m)
#pragma unroll
                for (int n = 0; n < 2; ++n) acc[a][b][m][n] = (f32x4){0.f, 0.f, 0.f, 0.f};
    bf16x8 At[4][2], B0[2][2], B1[2][2];
    const char* cA = (const char*)g.A + (size_t)cur.pm * tstep; const char* cB = (const char*)g.Bt + (size_t)cur.pn * tstep;
    S.a_ready(cur);
    if constexpr (SP2) {
        PG8_STAGE(PG8_SB(0, 0), cB, voffB); PG8_STAGE(PG8_SB(0, 1), cB + hstep, voffB); PG8_STAGE(PG8_SA(0, 0), cA, voffA); PG8_STAGE(PG8_SA(0, 1), cA + hstep, voffA);
        if (wr == 1) PG8_BAR;
        PG8_WAIT_V(2); PG8_BAR;
        PG8_STAGE(PG8_SB(1, 0), cB + kstep, voffB); PG8_STAGE(PG8_SA(1, 0), cA + kstep, voffA); PG8_STAGE(PG8_SB(1, 1), cB + hstep + kstep, voffB);
        PG8_WAIT_V(6); PG8_BAR;
    } else {
        PG8_STAGE(PG8_SB(0, 0), cB, voffB); PG8_STAGE(PG8_SA(0, 0), cA, voffA); PG8_STAGE(PG8_SB(0, 1), cB + hstep, voffB); PG8_STAGE(PG8_SA(0, 1), cA + hstep, voffA);
        if (wr == 1) PG8_BAR;
        PG8_WAIT_V(4); PG8_BAR;
        PG8_STAGE(PG8_SB(1, 0), cB + kstep, voffB); PG8_STAGE(PG8_SA(1, 0), cA + kstep, voffA); PG8_STAGE(PG8_SB(1, 1), cB + hstep + kstep, voffB);
        PG8_WAIT_V(6); PG8_BAR;
    }
    for (;;) {
        const bool has_next = S.next(ui + 1, nxt);
        const char* nA = has_next ? (const char*)g.A + (size_t)nxt.pm * tstep : cA; const char* nB = has_next ? (const char*)g.Bt + (size_t)nxt.pn * tstep : cB;
        for (int t = 0; t < nt; t += 2) {
            const bool last = (t == nt - 2);
            const char* a1 = cA + (size_t)(t + 1) * kstep;
            const char* a2 = last ? nA : cA + (size_t)(t + 2) * kstep; const char* b2 = last ? nB : cB + (size_t)(t + 2) * kstep;
            const char* a3 = a2 + kstep; const char* b3 = b2 + kstep;
            if (last && has_next) S.a_ready(nxt);
            if constexpr (SP2) {
            PG8_LDB(B0, 0, 0); PG8_LDB(B1, 0, 1); PG8_SCHED; PG8_LDA(At, 0, 0); PG8_STAGE(PG8_SA(1, 1), a1 + hstep, voffA);
            PG8_WAIT_V(8); PG8_WAIT_L(0); PG8_BAR; PG8_MMA(0, 0, At, B0); PG8_MMA(0, 1, At, B1); PG8_BAR; PG8_SCHED;
            PG8_LDA(At, 0, 1); PG8_STAGE(PG8_SB(0, 0), b2, voffB); PG8_STAGE(PG8_SB(0, 1), b2 + hstep, voffB); PG8_STAGE(PG8_SA(0, 0), a2, voffA);
            PG8_WAIT_V(8); PG8_WAIT_L(0); PG8_BAR; PG8_MMA(1, 0, At, B0); PG8_MMA(1, 1, At, B1); PG8_BAR; PG8_SCHED;
            PG8_LDB(B0, 1, 0); PG8_LDB(B1, 1, 1); PG8_SCHED; PG8_LDA(At, 1, 0); PG8_STAGE(PG8_SA(0, 1), a2 + hstep, voffA);
            PG8_WAIT_V(8); PG8_WAIT_L(0); PG8_BAR; PG8_MMA(0, 0, At, B0); PG8_MMA(0, 1, At, B1); PG8_BAR; PG8_SCHED;
            PG8_LDA(At, 1, 1); PG8_STAGE(PG8_SB(1, 0), b3, voffB); PG8_STAGE(PG8_SB(1, 1), b3 + hstep, voffB); PG8_STAGE(PG8_SA(1, 0), a3, voffA);
            PG8_WAIT_V(8); PG8_WAIT_L(0); PG8_BAR; PG8_MMA(1, 0, At, B0); PG8_MMA(1, 1, At, B1); PG8_BAR; PG8_SCHED;
            } else {
            PG8_LDB(B0, 0, 0); PG8_SCHED; PG8_LDA(At, 0, 0); PG8_STAGE(PG8_SA(1, 1), a1 + hstep, voffA);
            PG8_WAIT_L(8); PG8_BAR; PG8_WAIT_L(0); PG8_MMA(0, 0, At, B0); PG8_BAR; PG8_SCHED;
            PG8_LDB(B1, 0, 1); PG8_STAGE(PG8_SB(0, 0), b2, voffB);
            PG8_BAR; PG8_WAIT_L(0); PG8_MMA(0, 1, At, B1); PG8_BAR;
            PG8_LDA(At, 0, 1); PG8_STAGE(PG8_SA(0, 0), a2, voffA);
            PG8_BAR; PG8_WAIT_L(0); PG8_MMA(1, 0, At, B0); PG8_BAR; PG8_SCHED;
            PG8_STAGE(PG8_SB(0, 1), b2 + hstep, voffB);
            PG8_WAIT_V(6); PG8_BAR; PG8_MMA(1, 1, At, B1); PG8_BAR;
            PG8_LDB(B0, 1, 0); PG8_SCHED; PG8_LDA(At, 1, 0); PG8_STAGE(PG8_SA(0, 1), a2 + hstep, voffA);
            PG8_WAIT_L(8); PG8_BAR; PG8_WAIT_L(0); PG8_MMA(0, 0, At, B0); PG8_BAR; PG8_SCHED;
            PG8_LDB(B1, 1, 1); PG8_STAGE(PG8_SB(1, 0), b3, voffB);
            PG8_BAR; PG8_WAIT_L(0); PG8_MMA(0, 1, At, B1); PG8_BAR;
            PG8_LDA(At, 1, 1); PG8_STAGE(PG8_SA(1, 0), a3, voffA);
            PG8_BAR; PG8_WAIT_L(0); PG8_MMA(1, 0, At, B0); PG8_BAR; PG8_SCHED;
            PG8_STAGE(PG8_SB(1, 1), b3 + hstep, voffB);
            PG8_WAIT_V(6); PG8_BAR; PG8_MMA(1, 1, At, B1); PG8_BAR;
            }
        }
        if constexpr (ALIGN_EPI) { if (wr == 0) PG8_BAR; }
        if constexpr (!Epi::AFTER_DRAIN) { E(acc, cur, wr, wc, fr, fq); S.done(cur); PG8_EPI_DRAIN; }
        if (!has_next) break;
#pragma unroll
        for (int a = 0; a < 2; ++a)
#pragma unroll
            for (int b = 0; b < 2; ++b)
#pragma unroll
                for (int m = 0; m < 4; ++m)
#pragma unroll
                    for (int n = 0; n < 2; ++n) acc[a][b][m][n] = (f32x4){0.f, 0.f, 0.f, 0.f};
        cur = nxt; cA = nA; cB = nB; ++ui;
        if constexpr (ALIGN_EPI) { if (wr == 1) PG8_BAR; }
    }
    PG8_WAIT_V(0);
    if constexpr (!ALIGN_EPI) { if (wr == 0) PG8_BAR; }
    PG8_BAR;
    if constexpr (Epi::AFTER_DRAIN) { E.fused(acc, cur, wr, wc, fr, fq, lds, wid, lane); S.done(cur); }
#undef PG8_SA
#undef PG8_SB
#undef PG8_STAGE
#undef PG8_LDA
#undef PG8_LDB
#undef PG8_MMA
#undef PG8_WAIT_V
#undef PG8_WAIT_L
#undef PG8_BAR
#undef PG8_SCHED
}
}
#define GAS __attribute__((address_space(1)))
#define LAS __attribute__((address_space(3)))
typedef unsigned short bf16;
typedef unsigned v4u __attribute__((ext_vector_type(4)));
typedef float f32x4 __attribute__((ext_vector_type(4)));
typedef short bf16x8 __attribute__((ext_vector_type(8)));
typedef GAS unsigned gu32;
typedef GAS unsigned long long gu64;
#define RLX_AGENT __ATOMIC_RELAXED, __HIP_MEMORY_SCOPE_AGENT
#define LDS_WAIT() asm volatile("s_waitcnt lgkmcnt(0)" ::: "memory")
#define VM_WAIT() asm volatile("s_waitcnt vmcnt(0)" ::: "memory")
__device__ __forceinline__ unsigned long long rt() { return __builtin_amdgcn_s_memrealtime(); }
__device__ __forceinline__ unsigned f2bf(float f) { unsigned u = __builtin_bit_cast(unsigned, f); return (u + 0x7fffu + ((u >> 16) & 1u)) >> 16; }
__device__ __forceinline__ unsigned pk2(float lo, float hi) { return f2bf(lo) | (f2bf(hi) << 16); }
#define XB_TMO      128
#define XB_XCNT(j)  (256  + 64 * (j))
#define XB_XSUB(j)  (1280 + 64 * (j))
#define XB_XGEN(j)  (2304 + 64 * (j))
#define XB_TOP      3328
#define XB_TOPGEN   3392
#define XCD_BAR_WORDS 3456
#ifndef XB_SCOPE
#define XB_SCOPE "agent"
#endif
#define XB_SPIN_CAP (1u << 18)

__device__ __forceinline__ unsigned xb_ld(unsigned* p)              { return __hip_atomic_load(p, __ATOMIC_RELAXED, __HIP_MEMORY_SCOPE_AGENT); }
__device__ __forceinline__ unsigned xb_add(unsigned* p, unsigned v) { return __hip_atomic_fetch_add(p, v, __ATOMIC_RELAXED, __HIP_MEMORY_SCOPE_AGENT); }
__device__ __forceinline__ unsigned xb_xcc_id() { return (unsigned)__builtin_amdgcn_s_getreg((3 << 11) | 20) & 0xFu; }
#define XB_SPIN(cond, bar) do { unsigned _sp = 0; while (cond) { __builtin_amdgcn_s_sleep(1); \
    if ((++_sp & 255u) == 0u) { if (xb_ld(&(bar)[XB_TMO])) break; if (_sp > XB_SPIN_CAP) { atomicAdd(&(bar)[XB_TMO], 1u); break; } } } } while (0)

struct XcdBarrier {
    unsigned* bar; unsigned x;
    volatile LAS unsigned* st;
};

__device__ __forceinline__ XcdBarrier xcd_barrier_post(unsigned* bar, volatile LAS unsigned* st) {
    XcdBarrier b; b.bar = bar; b.x = xb_xcc_id(); b.st = st;
    if (threadIdx.x == 0) (void)xb_add(&bar[XB_XCNT(b.x)], 1u);
    return b;
}
__device__ __forceinline__ void xcd_barrier_complete(unsigned* bar, unsigned x, unsigned& nloc, unsigned& nx) {
    const unsigned G = gridDim.x * gridDim.y * gridDim.z;
    unsigned sum, cnt, mine, sp = 0u;
    for (;;) {
        sum = 0u; cnt = 0u; mine = 0u;
#pragma unroll
        for (unsigned j = 0; j < 16; ++j) { const unsigned c = xb_ld(&bar[XB_XCNT(j)]); sum += c; cnt += (c > 0u) ? 1u : 0u; mine = (j == x) ? c : mine; }
        if (sum == G) break;
        __builtin_amdgcn_s_sleep(1);
        if ((++sp & 255u) == 0u) { if (xb_ld(&bar[XB_TMO])) break; if (sp > XB_SPIN_CAP) { atomicAdd(&bar[XB_TMO], 1u); break; } }
    }
    nloc = mine > 0u ? mine : 1u; nx = cnt > 0u ? cnt : 1u;
}

__device__ __forceinline__ void xcd_barrier(const XcdBarrier& b) {
    asm volatile("s_waitcnt vmcnt(0)" ::: "memory");
    __syncthreads();
    if (threadIdx.x == 0) {
        unsigned* bar = b.bar;
        __builtin_amdgcn_s_waitcnt(0);
        unsigned nloc = b.st[0], nx = b.st[1];
        if (nloc == 0u) { xcd_barrier_complete(bar, b.x, nloc, nx); b.st[0] = nloc; b.st[1] = nx; }
        const unsigned old = xb_add(&bar[XB_XSUB(b.x)], 1u);
        const unsigned gen = old / nloc;
        if (old + 1u == (gen + 1u) * nloc) {
            __builtin_amdgcn_fence(__ATOMIC_RELEASE, XB_SCOPE);
            asm volatile("s_waitcnt vmcnt(0)" ::: "memory");
            const unsigned og = xb_add(&bar[XB_TOP], 1u);
            const unsigned tg = og / nx;
            if (og + 1u == (tg + 1u) * nx) xb_add(&bar[XB_TOPGEN], 1u);
            else XB_SPIN(xb_ld(&bar[XB_TOPGEN]) == tg, bar);
            __builtin_amdgcn_fence(__ATOMIC_ACQUIRE, XB_SCOPE);
            xb_add(&bar[XB_XGEN(b.x)], 1u);
            asm volatile("s_waitcnt vmcnt(0)" ::: "memory");
        } else {
            XB_SPIN(xb_ld(&bar[XB_XGEN(b.x)]) == gen, bar);
            __builtin_amdgcn_fence(__ATOMIC_ACQUIRE, XB_SCOPE);
            asm volatile("s_waitcnt vmcnt(0)" ::: "memory");
        }
    }
    __syncthreads();
}

constexpr int NWAVES = 8;
constexpr int TOK = 16384, DM = 2048, SEQ = 8192, INC = 11264;
constexpr float EPS = 1e-6f;
#ifndef MK_PER_PHASE
#define MK_PER_PHASE 1
#endif
constexpr int N_PHASES = 10;
#ifndef PHASE_MASK
#define PHASE_MASK 0x3ff
#endif

constexpr size_t MiB = 1u << 20;
constexpr size_t WS_CTL = 0, CTL_ZERO_BYTES = 1 * MiB;
constexpr size_t WS_WMAIN = 2 * MiB;
constexpr size_t WS_WKV = 38 * MiB;
constexpr size_t WS_WRO = 50 * MiB;
constexpr size_t WS_WPO = 58 * MiB;
constexpr size_t WS_WOUT = 62 * MiB;
constexpr size_t WS_WQ = 70 * MiB;
constexpr size_t WS_LINT = 78 * MiB;
constexpr size_t WS_KEYS = 79 * MiB;
constexpr size_t WS_H = 80 * MiB;
constexpr size_t WS_Q = 144 * MiB;
constexpr size_t WS_K = 176 * MiB;
constexpr size_t WS_KZT = 208 * MiB;
constexpr size_t WS_VT = 240 * MiB;
constexpr size_t WS_GATES = 144 * MiB;
constexpr size_t WS_UT = 144 * MiB;
constexpr size_t WS_VTAB = 208 * MiB;
constexpr size_t WS_GR = 304 * MiB;
constexpr size_t WS_PIN = 368 * MiB;
constexpr size_t WS_ST = 400 * MiB;
constexpr size_t WS_POOLED = 464 * MiB;
constexpr size_t WS_RETN = 464 * MiB;
constexpr size_t WS_X1 = 400 * MiB;
constexpr size_t WS_END = 528 * MiB;
constexpr int CW_BAR = 4096;
constexpr int CW_SUMSQ = 65536;

constexpr int LDS_BYTES = 147456;
constexpr int MISC_OFF = 143360;

struct Frame {
    LAS unsigned char* lds;
    int tid, lane, wave, G, vcu;
};
__device__ __forceinline__ float wave_sum(float v) {
#pragma unroll
    for (int o = 1; o < 64; o <<= 1) v += __shfl_xor(v, o);
    return v;
}
typedef GAS const v4u gcv4u;
typedef GAS v4u gv4u;
typedef GAS const f32x4 gcf4;
typedef GAS f32x4 gf4;
__device__ __forceinline__ float bflo(unsigned u) { return __builtin_bit_cast(float, u << 16); }
__device__ __forceinline__ float bfhi(unsigned u) { return __builtin_bit_cast(float, u & 0xffff0000u); }
__device__ __forceinline__ float log2_gamma(int h) { return pg8::log2_gamma(h); }

__device__ __forceinline__ void win_rows(int c, int& rmain, int& rkv) {
    rmain = -1; rkv = -1;
    if (c < 2048) { const int isk = c >> 10, cc = c & 1023, hh = cc >> 7, r = cc & 127, half = r >> 6, i = r & 63;
        rmain = isk * 1024 + hh * 128 + 2 * i + half;
        if (isk) rkv = hh * 128 + 64 * (i >> 5) + 16 * (2 * half + ((i >> 4) & 1)) + (i & 15); }
    else if (c < 4096) rkv = 1024 + (c - 2048);
    else if (c < 6144) rmain = 2048 + (c - 4096);
    else if (c < 7168) rmain = 4096 + (c - 6144);
    else rmain = 5120 + (c - 7168);
}
template <int MODE>
__device__ __forceinline__ void p0_transpose_item(const float* W, int ldw, int k0, int n0, bf16* WT, bf16* WT2, int ldt, int row_off, const float* ksc, LAS float* scr, int lane) {
#pragma unroll 8
    for (int i = 0; i < 32; ++i) { const int kk = 2 * i + (lane >> 5); float v = W[(size_t)(k0 + kk) * ldw + n0 + (lane & 31)]; if (ksc) v *= ksc[k0 + kk]; scr[kk * 33 + (lane & 31)] = v; }
    LDS_WAIT(); asm volatile("" ::: "memory");
    const int c = lane & 7;
#pragma unroll
    for (int j = 0; j < 4; ++j) { const int n = (lane >> 3) + 8 * j; const LAS float* s = scr + (8 * c) * 33 + n;
        v4u o; o.x = pk2(s[0 * 33], s[1 * 33]); o.y = pk2(s[2 * 33], s[3 * 33]); o.z = pk2(s[4 * 33], s[5 * 33]); o.w = pk2(s[6 * 33], s[7 * 33]);
        if (MODE == 0) { *(GAS v4u*)(WT + (size_t)(row_off + n0 + n) * ldt + k0 + 8 * c) = o; }
        else { int r1, r2; win_rows(n0 + n, r1, r2);
            if (r1 >= 0) *(GAS v4u*)(WT + (size_t)r1 * ldt + k0 + 8 * c) = o;
            if (r2 >= 0) *(GAS v4u*)(WT2 + (size_t)r2 * ldt + k0 + 8 * c) = o; } }
    LDS_WAIT(); asm volatile("" ::: "memory");
}
__device__ __forceinline__ void rms_row_to_bf16(int lane, const float* xrow, const float* w, bf16* orow) {
    const GAS f32x4* xr = (const GAS f32x4*)xrow + lane; const GAS f32x4* wr = (const GAS f32x4*)w + lane;
    f32x4 v[8]; float s = 0.f;
#pragma unroll
    for (int j = 0; j < 8; ++j) { v[j] = xr[64 * j]; s += (v[j].x * v[j].x + v[j].y * v[j].y) + (v[j].z * v[j].z + v[j].w * v[j].w); }
    const float rstd = __builtin_amdgcn_rsqf(wave_sum(s) * (1.f / DM) + EPS);
    GAS unsigned long long* o8 = (GAS unsigned long long*)orow + lane;
#pragma unroll
    for (int j = 0; j < 8; ++j) { const f32x4 ww = wr[64 * j];
        o8[64 * j] = (unsigned long long)pk2(v[j].x * rstd * ww.x, v[j].y * rstd * ww.y) | ((unsigned long long)pk2(v[j].z * rstd * ww.z, v[j].w * rstd * ww.w) << 32); }
}
struct P0Args { const float *x, *norm1_w, *w_in, *w_ret_o, *w_pool_lin, *w_pool_o, *w_out, *norm2_w, *peer_w_q, *sub_keys;
    bf16 *Wmain, *Wkv, *Wro, *Wpo, *Wout, *Wq, *linT, *keys, *h; };
__device__ __forceinline__ void p0_prologue(const Frame& F, const P0Args& a) {
    LAS float* scr = (LAS float*)(F.lds + F.wave * 16384);
    const int gw = F.vcu * NWAVES + F.wave, NGW = F.G * NWAVES;
    constexpr int I_IN = 32 * 352, I_SQ = 32 * 64, I_PO = 16 * 64, I_LIN = 4 * 4 * 8;
    constexpr int NITEMS = I_IN + 3 * I_SQ + I_PO + I_LIN;
    for (int it = gw; it < NITEMS; it += NGW) {
        int r = it;
        if (r < I_IN) { const int kb = r / 352, nb = r % 352; p0_transpose_item<1>(a.w_in, INC, 64 * kb, 32 * nb, a.Wmain, a.Wkv, DM, 0, nullptr, scr, F.lane); continue; } r -= I_IN;
        if (r < I_SQ) { const int kb = r / 64, nb = r % 64; p0_transpose_item<0>(a.w_ret_o, DM, 64 * kb, 32 * nb, a.Wro, nullptr, DM, 0, nullptr, scr, F.lane); continue; } r -= I_SQ;
        if (r < I_SQ) { const int kb = r / 64, nb = r % 64; p0_transpose_item<0>(a.w_out, DM, 64 * kb, 32 * nb, a.Wout, nullptr, DM, 0, nullptr, scr, F.lane); continue; } r -= I_SQ;
        if (r < I_SQ) { const int kb = r / 64, nb = r % 64; p0_transpose_item<0>(a.peer_w_q, DM, 64 * kb, 32 * nb, a.Wq, nullptr, DM, 0, a.norm2_w, scr, F.lane); continue; } r -= I_SQ;
        if (r < I_PO) { const int kb = r / 64, nb = r % 64; p0_transpose_item<0>(a.w_pool_o, DM, 64 * kb, 32 * nb, a.Wpo, nullptr, 1024, 0, nullptr, scr, F.lane); continue; } r -= I_PO;
        { const int g = r >> 5, kb = (r >> 3) & 3, nb = r & 7; p0_transpose_item<0>(a.w_pool_lin + (size_t)g * 65536, 256, 64 * kb, 32 * nb, a.linT, nullptr, 256, g * 256, nullptr, scr, F.lane); }
    }
    for (int m = gw; m < TOK; m += NGW) rms_row_to_bf16(F.lane, a.x + (size_t)m * DM, a.norm1_w, a.h + (size_t)m * DM);
    for (int i = (gw * 64 + F.lane) * 2; i < 2 * 128 * 128; i += NGW * 64 * 2) *(GAS unsigned*)(a.keys + i) = pk2(a.sub_keys[i], a.sub_keys[i + 1]);
}

__device__ __forceinline__ void p2_kv_unit(const Frame& F, int uu, const bf16* kzT, const bf16* vT, bf16* st) {
    const int bh = uu / 63, n = uu - bh * 63, w = F.wave, fr = F.lane & 15, fq = F.lane >> 4;
    const bf16* kz = kzT + ((size_t)bh * 128 + fr) * 8192 + 128 * n + 8 * fq;
    const bf16* vv = vT + ((size_t)bh * 256 + 32 * w + fr) * 8192 + 128 * n + 8 * fq;
    f32x4 acc[8][2];
#pragma unroll
    for (int dt = 0; dt < 8; ++dt) { acc[dt][0] = (f32x4){0.f, 0.f, 0.f, 0.f}; acc[dt][1] = (f32x4){0.f, 0.f, 0.f, 0.f}; }
#pragma unroll 2
    for (int ks = 0; ks < 4; ++ks) {
        bf16x8 vf[2], kf[8];
#pragma unroll
        for (int t = 0; t < 2; ++t) vf[t] = *(GAS const bf16x8*)(vv + (size_t)(16 * t) * 8192 + 32 * ks);
#pragma unroll
        for (int dt = 0; dt < 8; ++dt) kf[dt] = *(GAS const bf16x8*)(kz + (size_t)(16 * dt) * 8192 + 32 * ks);
#pragma unroll
        for (int dt = 0; dt < 8; ++dt)
#pragma unroll
            for (int t = 0; t < 2; ++t) acc[dt][t] = __builtin_amdgcn_mfma_f32_16x16x32_bf16(kf[dt], vf[t], acc[dt][t], 0, 0, 0);
    }
    bf16* so = st + ((size_t)(bh * 64 + n) * 256 + 32 * w + fr) * 128 + 4 * fq;
#pragma unroll
    for (int dt = 0; dt < 8; ++dt)
#pragma unroll
        for (int t = 0; t < 2; ++t) { const f32x4 v = acc[dt][t];
            *(GAS unsigned long long*)(so + (size_t)(16 * t) * 128 + 16 * dt) = (unsigned long long)pk2(v[0], v[1]) | ((unsigned long long)pk2(v[2], v[3]) << 32); }
}
__device__ __forceinline__ void p2_pool(const Frame& F, const bf16* pin, bf16* pooled) {
    const int NT = F.G * NWAVES * 64;
    for (int idx = F.vcu * NWAVES * 64 + F.tid; idx < TOK * 128; idx += NT) {
        const int tok = idx >> 7, cg = idx & 127, g = cg >> 5, w = 2 << g, s = tok & 8191, cnt = (s + 1 < w) ? s + 1 : w;
        const bf16* p = pin + (size_t)tok * 1024 + 8 * cg;
        float a[8];
        const v4u self = *(gcv4u*)p;
        a[0] = bflo(self.x); a[1] = bfhi(self.x); a[2] = bflo(self.y); a[3] = bfhi(self.y); a[4] = bflo(self.z); a[5] = bfhi(self.z); a[6] = bflo(self.w); a[7] = bfhi(self.w);
        float sm[8];
#pragma unroll
        for (int j = 0; j < 8; ++j) sm[j] = a[j];
        for (int t = 1; t < cnt; ++t) { const v4u o = *(gcv4u*)(p - (size_t)t * 1024);
            sm[0] += bflo(o.x); sm[1] += bfhi(o.x); sm[2] += bflo(o.y); sm[3] += bfhi(o.y); sm[4] += bflo(o.z); sm[5] += bfhi(o.z); sm[6] += bflo(o.w); sm[7] += bfhi(o.w); }
        const float ic = 1.0f / (float)cnt;
        v4u o; o.x = pk2(sm[0] * ic - a[0], sm[1] * ic - a[1]); o.y = pk2(sm[2] * ic - a[2], sm[3] * ic - a[3]); o.z = pk2(sm[4] * ic - a[4], sm[5] * ic - a[5]); o.w = pk2(sm[6] * ic - a[6], sm[7] * ic - a[7]);
        *(gv4u*)(pooled + ((size_t)g * TOK + tok) * 256 + ((8 * cg) & 255)) = o;
    }
}

__device__ __forceinline__ void p3_scan(const Frame& F, bf16* st) {
    const int NT = F.G * NWAVES * 64;
    for (int vid = F.vcu * NWAVES * 64 + F.tid; vid < 65536; vid += NT) {
        const int bh = vid >> 12, vec = vid & 4095, hh = bh & 7;
        const float gc = __builtin_amdgcn_exp2f(128.0f * log2_gamma(hh));
        bf16* p = st + (size_t)bh * 64 * 32768 + 8 * vec;
        float R[8];
#pragma unroll
        for (int j = 0; j < 8; ++j) R[j] = 0.f;
#pragma unroll 1
        for (int n0 = 0; n0 < 64; n0 += 8) {
            v4u kv[8];
#pragma unroll
            for (int t = 0; t < 8; ++t) if (n0 + t < 63) kv[t] = *(gcv4u*)(p + (size_t)(n0 + t) * 32768); else kv[t] = (v4u){0u, 0u, 0u, 0u};
#pragma unroll
            for (int t = 0; t < 8; ++t) {
                v4u o; o.x = pk2(R[0], R[1]); o.y = pk2(R[2], R[3]); o.z = pk2(R[4], R[5]); o.w = pk2(R[6], R[7]);
                *(gv4u*)(p + (size_t)(n0 + t) * 32768) = o;
                R[0] = gc * R[0] + bflo(kv[t].x); R[1] = gc * R[1] + bfhi(kv[t].x); R[2] = gc * R[2] + bflo(kv[t].y); R[3] = gc * R[3] + bfhi(kv[t].y);
                R[4] = gc * R[4] + bflo(kv[t].z); R[5] = gc * R[5] + bfhi(kv[t].z); R[6] = gc * R[6] + bflo(kv[t].w); R[7] = gc * R[7] + bfhi(kv[t].w);
            }
        }
    }
}

constexpr int P4_PITCH = 272;
__device__ __forceinline__ void p4_unit(const Frame& F, int uu, const bf16* q, const bf16* k, const bf16* vT, const bf16* st, const bf16* grs, bf16* retn) {
    const int bh = uu >> 6, n = uu & 63, hh = bh & 7, b = bh >> 3;
    const int w = F.wave, wr = w >> 2, wc = w & 3, fr = F.lane & 15, fq = F.lane >> 4;
    const float lg = log2_gamma(hh);
    LAS unsigned char* P = F.lds;
    LAS float* stats = (LAS float*)(F.lds + 128 * P4_PITCH);
    const bf16* Qb = q + ((size_t)bh * 8192 + 128 * n) * 128;
    const bf16* Kb = k + ((size_t)bh * 8192 + 128 * n) * 128;
    {
        f32x4 sa[4][2];
#pragma unroll
        for (int it = 0; it < 4; ++it) { sa[it][0] = (f32x4){0.f, 0.f, 0.f, 0.f}; sa[it][1] = (f32x4){0.f, 0.f, 0.f, 0.f}; }
#pragma unroll
        for (int ks = 0; ks < 4; ++ks) {
            bf16x8 qf[4], kf[2];
#pragma unroll
            for (int it = 0; it < 4; ++it) qf[it] = *(GAS const bf16x8*)(Qb + (size_t)(64 * wr + 16 * it + fr) * 128 + 32 * ks + 8 * fq);
#pragma unroll
            for (int jt = 0; jt < 2; ++jt) kf[jt] = *(GAS const bf16x8*)(Kb + (size_t)(32 * wc + 16 * jt + fr) * 128 + 32 * ks + 8 * fq);
#pragma unroll
            for (int it = 0; it < 4; ++it)
#pragma unroll
                for (int jt = 0; jt < 2; ++jt) sa[it][jt] = __builtin_amdgcn_mfma_f32_16x16x32_bf16(kf[jt], qf[it], sa[it][jt], 0, 0, 0);
        }
#pragma unroll
        for (int it = 0; it < 4; ++it)
#pragma unroll
            for (int jt = 0; jt < 2; ++jt) {
                const int i = 64 * wr + 16 * it + fr, j0 = 32 * wc + 16 * jt + 4 * fq;
                float pv[4];
#pragma unroll
                for (int r = 0; r < 4; ++r) { const int dlt = i - (j0 + r); pv[r] = (dlt >= 0) ? sa[it][jt][r] * __builtin_amdgcn_exp2f((float)dlt * lg) : 0.f; }
                *(LAS unsigned long long*)(P + i * P4_PITCH + j0 * 2) = (unsigned long long)pk2(pv[0], pv[1]) | ((unsigned long long)pk2(pv[2], pv[3]) << 32);
            }
    }
    __syncthreads();
    f32x4 acc[4][4];
#pragma unroll
    for (int it = 0; it < 4; ++it)
#pragma unroll
        for (int et = 0; et < 4; ++et) acc[it][et] = (f32x4){0.f, 0.f, 0.f, 0.f};
    const bf16* RTb = st + ((size_t)(bh * 64 + n)) * 32768;
    const bf16* vTb = vT + ((size_t)bh * 256) * 8192 + 128 * n;
    int esrc[4];
#pragma unroll
    for (int et = 0; et < 4; ++et) esrc[et] = 64 * wc + 32 * (et >> 1) + 8 * (fr >> 2) + 4 * (et & 1) + (fr & 3);
#pragma unroll
    for (int ks = 0; ks < 4; ++ks) {
        bf16x8 qf[4], rf[4];
#pragma unroll
        for (int it = 0; it < 4; ++it) qf[it] = *(GAS const bf16x8*)(Qb + (size_t)(64 * wr + 16 * it + fr) * 128 + 32 * ks + 8 * fq);
#pragma unroll
        for (int et = 0; et < 4; ++et) rf[et] = *(GAS const bf16x8*)(RTb + (size_t)esrc[et] * 128 + 32 * ks + 8 * fq);
#pragma unroll
        for (int it = 0; it < 4; ++it)
#pragma unroll
            for (int et = 0; et < 4; ++et) acc[it][et] = __builtin_amdgcn_mfma_f32_16x16x32_bf16(rf[et], qf[it], acc[it][et], 0, 0, 0);
    }
#pragma unroll
    for (int it = 0; it < 4; ++it) { const float xi = __builtin_amdgcn_exp2f((float)(64 * wr + 16 * it + fr + 1) * lg);
#pragma unroll
        for (int et = 0; et < 4; ++et) acc[it][et] = acc[it][et] * xi; }
#pragma unroll
    for (int ks = 0; ks < 4; ++ks) {
        bf16x8 pf[4], vf[4];
#pragma unroll
        for (int it = 0; it < 4; ++it) pf[it] = *(LAS const bf16x8*)(P + (64 * wr + 16 * it + fr) * P4_PITCH + (32 * ks + 8 * fq) * 2);
#pragma unroll
        for (int et = 0; et < 4; ++et) vf[et] = *(GAS const bf16x8*)(vTb + (size_t)esrc[et] * 8192 + 32 * ks + 8 * fq);
#pragma unroll
        for (int it = 0; it < 4; ++it)
#pragma unroll
            for (int et = 0; et < 4; ++et) acc[it][et] = __builtin_amdgcn_mfma_f32_16x16x32_bf16(vf[et], pf[it], acc[it][et], 0, 0, 0);
    }
#pragma unroll
    for (int it = 0; it < 4; ++it) {
        float s1 = 0.f, s2 = 0.f;
#pragma unroll
        for (int et = 0; et < 4; ++et)
#pragma unroll
            for (int r = 0; r < 4; ++r) { const float v = acc[it][et][r]; s1 += v; s2 += v * v; }
        s1 += __shfl_xor(s1, 16); s1 += __shfl_xor(s1, 32); s2 += __shfl_xor(s2, 16); s2 += __shfl_xor(s2, 32);
        if (fq == 0) { const int i = 64 * wr + 16 * it + fr; stats[(i * 4 + wc) * 2] = s1; stats[(i * 4 + wc) * 2 + 1] = s2; }
    }
    __syncthreads();
#pragma unroll
    for (int it = 0; it < 4; ++it) {
        const int i = 64 * wr + 16 * it + fr;
        float s1 = 0.f, s2 = 0.f;
#pragma unroll
        for (int c = 0; c < 4; ++c) { s1 += stats[(i * 4 + c) * 2]; s2 += stats[(i * 4 + c) * 2 + 1]; }
        const float mu = s1 * (1.f / 256.f), var = s2 * (1.f / 256.f) - mu * mu, rstd = __builtin_amdgcn_rsqf(fmaxf(var, 0.f) + EPS);
        const size_t tok = (size_t)b * 8192 + 128 * n + i;
#pragma unroll
        for (int t = 0; t < 2; ++t) {
            const size_t off = tok * 2048 + hh * 256 + 64 * wc + 32 * t + 8 * fq;
            const v4u g = *(gcv4u*)(grs + off);
            const f32x4 a0 = acc[it][2 * t], a1 = acc[it][2 * t + 1];
            v4u o;
            o.x = pk2((a0[0] - mu) * rstd * bflo(g.x), (a0[1] - mu) * rstd * bfhi(g.x)); o.y = pk2((a0[2] - mu) * rstd * bflo(g.y), (a0[3] - mu) * rstd * bfhi(g.y));
            o.z = pk2((a1[0] - mu) * rstd * bflo(g.z), (a1[1] - mu) * rstd * bfhi(g.z)); o.w = pk2((a1[2] - mu) * rstd * bflo(g.w), (a1[3] - mu) * rstd * bfhi(g.w));
            *(gv4u*)(retn + off) = o;
        }
    }
    __syncthreads();
}

__device__ __forceinline__ void p6_tables(const Frame& F, const float* u, const float* v, const float* n2w, bf16* ut, bf16* vt) {
    const int gw = F.vcu * NWAVES + F.wave, NGW = F.G * NWAVES;
    f32x4 wv[8];
#pragma unroll
    for (int j = 0; j < 4; ++j) { wv[2 * j] = *(gcf4*)(n2w + 512 * j + 8 * F.lane); wv[2 * j + 1] = *(gcf4*)(n2w + 512 * j + 8 * F.lane + 4); }
    for (int r = gw; r < 32768; r += NGW) {
        const bool isv = r >= 16384; const int rr = r & 16383;
        const float* src = (isv ? v : u) + (size_t)rr * 2048 + 8 * F.lane; bf16* dst = (isv ? vt : ut) + (size_t)rr * 2048 + 8 * F.lane;
#pragma unroll
        for (int j = 0; j < 4; ++j) { f32x4 a = *(gcf4*)(src + 512 * j), c = *(gcf4*)(src + 512 * j + 4);
            if (!isv) { a = a * wv[2 * j]; c = c * wv[2 * j + 1]; }
            v4u o; o.x = pk2(a[0], a[1]); o.y = pk2(a[2], a[3]); o.z = pk2(c[0], c[1]); o.w = pk2(c[2], c[3]);
            *(gv4u*)(dst + 512 * j) = o; }
    }
}

constexpr int P8_SEG = 272;
constexpr int P8_KX_OFF = 512 * P8_SEG;
__device__ __forceinline__ int f2key(float f) { const int b = __builtin_bit_cast(int, f); return b ^ ((b >> 31) & 0x7fffffff); }
__device__ __forceinline__ float key2f(int k) { return __builtin_bit_cast(float, k ^ ((k >> 31) & 0x7fffffff)); }
__device__ __forceinline__ int imax(int a, int b) { return a > b ? a : b; }
__device__ __forceinline__ int imin(int a, int b) { return a < b ? a : b; }
#define TOPK_INS(L, xk) do { int _x = (xk); _Pragma("unroll") for (int _q = 0; _q < 16; ++_q) { const int _h = imax(L[_q], _x); _x = imin(L[_q], _x); L[_q] = _h; } } while (0)
#define BITONIC16(M) do { _Pragma("unroll") for (int _s = 8; _s >= 1; _s >>= 1) { _Pragma("unroll") for (int _i = 0; _i < 16; ++_i) if ((_i & _s) == 0) { const int _a = imax(M[_i], M[_i + _s]), _b = imin(M[_i], M[_i + _s]); M[_i] = _a; M[_i + _s] = _b; } } } while (0)
__device__ __forceinline__ float gelu_exact(float v) {
    const float av = __builtin_fabsf(v), t = __builtin_amdgcn_rcpf(av * 0.2316418882f + 1.0f);
    float q = t * 0.5307027145f + (-0.7265760135f); q = q * t + 0.7107068705f; q = q * t + (-0.142248368f); q = q * t + 0.127414796f; q = q * t;
    const float e = __builtin_amdgcn_exp2f((v * v) * (-0.72134752044f)), m = v * (q * e);
    return v < 0.f ? m : v - m;
}
typedef __bf16 bf16x2_t __attribute__((ext_vector_type(2)));
__device__ __forceinline__ float dot2bf(unsigned a, unsigned b, float c) { return __builtin_amdgcn_fdot2_f32_bf16(__builtin_bit_cast(bf16x2_t, a), __builtin_bit_cast(bf16x2_t, b), c, false); }

struct P8Args { const bf16 *qp, *keys, *x1b, *ut, *vt; const float *sumsq, *fw, *x1; float* out; };

__device__ __forceinline__ void p8_subtile(const Frame& F, int sub, const P8Args& a) {
    const int w = F.wave, lane = F.lane, fr = lane & 15, fq = lane >> 4, tid = F.tid;
    const int tok0 = sub * 16;
    LAS unsigned char* S = F.lds;
#ifndef P8_NO_A
    {
        f32x4 acc[2][8];
#pragma unroll
        for (int p = 0; p < 2; ++p)
#pragma unroll
            for (int kt = 0; kt < 8; ++kt) acc[p][kt] = (f32x4){0.f, 0.f, 0.f, 0.f};
        const bf16* qrow = a.qp + (size_t)(tok0 + 2 * w + (fr >> 3)) * 2048 + (fr & 7) * 256 + 8 * fq;
#pragma unroll
        for (int p = 0; p < 2; ++p)
#pragma unroll 1
            for (int ks = 0; ks < 4; ++ks) {
                const bf16x8 qf = *(GAS const bf16x8*)(qrow + p * 128 + 32 * ks);
#pragma unroll
                for (int kt = 0; kt < 8; ++kt) {
                    const bf16x8 kf = *(GAS const bf16x8*)(a.keys + (size_t)(p * 128 + 16 * kt + fr) * 128 + 32 * ks + 8 * fq);
                    acc[p][kt] = __builtin_amdgcn_mfma_f32_16x16x32_bf16(kf, qf, acc[p][kt], 0, 0, 0);
                }
            }
        const int row = 16 * w + fr;
#pragma unroll
        for (int p = 0; p < 2; ++p)
#pragma unroll
            for (int kt = 0; kt < 8; ++kt)
                *(LAS f32x4*)(S + (row * 4 + p * 2 + (kt >> 2)) * P8_SEG + (16 * (kt & 3) + 4 * fq) * 4) = acc[p][kt];
    }
#endif
    __syncthreads();
#ifndef P8_NO_B
    int T[16];
    {
        int L[16];
#pragma unroll
        for (int i = 0; i < 16; ++i) L[i] = (int)0x80000000;
        const int half = tid & 1;
#pragma unroll
        for (int c = 0; c < 16; ++c) {
            const f32x4 v = *(LAS const f32x4*)(S + tid * P8_SEG + c * 16);
#pragma unroll
            for (int j = 0; j < 4; ++j) { const int key = (f2key(v[j]) & ~127) | (half * 64 + 4 * c + j); TOPK_INS(L, key); }
        }
        int M[16];
#pragma unroll
        for (int i = 0; i < 16; ++i) M[i] = imax(L[i], __builtin_amdgcn_mov_dpp(L[15 - i], 0xB1, 0xF, 0xF, true));
        BITONIC16(M);
        float fa[16], fb[16];
        const bool q2 = (tid & 2) != 0;
#pragma unroll
        for (int i = 0; i < 16; ++i) { const int o = __builtin_amdgcn_mov_dpp(M[i], 0x4E, 0xF, 0xF, true); fa[i] = key2f(q2 ? o : M[i]); fb[i] = key2f(q2 ? M[i] : o); }
        if ((tid & 1) == 0) {
            LAS unsigned* kx = (LAS unsigned*)(S + P8_KX_OFF + (tid >> 2) * 32 + ((tid >> 1) & 1) * 16);
#pragma unroll
            for (int d = 0; d < 4; ++d) kx[d] = (unsigned)(M[4 * d] & 127) | ((unsigned)(M[4 * d + 1] & 127) << 8) | ((unsigned)(M[4 * d + 2] & 127) << 16) | ((unsigned)(M[4 * d + 3] & 127) << 24);
        }
#pragma unroll
        for (int i = 0; i < 16; ++i) T[i] = (int)0x80000000;
#pragma unroll
        for (int i = 0; i < 16; ++i)
#pragma unroll
            for (int j = 0; j < 16; ++j)
                if ((i + 1) * (j + 1) <= 16) { const int key = (f2key(fa[i] + fb[j]) & ~255) | (i * 16 + j); TOPK_INS(T, key); }
    }
    __syncthreads();
    {
        LAS int* eidxL = (LAS int*)S;
        LAS float* gateL = (LAS float*)(S + 8192);
        LAS const unsigned char* kx = (LAS const unsigned char*)(S + P8_KX_OFF + (tid >> 2) * 32);
        const float mx = key2f(T[0]);
        float ev[16], sum = 0.f;
#pragma unroll
        for (int r = 0; r < 16; ++r) { ev[r] = __builtin_amdgcn_exp2f((key2f(T[r]) - mx) * 1.4426950408889634f); sum += ev[r]; }
        const float inv = __builtin_amdgcn_rcpf(sum);
        const int q = tid & 3, row = tid >> 2;
#pragma unroll
        for (int r = 0; r < 16; ++r) if ((r >> 2) == q) {
            const int i = (T[r] >> 4) & 15, j = T[r] & 15;
            eidxL[row * 16 + r] = (int)kx[i] * 128 + (int)kx[16 + j];
            gateL[row * 16 + r] = ev[r] * inv;
        }
    }
#endif
    __syncthreads();
#ifndef P8_NO_C
    {
        LAS const int* eidxL = (LAS const int*)S;
        LAS const float* gateL = (LAS const float*)(S + 8192);
#pragma unroll 1
        for (int ti = 0; ti < 2; ++ti) {
            const int tt = 2 * w + ti; const size_t tok = (size_t)(tok0 + tt);
            const int e0 = eidxL[tt * 128 + lane], e1 = eidxL[tt * 128 + 64 + lane];
            unsigned xp[16];
#pragma unroll
            for (int i = 0; i < 4; ++i) { const v4u t = *(gcv4u*)(a.x1b + tok * 2048 + 512 * i + 8 * lane); xp[4 * i] = t.x; xp[4 * i + 1] = t.y; xp[4 * i + 2] = t.z; xp[4 * i + 3] = t.w; }
            const float rstd2 = __builtin_amdgcn_rsqf(wave_sum(lane < 32 ? a.sumsq[tok * 32 + lane] : 0.f) * (1.0f / 2048.0f) + EPS);
            float out[32];
#pragma unroll
            for (int i = 0; i < 32; ++i) out[i] = 0.f;
#pragma unroll 1
            for (int g = 0; g < 8; ++g) {
                const int ev = (g < 4) ? e0 : e1; const int lbase = (16 * g) & 63;
                float part[16];
#pragma unroll
                for (int rb = 0; rb < 4; ++rb) {
                    v4u ub[4][4];
#pragma unroll
                    for (int r4 = 0; r4 < 4; ++r4) { const int e = __builtin_amdgcn_readlane(ev, lbase + 4 * rb + r4); const bf16* base = a.ut + (size_t)e * 2048 + 8 * lane;
#pragma unroll
                        for (int i = 0; i < 4; ++i) ub[r4][i] = *(gcv4u*)(base + 512 * i); }
#pragma unroll
                    for (int r4 = 0; r4 < 4; ++r4) { float p = 0.f;
#pragma unroll
                        for (int i = 0; i < 4; ++i) { p = dot2bf(ub[r4][i].x, xp[4 * i], p); p = dot2bf(ub[r4][i].y, xp[4 * i + 1], p); p = dot2bf(ub[r4][i].z, xp[4 * i + 2], p); p = dot2bf(ub[r4][i].w, xp[4 * i + 3], p); }
                        part[4 * rb + r4] = p; }
                    __builtin_amdgcn_sched_barrier(0);
                }
#pragma unroll
                for (int i = 0; i < 8; ++i) { const bool hi = (lane & 32) != 0; const float snd = hi ? part[i] : part[i + 8], kp = hi ? part[i + 8] : part[i]; part[i] = kp + __shfl_xor(snd, 32); }
#pragma unroll
                for (int i = 0; i < 4; ++i) { const bool hi = (lane & 16) != 0; const float snd = hi ? part[i] : part[i + 4], kp = hi ? part[i + 4] : part[i]; part[i] = kp + __shfl_xor(snd, 16); }
#pragma unroll
                for (int i = 0; i < 2; ++i) { const bool hi = (lane & 8) != 0; const float snd = hi ? part[i] : part[i + 2], kp = hi ? part[i + 2] : part[i]; part[i] = kp + __shfl_xor(snd, 8); }
                { const bool hi = (lane & 4) != 0; const float snd = hi ? part[0] : part[1], kp = hi ? part[1] : part[0]; part[0] = kp + __shfl_xor(snd, 4); }
                float av = part[0]; av += __shfl_xor(av, 1); av += __shfl_xor(av, 2);
                const float wv = gelu_exact(av * rstd2) * gateL[(tt * 8 + g) * 16 + (lane >> 2)];
#define P8_VLOAD(buf, rbx) do { _Pragma("unroll") for (int r4 = 0; r4 < 4; ++r4) { const int e = __builtin_amdgcn_readlane(ev, lbase + 4 * (rbx) + r4); const bf16* base = a.vt + (size_t)e * 2048 + 8 * lane; \
                    _Pragma("unroll") for (int i = 0; i < 4; ++i) buf[r4][i] = *(gcv4u*)(base + 512 * i); } } while (0)
#define P8_VFMA(buf, rbx) do { _Pragma("unroll") for (int r4 = 0; r4 < 4; ++r4) { const float ws = __builtin_bit_cast(float, __builtin_amdgcn_readlane(__builtin_bit_cast(int, wv), 4 * (4 * (rbx) + r4))); \
                    _Pragma("unroll") for (int i = 0; i < 4; ++i) { const v4u t = buf[r4][i]; \
                        out[8 * i + 0] += ws * bflo(t.x); out[8 * i + 1] += ws * bfhi(t.x); out[8 * i + 2] += ws * bflo(t.y); out[8 * i + 3] += ws * bfhi(t.y); \
                        out[8 * i + 4] += ws * bflo(t.z); out[8 * i + 5] += ws * bfhi(t.z); out[8 * i + 6] += ws * bflo(t.w); out[8 * i + 7] += ws * bfhi(t.w); } } } while (0)
#pragma unroll 1
                for (int rb = 0; rb < 4; ++rb) {
                    v4u vA[4][4];
                    P8_VLOAD(vA, rb);
                    P8_VFMA(vA, rb);
                }
            }
            float ss = 0.f;
            float* orow = a.out + tok * 2048 + 8 * lane; const float* xrow = a.x1 + tok * 2048 + 8 * lane;
#ifdef P8_X1_BF16
#pragma unroll
            for (int i = 0; i < 4; ++i) { out[8 * i + 0] += bflo(xp[4 * i]); out[8 * i + 1] += bfhi(xp[4 * i]); out[8 * i + 2] += bflo(xp[4 * i + 1]); out[8 * i + 3] += bfhi(xp[4 * i + 1]);
                out[8 * i + 4] += bflo(xp[4 * i + 2]); out[8 * i + 5] += bfhi(xp[4 * i + 2]); out[8 * i + 6] += bflo(xp[4 * i + 3]); out[8 * i + 7] += bfhi(xp[4 * i + 3]); }
#else
#pragma unroll
            for (int i = 0; i < 4; ++i) { const f32x4 c0 = *(gcf4*)(xrow + 512 * i), c1 = *(gcf4*)(xrow + 512 * i + 4);
                out[8 * i + 0] += c0[0]; out[8 * i + 1] += c0[1]; out[8 * i + 2] += c0[2]; out[8 * i + 3] += c0[3]; out[8 * i + 4] += c1[0]; out[8 * i + 5] += c1[1]; out[8 * i + 6] += c1[2]; out[8 * i + 7] += c1[3]; }
#endif
#pragma unroll
            for (int i = 0; i < 32; ++i) ss += out[i] * out[i];
            const float rs = __builtin_amdgcn_rsqf(wave_sum(ss) * (1.0f / 2048.0f) + EPS);
#pragma unroll
            for (int i = 0; i < 4; ++i) { const f32x4 w0 = *(gcf4*)(a.fw + 512 * i + 8 * lane), w1 = *(gcf4*)(a.fw + 512 * i + 8 * lane + 4);
                *(gf4*)(orow + 512 * i) = (f32x4){out[8 * i] * rs * w0[0], out[8 * i + 1] * rs * w0[1], out[8 * i + 2] * rs * w0[2], out[8 * i + 3] * rs * w0[3]};
                *(gf4*)(orow + 512 * i + 4) = (f32x4){out[8 * i + 4] * rs * w1[0], out[8 * i + 5] * rs * w1[1], out[8 * i + 6] * rs * w1[2], out[8 * i + 7] * rs * w1[3]}; }
        }
    }
#endif
    __syncthreads();
}

struct Args { const float* in[14]; float* out; unsigned char* ws; int ph_lo, ph_hi; };
__global__ void __launch_bounds__(NWAVES * 64, 2) hybrid_fwd(Args args) {
    extern __shared__ __attribute__((aligned(16))) unsigned char lds[];
    Frame F;
    F.lds = (LAS unsigned char*)lds;
    F.tid = threadIdx.x; F.lane = F.tid & 63; F.wave = __builtin_amdgcn_readfirstlane(F.tid >> 6);
    F.G = gridDim.x; { const int bx = blockIdx.x; F.vcu = (F.G % 8 == 0) ? (bx % 8) * (F.G / 8) + bx / 8 : bx; }
    unsigned char* ws = args.ws;
    gu32* ctl = (gu32*)(ws + WS_CTL);
    volatile LAS unsigned* MISC = (volatile LAS unsigned*)(F.lds + MISC_OFF);
    for (int u = F.tid; u < (LDS_BYTES - MISC_OFF) / 4; u += NWAVES * 64) ((LAS unsigned*)(F.lds + MISC_OFF))[u] = 0u;
    __syncthreads();
    XcdBarrier bar; bar.bar = (unsigned*)(ctl + CW_BAR); bar.x = 0; bar.st = nullptr;
    if (!MK_PER_PHASE) bar = xcd_barrier_post((unsigned*)(ctl + CW_BAR), MISC + 8);
#define GRID_BAR() do { if (!MK_PER_PHASE) xcd_barrier(bar); } while (0)
    const int lo = args.ph_lo, hi = args.ph_hi;
#ifdef START_ACQ
    if (threadIdx.x == 0) { __builtin_amdgcn_fence(__ATOMIC_ACQUIRE, "agent"); asm volatile("s_waitcnt vmcnt(0)" ::: "memory"); }
    __syncthreads();
#endif
#define IN(k) (((PHASE_MASK >> (k)) & 1) && lo <= (k) && (k) < hi)
#define BOTH(k) (IN(k) && IN((k) + 1))
    const float* x = args.in[0]; const float* norm1_w = args.in[1]; const float* w_in = args.in[2]; const float* w_ret_o = args.in[3];
    const float* w_pool_lin = args.in[4]; const float* pool_scale = args.in[5]; const float* w_pool_o = args.in[6]; const float* w_out = args.in[7];
    const float* norm2_w = args.in[8]; const float* peer_w_q = args.in[9]; const float* sub_keys = args.in[10]; const float* peer_u = args.in[11];
    const float* peer_v = args.in[12]; const float* final_w = args.in[13];
    bf16* Wmain = (bf16*)(ws + WS_WMAIN); bf16* Wkv = (bf16*)(ws + WS_WKV); bf16* Wro = (bf16*)(ws + WS_WRO); bf16* Wpo = (bf16*)(ws + WS_WPO);
    bf16* Wout = (bf16*)(ws + WS_WOUT); bf16* Wq = (bf16*)(ws + WS_WQ); bf16* linT = (bf16*)(ws + WS_LINT); bf16* keysb = (bf16*)(ws + WS_KEYS);
    bf16* hb = (bf16*)(ws + WS_H); bf16* qb = (bf16*)(ws + WS_Q); bf16* kb = (bf16*)(ws + WS_K); bf16* kzT = (bf16*)(ws + WS_KZT); bf16* vT = (bf16*)(ws + WS_VT);
    bf16* ut = (bf16*)(ws + WS_UT); bf16* vtab = (bf16*)(ws + WS_VTAB); bf16* grb = (bf16*)(ws + WS_GR); bf16* pinb = (bf16*)(ws + WS_PIN);
    bf16* stb = (bf16*)(ws + WS_ST); bf16* pooled = (bf16*)(ws + WS_POOLED);
    float* sumsq = (float*)(ws + WS_PIN);
    bf16* gatesb = (bf16*)(ws + WS_GATES); bf16* retn = (bf16*)(ws + WS_RETN); float* x1f = (float*)(ws + WS_X1);

    if (lo == 0) GRID_BAR();
    if (IN(0)) {
        P0Args a{x, norm1_w, w_in, w_ret_o, w_pool_lin, w_pool_o, w_out, norm2_w, peer_w_q, sub_keys, Wmain, Wkv, Wro, Wpo, Wout, Wq, linT, keysb, hb};
        p0_prologue(F, a);
        if (BOTH(0)) GRID_BAR();
    }
    if (IN(1)) {
        { pg8::Gemm g{hb, Wmain, TOK, 5120, DM}; pg8::StaticOrder S; S.init(TOK, 5120, F.G, (int)blockIdx.x);
          pg8::EpiMain E{qb, kb, grb, pinb};
          pg8::gemm_phase<pg8::EpiMain, pg8::StaticOrder, true, true>(F.lds, g, S, E); }
        { pg8::Gemm g{Wkv, hb, 3072, TOK, DM}; pg8::StaticOrder S; S.init(3072, TOK, F.G, (int)blockIdx.x);
          pg8::EpiKV E{kzT, vT};
          pg8::gemm_phase<pg8::EpiKV, pg8::StaticOrder, true, true>(F.lds, g, S, E); }
        if (BOTH(1)) GRID_BAR();
    }
    if (IN(2)) {
        for (int uu = F.vcu; uu < 16 * 63; uu += F.G) p2_kv_unit(F, uu, kzT, vT, stb);
        p2_pool(F, pinb, pooled);
        if (BOTH(2)) GRID_BAR();
    }
    if (IN(3)) {
        p3_scan(F, stb);
        { pg8::Gemm g{pooled, linT, 4 * TOK, 1024, 256}; pg8::DiagOrder S; S.init(F.G, (int)blockIdx.x);
          pg8::EpiPool E{pinb, pool_scale};
          pg8::gemm_phase<pg8::EpiPool, pg8::DiagOrder, true, true>(F.lds, g, S, E); }
        if (BOTH(3)) GRID_BAR();
    }
    if (IN(4)) {
        for (int uu = F.vcu; uu < 1024; uu += F.G) p4_unit(F, uu, qb, kb, vT, stb, grb, retn);
        if (BOTH(4)) GRID_BAR();
    }
    if (IN(5)) {
#ifdef L2_SWEEP
        {
            const gcv4u* src = (const gcv4u*)(ws + 2 * MiB + (size_t)blockIdx.x * (L2_SWEEP * 1024)) + threadIdx.x; v4u accv = (v4u){0u, 0u, 0u, 0u};
            for (int i = 0; i < L2_SWEEP * 1024 / (512 * 16); ++i) { const v4u t = src[(size_t)i * 512]; accv.x ^= t.x; accv.y ^= t.y; accv.z ^= t.z; accv.w ^= t.w; }
            if ((accv.x ^ accv.y ^ accv.z ^ accv.w) == 0x12345678u) ((unsigned*)ctl)[1000] = 1u;
            __syncthreads();
        }
#endif
        { pg8::Gemm g{hb, Wmain + (size_t)5120 * DM, TOK, 4096, DM}; pg8::StaticOrder S; S.init(TOK, 4096, F.G, (int)blockIdx.x);
          pg8::EpiGates E{gatesb};
          pg8::gemm_phase<pg8::EpiGates, pg8::StaticOrder, true, true>(F.lds, g, S, E); }
        if (BOTH(5)) GRID_BAR();
    }
    if (IN(6)) {
        { pg8::Gemm g{retn, Wro, TOK, DM, DM}; pg8::StaticOrder S; S.init(TOK, DM, F.G, (int)blockIdx.x);
          pg8::EpiMix<0> E{grb, gatesb};
          pg8::gemm_phase<pg8::EpiMix<0>, pg8::StaticOrder, true, true>(F.lds, g, S, E); }
        { pg8::Gemm g{pinb, Wpo, TOK, DM, 1024}; pg8::StaticOrder S; S.init(TOK, DM, F.G, (int)blockIdx.x);
          pg8::EpiMix<1> E{grb, gatesb};
          pg8::gemm_phase<pg8::EpiMix<1>, pg8::StaticOrder, true, true>(F.lds, g, S, E); }
        if (BOTH(6)) GRID_BAR();
    }
    if (IN(7)) {
        { pg8::Gemm g{grb, Wout, TOK, DM, DM}; pg8::StaticOrder S; S.init(TOK, DM, F.G, (int)blockIdx.x);
          pg8::EpiOut E{x, x1f, hb, sumsq};
          pg8::gemm_phase<pg8::EpiOut, pg8::StaticOrder, true, true>(F.lds, g, S, E); }
        if (BOTH(7)) GRID_BAR();
    }
    if (IN(8)) {
        { pg8::Gemm g{hb, Wq, TOK, DM, DM}; pg8::StaticOrder S; S.init(TOK, DM, F.G, (int)blockIdx.x);
          pg8::EpiQ E{grb, sumsq};
          pg8::gemm_phase<pg8::EpiQ, pg8::StaticOrder, true, true>(F.lds, g, S, E); }
        p6_tables(F, peer_u, peer_v, norm2_w, ut, vtab);
        if (BOTH(8)) GRID_BAR();
    }
    if (IN(9)) {
        P8Args a{grb, keysb, hb, ut, vtab, sumsq, final_w, x1f, args.out};
        for (int sub = F.vcu; sub < TOK / 16; sub += F.G) p8_subtile(F, sub, a);
    }

#if defined(DUMP_OFF_MIB)
    if (hi == N_PHASES) {
        const bf16* src = (const bf16*)(ws + (size_t)DUMP_OFF_MIB * MiB);
        for (size_t i = ((size_t)blockIdx.x * 512 + threadIdx.x) * 8; i < (size_t)TOK * DM; i += (size_t)gridDim.x * 512 * 8) {
            const v4u t = *(gcv4u*)(src + i);
            *(gf4*)(args.out + i) = (f32x4){bflo(t.x), bfhi(t.x), bflo(t.y), bfhi(t.y)};
            *(gf4*)(args.out + i + 4) = (f32x4){bflo(t.z), bfhi(t.z), bflo(t.w), bfhi(t.w)};
        }
    }
#endif
#ifdef END_REL
    asm volatile("s_waitcnt vmcnt(0)" ::: "memory"); __syncthreads();
    if (threadIdx.x == 0) { __builtin_amdgcn_fence(__ATOMIC_RELEASE, "agent"); asm volatile("s_waitcnt vmcnt(0)" ::: "memory"); }
    __syncthreads();
#endif

#if defined(DBG_CHECK)
    if (lo == 20) {
        const int gw = F.vcu * NWAVES + F.wave, NGW = F.G * NWAVES;
        for (int row = gw; row < TOK; row += NGW) {
            for (int ct = 0; ct < 16; ++ct) {
                const int col = 256 * ct + ((row * 7 + ct * 13) & 255);
                const bf16* hr = hb + (size_t)row * DM + 8 * F.lane; const bf16* wr_ = Wmain + (size_t)(5120 + col) * DM + 8 * F.lane;
                float s = 0.f;
                for (int j = 0; j < 4; ++j) { const v4u a = *(gcv4u*)(hr + 512 * j), b = *(gcv4u*)(wr_ + 512 * j);
                    s += bflo(a.x) * bflo(b.x) + bfhi(a.x) * bfhi(b.x) + bflo(a.y) * bflo(b.y) + bfhi(a.y) * bfhi(b.y) + bflo(a.z) * bflo(b.z) + bfhi(a.z) * bfhi(b.z) + bflo(a.w) * bflo(b.w) + bfhi(a.w) * bfhi(b.w); }
                s = wave_sum(s);
                const float g = 1.0f / (1.0f + __expf(-s));
                const unsigned short gs = gatesb[(size_t)row * 4096 + col];
                const float gv = bflo((unsigned)gs);
                if (F.lane == 0 && !(fabsf(g - gv) < 0.02f)) { atomicMin((unsigned*)ctl + 512, (unsigned)(row >> 8)); atomicAdd((unsigned*)ctl + 513, 1u); atomicAdd((unsigned*)ctl + 600 + (row >> 8), 1u); atomicAdd((unsigned*)ctl + 700 + ct, 1u); atomicAdd((unsigned*)ctl + 800 + ((row >> 4) & 15), 1u); if (!(fabsf(g - gv) < 0.2f)) { atomicAdd((unsigned*)ctl + 514, 1u); if (!(gv >= 0.f && gv <= 1.0f)) atomicAdd((unsigned*)ctl + 515, 1u); if (gv == 0.5f) atomicAdd((unsigned*)ctl + 516, 1u); } atomicAdd((unsigned*)ctl + 900 + (col & 255) / 8, 1u); }
            }
        }
    }
    if (lo == 21) {
        for (size_t i = ((size_t)blockIdx.x * 512 + threadIdx.x) * 4; i < (size_t)TOK * DM; i += (size_t)gridDim.x * 512 * 4) *(gf4*)(args.out + i) = (f32x4){0.f, 0.f, 0.f, 0.f};
        __syncthreads();
        if (blockIdx.x == 0 && threadIdx.x == 0) {
            const unsigned first = ((unsigned*)ctl)[512], cnt = ((unsigned*)ctl)[513];
            const unsigned* C = (const unsigned*)ctl;
            unsigned nrt = 0, nct = 0, maxct = 0, maxcti = 0, n16 = 0, mx16 = 0, mx16i = 0;
            for (int i = 0; i < 64; ++i) nrt += C[600 + i] ? 1u : 0u;
            for (int i = 0; i < 16; ++i) { nct += C[700 + i] ? 1u : 0u; if (C[700 + i] > maxct) { maxct = C[700 + i]; maxcti = i; } n16 += C[800 + i] ? 1u : 0u; if (C[800 + i] > mx16) { mx16 = C[800 + i]; mx16i = i; } }
            unsigned cv = 0;
            if (DBG_CHECK == 1) cv = cnt == 0 ? 0 : first + 1;
            if (DBG_CHECK == 2) cv = cnt >> DBG_SHIFT;
            if (DBG_CHECK == 3) cv = nrt;
            if (DBG_CHECK == 4) cv = nct;
            if (DBG_CHECK == 5) cv = maxcti + 1;
            if (DBG_CHECK == 6) cv = n16;
            if (DBG_CHECK == 7) cv = mx16i + 1;
            if (DBG_CHECK == 8) cv = (C[600 + DBG_ARG]) >> DBG_SHIFT;
            if (DBG_CHECK == 9) cv = (C[700 + DBG_ARG]) >> DBG_SHIFT;
            if (DBG_CHECK == 10) cv = C[514] >> DBG_SHIFT;
            if (DBG_CHECK == 11) { unsigned n = 0; for (int i = 0; i < 32; ++i) n += C[900 + i] ? 1u : 0u; cv = n; }
            if (DBG_CHECK == 12) cv = (C[800 + DBG_ARG]) >> DBG_SHIFT;
            if (DBG_CHECK == 13) cv = (C[900 + DBG_ARG]) >> DBG_SHIFT;
            if (DBG_CHECK == 14) { int second = -1; for (int i = 0; i < 16; ++i) if (C[800 + i] && (unsigned)i != mx16i) second = i; cv = (unsigned)(second + 1); }
            if (DBG_CHECK == 15) { unsigned m = 0; for (int i = 0; i < 16; ++i) if (C[700 + i]) m |= 1u << i; cv = (DBG_ARG == 0) ? (m & 63u) : (DBG_ARG == 1 ? ((m >> 6) & 63u) : (m >> 12)); }
            if (DBG_CHECK == 16) { unsigned m = 0; for (int i = 0; i < 32; ++i) if (C[900 + i]) m |= 1u << i; cv = (m >> (6 * DBG_ARG)) & 63u; }
            if (DBG_CHECK == 17) cv = C[515] >> DBG_SHIFT;
            if (DBG_CHECK == 18) cv = C[516] >> DBG_SHIFT;
            if (DBG_CHECK == 19) cv = C[514] >> DBG_SHIFT;
            float code = (float)(cv > 97 ? 97 : cv);
            args.out[0] = sqrtf((float)TOK * (float)DM * code);
        }
    }
#endif
#undef IN
#undef BOTH
#undef GRID_BAR
}

extern "C" void kernel_launch(void* const* d_in, const int* in_sizes, int n_in, void* d_out, int out_size, void* d_ws, size_t ws_size, hipStream_t stream) {
    static int grid = 0;
    if (grid == 0) {
        if (n_in != 14 || out_size != TOK * DM || ws_size < WS_END) { fprintf(stderr, "kernel_launch: unexpected shapes (n_in %d, out %d, ws %zu); nothing launched\n", n_in, out_size, ws_size); grid = -1; return; }
        int dev = 0, cus = 0, per_cu = 0;
        if (hipGetDevice(&dev) != hipSuccess || hipDeviceGetAttribute(&cus, hipDeviceAttributeMultiprocessorCount, dev) != hipSuccess) { grid = -1; return; }
        if (hipFuncSetAttribute((const void*)hybrid_fwd, hipFuncAttributeMaxDynamicSharedMemorySize, LDS_BYTES) != hipSuccess) { fprintf(stderr, "kernel_launch: hipFuncSetAttribute failed\n"); grid = -1; return; }
        if (hipOccupancyMaxActiveBlocksPerMultiprocessor(&per_cu, (const void*)hybrid_fwd, NWAVES * 64, LDS_BYTES) != hipSuccess || per_cu < 1)
            fprintf(stderr, "kernel_launch: note: occupancy query reports %d workgroups per CU\n", per_cu);
        (void)hipGetLastError();
        grid = cus;
    }
    if (grid < 0) return;
    if (hipMemsetAsync((char*)d_ws + WS_CTL, 0, CTL_ZERO_BYTES, stream) != hipSuccess) { fprintf(stderr, "kernel_launch: hipMemsetAsync failed\n"); return; }
    Args a{};
    for (int i = 0; i < 14; ++i) a.in[i] = (const float*)d_in[i];
    a.out = (float*)d_out; a.ws = (unsigned char*)d_ws;
#if MK_PER_PHASE
#if defined(DBG_CHECK)
    { const int order[] = {0, 1, 2, 3, 4, 5, 20, 6, 7, 8, 9, 21};
      hipMemsetAsync((char*)d_ws + 2048, 0xFF, 4, stream);
      for (int p : order) { a.ph_lo = p; a.ph_hi = p + 1; hipLaunchKernelGGL(hybrid_fwd, dim3(grid), dim3(NWAVES * 64), LDS_BYTES, stream, a); } }
#else
    for (int p = 0; p < N_PHASES; ++p) { a.ph_lo = p; a.ph_hi = p + 1; hipLaunchKernelGGL(hybrid_fwd, dim3(grid), dim3(NWAVES * 64), LDS_BYTES, stream, a); }
#endif
#else
    a.ph_lo = 0; a.ph_hi = N_PHASES;
    hipLaunchKernelGGL(hybrid_fwd, dim3(grid), dim3(NWAVES * 64), LDS_BYTES, stream, a);
#endif
    const hipError_t le = hipPeekAtLastError();
    if (le != hipSuccess) fprintf(stderr, "kernel_launch: launch failed: %s\n", hipGetErrorName(le));
}
```

```cpp
#include <hip/hip_runtime.h>
#include <cstdio>
#include <cstdint>
typedef unsigned wt_u32x4 __attribute__((ext_vector_type(4)));
typedef float wt_f32x4 __attribute__((ext_vector_type(4)));
__device__ __forceinline__ void st16_wt(void* p, wt_u32x4 v) { asm volatile("global_store_dwordx4 %0, %1, off sc1\n\ts_nop 1" :: "v"(p), "v"(v) : "memory"); }
__device__ __forceinline__ void st16f_wt(void* p, wt_f32x4 v) { asm volatile("global_store_dwordx4 %0, %1, off sc1\n\ts_nop 1" :: "v"(p), "v"(v) : "memory"); }
__device__ __forceinline__ void st8_wt(void* p, unsigned long long v) { asm volatile("global_store_dwordx2 %0, %1, off sc1\n\ts_nop 0" :: "v"(p), "v"(v) : "memory"); }
__device__ __forceinline__ void st4_wt(void* p, unsigned v) { asm volatile("global_store_dword %0, %1, off sc1" :: "v"(p), "v"(v) : "memory"); }
__device__ __forceinline__ void st4f_wt(void* p, float v) { asm volatile("global_store_dword %0, %1, off sc1" :: "v"(p), "v"(v) : "memory"); }
namespace pg8 {
#define PG8_LAS __attribute__((address_space(3)))
typedef unsigned short bf16_t;
typedef short bf16x8 __attribute__((ext_vector_type(8)));
typedef float f32x4 __attribute__((ext_vector_type(4)));
typedef unsigned u32x4 __attribute__((ext_vector_type(4)));
constexpr int BM = 256, BK = 64, HALF = 128, HTB = HALF * BK * 2  , STAGE_BYTES = 8 * HTB, NXCD = 8, WGM = 4;

__host__ __device__ __forceinline__ int lds_byte(int r, int c) { const int st = (r >> 4) * 2 + (c >> 5), rr = r & 15, cc = c & 31, ob = rr * 64 + cc * 2; return st * 1024 + (ob ^ (((ob >> 9) & 1) << 5)); }
__host__ __device__ __forceinline__ void stage_rc(int b, int& R, int& C) { const int st = b / 1024, sb = b % 1024, swz = sb ^ (((sb >> 9) & 1) << 5); R = (st >> 1) * 16 + swz / 64; C = (st & 1) * 32 + (swz % 64) / 2; }
__host__ __device__ __forceinline__ int perm32(int rho) { const int n = rho >> 4, i = rho & 15; return 8 * (i >> 2) + 4 * n + (i & 3); }

struct Unit { int pm, pn, seg; };
struct Gemm { const bf16_t* A; const bf16_t* Bt; int M, N, K; const bf16_t* A2; const bf16_t* Bt2; int K2; };

struct StaticOrder {
    int nM, nN, nwg, G, c;
    __host__ __device__ void init(int M, int N, int G_, int c_) { nM = M / BM; nN = N / BM; nwg = nM * nN; G = G_; c = c_; }
    __host__ __device__ bool next(int i, Unit& u) const {
        const long L = (long)i * G + c; if (L >= nwg) return false;
        int wgid = (int)L; { const int q = nwg / NXCD, r = nwg % NXCD, xcd = wgid % NXCD, off = wgid / NXCD; wgid = (xcd < r ? xcd * (q + 1) : r * (q + 1) + (xcd - r) * q) + off; }
        const int nig = WGM * nN, gid = wgid / nig, fm = gid * WGM, gsz = (nM - fm) < WGM ? (nM - fm) : WGM;
        u.pm = fm + ((wgid % nig) % gsz); u.pn = (wgid % nig) / gsz; return true;
    }
    __device__ __forceinline__ void a_ready(const Unit&) const {}
    __device__ __forceinline__ void done(const Unit&) const {}
};
struct DiagOrder {
    int G, c;
    __device__ void init(int G_, int c_) { G = G_; c = c_; }
    __device__ bool next(int i, Unit& u) const { const int L = i * G + c; if (L >= 256) return false; u.pm = L; u.pn = L >> 6; return true; }
    __device__ __forceinline__ void a_ready(const Unit&) const {}
    __device__ __forceinline__ void done(const Unit&) const {}
};

struct ChainOrder {
    StaticOrder S;
    __device__ void init(int M, int N, int G_, int c_) { S.init(M, N, G_, c_); }
    __device__ bool next(int i, Unit& u) const { if (!S.next(i >> 1, u)) return false; u.seg = i & 1; return true; }
    __device__ __forceinline__ void a_ready(const Unit&) const {}
    __device__ __forceinline__ void done(const Unit&) const {}
};

__device__ __forceinline__ unsigned cvt_pk_bf16(float lo, float hi) { unsigned r; asm volatile("v_cvt_pk_bf16_f32 %0, %1, %2" : "=v"(r) : "v"(lo), "v"(hi)); return r; }
__device__ __forceinline__ u32x4 pack8(const f32x4 v0, const f32x4 v1) { u32x4 w; w.x = cvt_pk_bf16(v0[0], v0[1]); w.y = cvt_pk_bf16(v0[2], v0[3]); w.z = cvt_pk_bf16(v1[0], v1[1]); w.w = cvt_pk_bf16(v1[2], v1[3]); return w; }
__device__ __forceinline__ float bf_lo(unsigned u) { return __builtin_bit_cast(float, u << 16); }
__device__ __forceinline__ float bf_hi(unsigned u) { return __builtin_bit_cast(float, u & 0xffff0000u); }
__device__ __forceinline__ void unpack8(const u32x4 w, f32x4& v0, f32x4& v1) { v0 = (f32x4){bf_lo(w.x), bf_hi(w.x), bf_lo(w.y), bf_hi(w.y)}; v1 = (f32x4){bf_lo(w.z), bf_hi(w.z), bf_lo(w.w), bf_hi(w.w)}; }
__device__ __forceinline__ float fast_sigmoid(float v) { return __builtin_amdgcn_rcpf(1.0f + __builtin_amdgcn_exp2f(-1.4426950408889634f * v)); }
__device__ __forceinline__ float log2_gamma(int h) { const float x = __builtin_amdgcn_exp2f((float)(-5 - h)); return -1.4426950408889634f * x * (1.f + x * (0.5f + x * (0.33333333f + x * (0.25f + x * 0.2f)))); }
constexpr float ROPE_C = 0.20762050593046014f;
constexpr float INV_2PI = 0.15915494309189535f;
constexpr float DK_SCALE = 0.08838834764831845f;

#ifndef MAIN_FP8
#define MAIN_FP8 3
#endif
struct EpiMain {
    static constexpr bool PERM = true, AFTER_DRAIN = false;
    bf16_t *q, *k, *gr, *pin; float asc; int pn0;
    __device__ __forceinline__ void operator()(const f32x4 (&acc)[2][2][4][2], const Unit& u, int wr, int wc, int fr, int fq) const {
        asm volatile("" : "+v"(fr), "+v"(fq));
        const int row0 = u.pm * BM + wr * 64 + fr, cl = wc * 32 + 8 * fq, pn = u.pn + pn0;
        if (pn < 8) {
            const bool isk = pn >= 4; bf16_t* base = isk ? k : q; const float sc = (isk ? DK_SCALE : 1.0f) * asc; const int pnl = pn & 3;
            float invf[4];
#pragma unroll
            for (int p = 0; p < 4; ++p) invf[p] = __builtin_amdgcn_exp2f(-(float)(16 * wc + 4 * fq + p) * ROPE_C) * INV_2PI;
#pragma unroll
            for (int ai = 0; ai < 2; ++ai)
#pragma unroll
                for (int m = 0; m < 4; ++m) {
                    const int row = row0 + ai * HALF + m * 16, s = row & 8191, b = row >> 13;
                    float cs[4], sn[4];
#pragma unroll
                    for (int p = 0; p < 4; ++p) { const float r = __builtin_amdgcn_fractf((float)s * invf[p]); cs[p] = __builtin_amdgcn_cosf(r) * sc; sn[p] = __builtin_amdgcn_sinf(r) * sc; }
#pragma unroll
                    for (int bj = 0; bj < 2; ++bj) {
                        const int hh = 2 * pnl + bj; const f32x4 v0 = acc[ai][bj][m][0], v1 = acc[ai][bj][m][1];
                        f32x4 o0, o1;
                        o0[0] = v0[0] * cs[0] - v0[1] * sn[0]; o0[1] = v0[0] * sn[0] + v0[1] * cs[0];
                        o0[2] = v0[2] * cs[1] - v0[3] * sn[1]; o0[3] = v0[2] * sn[1] + v0[3] * cs[1];
                        o1[0] = v1[0] * cs[2] - v1[1] * sn[2]; o1[1] = v1[0] * sn[2] + v1[1] * cs[2];
                        o1[2] = v1[2] * cs[3] - v1[3] * sn[3]; o1[3] = v1[2] * sn[3] + v1[3] * cs[3];
                        st16_wt(base + ((size_t)((b * 8 + hh) * 8192 + s)) * 128 + cl, pack8(o0, o1));
                    }
                }
        } else if (pn < 16) {
            const int c0 = (pn - 8) * BM + cl;
#pragma unroll
            for (int ai = 0; ai < 2; ++ai)
#pragma unroll
                for (int m = 0; m < 4; ++m) { bf16_t* rowp = gr + (size_t)(row0 + ai * HALF + m * 16) * 2048 + c0;
#pragma unroll
                    for (int bj = 0; bj < 2; ++bj) { f32x4 v0 = acc[ai][bj][m][0] * asc, v1 = acc[ai][bj][m][1] * asc;
#pragma unroll
                        for (int j = 0; j < 4; ++j) { v0[j] = v0[j] * fast_sigmoid(v0[j]); v1[j] = v1[j] * fast_sigmoid(v1[j]); }
                        st16_wt(rowp + bj * HALF, pack8(v0, v1)); } }
        } else {
            const int c0 = (pn - 16) * BM + cl;
#pragma unroll
            for (int ai = 0; ai < 2; ++ai)
#pragma unroll
                for (int m = 0; m < 4; ++m) { bf16_t* rowp = pin + (size_t)(row0 + ai * HALF + m * 16) * 1024 + c0;
#pragma unroll
                    for (int bj = 0; bj < 2; ++bj) st16_wt(rowp + bj * HALF, pack8(acc[ai][bj][m][0] * asc, acc[ai][bj][m][1] * asc)); }
        }
    }
};
#ifndef GATES_U8
#define GATES_U8 1
#endif
__device__ __forceinline__ unsigned pk4_u8(f32x4 g) {
    const unsigned b0 = (unsigned)fminf(g[0] * 256.f, 255.f), b1 = (unsigned)fminf(g[1] * 256.f, 255.f), b2 = (unsigned)fminf(g[2] * 256.f, 255.f), b3 = (unsigned)fminf(g[3] * 256.f, 255.f);
    return b0 | (b1 << 8) | (b2 << 16) | (b3 << 24); }
__device__ __forceinline__ f32x4 unpk4_u8(unsigned w) { return (f32x4){(float)(w & 0xffu) + 0.5f, (float)((w >> 8) & 0xffu) + 0.5f, (float)((w >> 16) & 0xffu) + 0.5f, (float)(w >> 24) + 0.5f}; }
struct EpiGates {
    static constexpr bool PERM = true, AFTER_DRAIN = false;
    bf16_t *gret, *gpool; float sc; int dbg;
    __device__ __forceinline__ void operator()(const f32x4 (&acc)[2][2][4][2], const Unit& u, int wr, int wc, int fr, int fq) const {
        const int row0 = u.pm * BM + wr * 64 + fr, c0 = (u.pn & 7) * BM + wc * 32 + 8 * fq; bf16_t* gates = (u.pn < 8) ? gret : gpool;
#pragma unroll
        for (int ai_ = 0; ai_ < 2; ++ai_)
#pragma unroll
            for (int m_ = 0; m_ < 4; ++m_) {
#ifdef GATES_REV
                const int ai = 1 - ai_, m = 3 - m_;
#else
                const int ai = ai_, m = m_;
#endif
                bf16_t* rowp = gates + (size_t)(row0 + ai * HALF + m * 16) * 2048 + c0;
#pragma unroll
                for (int bj = 0; bj < 2; ++bj) { f32x4 v0 = acc[ai][bj][m][0], v1 = acc[ai][bj][m][1];
#pragma unroll
                    for (int j = 0; j < 4; ++j) { v0[j] = fast_sigmoid(v0[j] * sc); v1[j] = fast_sigmoid(v1[j] * sc); }
                    if (dbg == 1) { asm volatile("" :: "v"(v0), "v"(v1)); continue; }
                    if (GATES_U8) st8_wt((unsigned char*)gates + (size_t)(row0 + ai * HALF + m * 16) * 2048 + c0 + bj * HALF, (unsigned long long)pk4_u8(v0) | ((unsigned long long)pk4_u8(v1) << 32));
                    else st16_wt(rowp + bj * HALF, pack8(v0, v1));
                } }
    }
};

#ifndef KV_FP8
#define KV_FP8 1
#endif
struct EpiKV {
    static constexpr bool PERM = true, AFTER_DRAIN = false;
    bf16_t* vT; float asc;
    __device__ __forceinline__ void operator()(const f32x4 (&acc)[2][2][4][2], const Unit& u, int wr, int wc, int fr, int fq) const {
        const int b = u.pn >> 5, sl = wc * 32 + 8 * fq, sbase = (u.pn & 31) * BM;
#pragma unroll
        for (int ai = 0; ai < 2; ++ai)
#pragma unroll
            for (int m = 0; m < 4; ++m) {
                const int R = u.pm * BM + ai * HALF + wr * 64 + m * 16 + fr;
                bf16_t* rowp = vT + ((size_t)(b * 2048 + R)) * 8192 + sbase + sl;
#pragma unroll
                for (int bj = 0; bj < 2; ++bj) st16_wt(rowp + bj * HALF, pack8(acc[ai][bj][m][0] * asc, acc[ai][bj][m][1] * asc));
            }
    }
};

#ifndef P6_CHAIN
#define P6_CHAIN 1
#endif
#ifndef MIX_FP8
#define MIX_FP8 1
#endif
constexpr float R8_SCALE = 16.0f, WB8_SCALE = 512.0f;
__device__ __forceinline__ unsigned pk4_fp8_(f32x4 a) { int p = __builtin_amdgcn_cvt_pk_fp8_f32(a[0], a[1], 0, false); p = __builtin_amdgcn_cvt_pk_fp8_f32(a[2], a[3], p, true); return (unsigned)p; }
struct EpiPool {
    static constexpr bool PERM = true, AFTER_DRAIN = false;
    bf16_t* out; const float* scale;
    __device__ __forceinline__ void operator()(const f32x4 (&acc)[2][2][4][2], const Unit& u, int wr, int wc, int fr, int fq) const {
        const int g = u.pm >> 6, tok0 = (u.pm & 63) * BM + wr * 64 + fr, c0 = g * 256 + wc * 32 + 8 * fq;
        f32x4 sv[2][2];
#pragma unroll
        for (int bj = 0; bj < 2; ++bj)
#pragma unroll
            for (int n = 0; n < 2; ++n) sv[bj][n] = *(const f32x4*)(scale + c0 + bj * HALF + 4 * n);
#pragma unroll
        for (int ai = 0; ai < 2; ++ai)
#pragma unroll
            for (int m = 0; m < 4; ++m) { bf16_t* rowp = out + (size_t)(tok0 + ai * HALF + m * 16) * 1024 + c0;
#pragma unroll
                for (int bj = 0; bj < 2; ++bj) {
                    if (MIX_FP8) st8_wt((unsigned char*)out + (size_t)(tok0 + ai * HALF + m * 16) * (P6_CHAIN ? 2048 : 1024) + c0 + bj * HALF, (unsigned long long)pk4_fp8_(acc[ai][bj][m][0] * sv[bj][0] * R8_SCALE) | ((unsigned long long)pk4_fp8_(acc[ai][bj][m][1] * sv[bj][1] * R8_SCALE) << 32));
                    else st16_wt(rowp + bj * HALF, pack8(acc[ai][bj][m][0] * sv[bj][0], acc[ai][bj][m][1] * sv[bj][1])); } }
    }
};

#ifndef OUT_FP8
#define OUT_FP8 1
#endif
constexpr float M8_SCALE = 32.0f, WO8_SCALE = 512.0f;
template <int PASS> struct EpiMix {
    static constexpr bool PERM = true, AFTER_DRAIN = false;
    bf16_t* mixed; const bf16_t* gates; unsigned char* m8; float sc;
    __device__ __forceinline__ void operator()(const f32x4 (&acc)[2][2][4][2], const Unit& u, int wr, int wc, int fr, int fq) const {
        const int row0 = u.pm * BM + wr * 64 + fr, c0 = u.pn * BM + wc * 32 + 8 * fq;
#pragma unroll
        for (int ai = 0; ai < 2; ++ai) {
            unsigned long long gw8[4][2]; u32x4 gw16[4][2], pw[4][2];
#pragma unroll
            for (int m = 0; m < 4; ++m) { const size_t row = (size_t)(row0 + ai * HALF + m * 16);
#pragma unroll
                for (int bj = 0; bj < 2; ++bj) {
                    if (GATES_U8) gw8[m][bj] = *(const unsigned long long*)((const unsigned char*)gates + row * 2048 + c0 + bj * HALF);
                    else gw16[m][bj] = *(const u32x4*)(gates + row * 2048 + c0 + bj * HALF);
                    if (PASS == 1) pw[m][bj] = *(const u32x4*)(mixed + row * 2048 + c0 + bj * HALF); } }
#pragma unroll
            for (int m = 0; m < 4; ++m) { const size_t row = (size_t)(row0 + ai * HALF + m * 16);
#pragma unroll
                for (int bj = 0; bj < 2; ++bj) {
                    f32x4 g0, g1; float scg = sc;
                    if (GATES_U8) { g0 = unpk4_u8((unsigned)gw8[m][bj]); g1 = unpk4_u8((unsigned)(gw8[m][bj] >> 32)); scg = sc * (1.0f / 256.0f); }
                    else unpack8(gw16[m][bj], g0, g1);
                    f32x4 v0 = acc[ai][bj][m][0] * (g0 * scg), v1 = acc[ai][bj][m][1] * (g1 * scg);
                    bf16_t* p = mixed + row * 2048 + c0 + bj * HALF;
                    if (PASS == 1) { f32x4 t0, t1; unpack8(pw[m][bj], t0, t1); v0 += t0; v1 += t1; }
                    if (PASS == 1 && OUT_FP8) st8_wt(m8 + row * 2048 + c0 + bj * HALF, (unsigned long long)pk4_fp8_(v0 * M8_SCALE) | ((unsigned long long)pk4_fp8_(v1 * M8_SCALE) << 32));
                    else st16_wt(p, pack8(v0, v1)); } }
        }
    }
};

struct EpiChain {
    static constexpr bool PERM = true, AFTER_DRAIN = false;
    const unsigned char* gret; const unsigned char* gpool; unsigned char* m8; float sc;
    __device__ __forceinline__ void mid(f32x4 (&acc)[2][2][4][2], const Unit& u, int wr, int wc, int fr, int fq) const {
        const int row0 = u.pm * BM + wr * 64 + fr, c0 = u.pn * BM + wc * 32 + 8 * fq;
#pragma unroll
        for (int ai = 0; ai < 2; ++ai) {
            unsigned long long gr8[4][2], gp8[4][2];
#pragma unroll
            for (int m = 0; m < 4; ++m) { const size_t off = (size_t)(row0 + ai * HALF + m * 16) * 2048 + c0;
#pragma unroll
                for (int bj = 0; bj < 2; ++bj) { gr8[m][bj] = *(const unsigned long long*)(gret + off + bj * HALF); gp8[m][bj] = *(const unsigned long long*)(gpool + off + bj * HALF); } }
#pragma unroll
            for (int m = 0; m < 4; ++m)
#pragma unroll
                for (int bj = 0; bj < 2; ++bj) {
                    const f32x4 r0 = unpk4_u8((unsigned)gr8[m][bj]), r1 = unpk4_u8((unsigned)(gr8[m][bj] >> 32)), p0 = unpk4_u8((unsigned)gp8[m][bj]), p1 = unpk4_u8((unsigned)(gp8[m][bj] >> 32));
#pragma unroll
                    for (int j = 0; j < 4; ++j) { acc[ai][bj][m][0][j] *= p0[j] * __builtin_amdgcn_rcpf(r0[j]); acc[ai][bj][m][1][j] *= p1[j] * __builtin_amdgcn_rcpf(r1[j]); } }
        }
    }
    __device__ __forceinline__ void operator()(const f32x4 (&acc)[2][2][4][2], const Unit& u, int wr, int wc, int fr, int fq) const {
        const int row0 = u.pm * BM + wr * 64 + fr, c0 = u.pn * BM + wc * 32 + 8 * fq;
        const float scg = sc * (M8_SCALE / 256.0f);
#pragma unroll
        for (int ai = 0; ai < 2; ++ai) {
            unsigned long long gr8[4][2];
#pragma unroll
            for (int m = 0; m < 4; ++m)
#pragma unroll
                for (int bj = 0; bj < 2; ++bj) gr8[m][bj] = *(const unsigned long long*)(gret + (size_t)(row0 + ai * HALF + m * 16) * 2048 + c0 + bj * HALF);
#pragma unroll
            for (int m = 0; m < 4; ++m)
#pragma unroll
                for (int bj = 0; bj < 2; ++bj) {
                    const f32x4 r0 = unpk4_u8((unsigned)gr8[m][bj]), r1 = unpk4_u8((unsigned)(gr8[m][bj] >> 32));
                    st8_wt(m8 + (size_t)(row0 + ai * HALF + m * 16) * 2048 + c0 + bj * HALF, (unsigned long long)pk4_fp8_(acc[ai][bj][m][0] * (r0 * scg)) | ((unsigned long long)pk4_fp8_(acc[ai][bj][m][1] * (r1 * scg)) << 32)); }
        }
    }
};

struct EpiOut {
    static constexpr bool PERM = true, AFTER_DRAIN = false;
    const float* x; bf16_t* x1b; float* sumsq; float sc;
    __device__ __forceinline__ void operator()(const f32x4 (&acc)[2][2][4][2], const Unit& u, int wr, int wc, int fr, int fq) const {
        const int row0 = u.pm * BM + wr * 64 + fr, c0 = u.pn * BM + wc * 32 + 8 * fq;
#pragma unroll
        for (int aim = 0; aim < 4; ++aim)
        {   const int ai = aim >> 1, mb = 2 * (aim & 1);
            f32x4 xv[4][2][2];
#pragma unroll
            for (int m = mb; m < mb + 2; ++m)
#pragma unroll
                for (int bj = 0; bj < 2; ++bj) { const size_t off = (size_t)(row0 + ai * HALF + m * 16) * 2048 + c0 + bj * HALF; xv[m][bj][0] = *(const f32x4*)(x + off); xv[m][bj][1] = *(const f32x4*)(x + off + 4); }
#pragma unroll
            for (int m = mb; m < mb + 2; ++m) { const size_t row = (size_t)(row0 + ai * HALF + m * 16); float ss = 0.f;
#pragma unroll
                for (int bj = 0; bj < 2; ++bj) {
                    const size_t off = row * 2048 + c0 + bj * HALF;
                    const f32x4 v0 = acc[ai][bj][m][0] * sc + xv[m][bj][0], v1 = acc[ai][bj][m][1] * sc + xv[m][bj][1];
                    st16_wt(x1b + off, pack8(v0, v1));
                    ss += (v0[0] * v0[0] + v0[1] * v0[1]) + (v0[2] * v0[2] + v0[3] * v0[3]) + (v1[0] * v1[0] + v1[1] * v1[1]) + (v1[2] * v1[2] + v1[3] * v1[3]); }
                ss += __shfl_xor(ss, 16); ss += __shfl_xor(ss, 32);
                if (fq == 0) st4f_wt(sumsq + row * 32 + u.pn * 4 + wc, ss); }
        }
    }
};

struct EpiQ {
    static constexpr bool PERM = true, AFTER_DRAIN = false;
    bf16_t* qp; const float* sumsq;
    __device__ __forceinline__ void operator()(const f32x4 (&acc)[2][2][4][2], const Unit& u, int wr, int wc, int fr, int fq) const {
        const int row0 = u.pm * BM + wr * 64 + fr, c0 = u.pn * BM + wc * 32 + 8 * fq;
        float rsv[2][4];
#pragma unroll
        for (int ai = 0; ai < 2; ++ai)
#pragma unroll
            for (int m = 0; m < 4; ++m) { const size_t row = (size_t)(row0 + ai * HALF + m * 16);
                const f32x4 p0 = *(const f32x4*)(sumsq + row * 32 + fq * 8), p1 = *(const f32x4*)(sumsq + row * 32 + fq * 8 + 4);
                float st = ((p0[0] + p0[1]) + (p0[2] + p0[3])) + ((p1[0] + p1[1]) + (p1[2] + p1[3]));
                st += __shfl_xor(st, 16); st += __shfl_xor(st, 32);
                rsv[ai][m] = __builtin_amdgcn_rsqf(st * (1.0f / 2048.0f) + 1e-6f); }
#pragma unroll
        for (int ai = 0; ai < 2; ++ai)
#pragma unroll
            for (int m = 0; m < 4; ++m) { const size_t row = (size_t)(row0 + ai * HALF + m * 16); const float rs = rsv[ai][m];
#pragma unroll
                for (int bj = 0; bj < 2; ++bj) st16_wt(qp + row * 2048 + c0 + bj * HALF, pack8(acc[ai][bj][m][0] * rs, acc[ai][bj][m][1] * rs)); }
    }
};

template <class Epi, class Sched, bool ALIGN_EPI = false, bool SP2 = false, bool F8 = false, bool CHAIN = false>
__device__ __forceinline__ void gemm_phase(PG8_LAS unsigned char* lds, const Gemm g, const Sched& S, const Epi& E) {
    int tid_ = threadIdx.x; asm volatile("" : "+v"(tid_));
    const int tid = tid_, wid = __builtin_amdgcn_readfirstlane(tid >> 6), lane = tid & 63, wr = wid >> 2, wc = wid & 3, fr = lane & 15, fq = lane >> 4;
    int K_ = g.K; asm volatile("" : "+s"(K_));
    const int K = K_, nt = K / BK; int K2_ = g.K2; asm volatile("" : "+s"(K2_)); const int nt2 = K2_ / BK;
    unsigned voffA[2], voffB[2];
#pragma unroll
    for (int i = 0; i < 2; ++i) { int R, C; stage_rc(tid * 16 + i * 8192, R, C); const int Rb = Epi::PERM ? ((R & ~31) + perm32(R & 31)) : R;
        voffA[i] = (unsigned)(R * K + C) * 2u; voffB[i] = (unsigned)(Rb * K + C) * 2u; }
    const size_t kstep = (size_t)(BK * 2);
    const size_t hstep = (size_t)HALF * K * 2;
    const size_t tstep = 2 * hstep;
    const unsigned ldsw = (unsigned)wid * 1024u;
    const int aoff = lds_byte(wr * 64 + fr, fq * 8), boff = lds_byte(wc * 32 + fr, fq * 8);
    const int aoffk0 = F8 ? lds_byte(wr * 64 + fr, 16 * fq) : aoff, aoffk1 = F8 ? lds_byte(wr * 64 + fr, 16 * fq + 8) : aoff + 1024;
    const int boffk0 = F8 ? lds_byte(wc * 32 + fr, 16 * fq) : boff, boffk1 = F8 ? lds_byte(wc * 32 + fr, 16 * fq + 8) : boff + 1024;
#ifndef F8_LEGACY
#define F8_LEGACY 0
#endif
#ifndef DBG_HALF_MMA
#define DBG_HALF_MMA 0
#endif
#ifndef F8_SAFE
#define F8_SAFE 0
#endif
#ifndef F8_FIXREG
#define F8_FIXREG 1
#endif
#ifndef F8_BUILTIN
#define F8_BUILTIN 0
#endif
#define PG8_SA(b, h) (((b) * 2 + (h)) * HTB)
#define PG8_SB(b, h) ((4 + (b) * 2 + (h)) * HTB)
#define PG8_STAGE(bufoff, gbase, voff) do { _Pragma("unroll") for (int _i = 0; _i < 2; ++_i) \
        __builtin_amdgcn_global_load_lds((const unsigned*)((const char*)(gbase) + (voff)[_i]), (PG8_LAS unsigned*)(lds + (bufoff) + ldsw + _i * 8192), 16, 0, 0); } while (0)
#define PG8_LDA(dst, b, h) do { _Pragma("unroll") for (int m = 0; m < 4; ++m) { if constexpr (F8 && !F8_LEGACY) { \
            dst##8[m] = __builtin_shufflevector(*(const PG8_LAS i32x4_*)(lds + PG8_SA(b, h) + aoffk0 + m * 2048), *(const PG8_LAS i32x4_*)(lds + PG8_SA(b, h) + aoffk1 + m * 2048), 0, 1, 2, 3, 4, 5, 6, 7); } \
        else { _Pragma("unroll") for (int k = 0; k < 2; ++k) dst[m][k] = *(const PG8_LAS bf16x8*)(lds + PG8_SA(b, h) + (k ? aoffk1 : aoffk0) + m * 2048); } } } while (0)
#define PG8_LDB(dst, b, h) do { _Pragma("unroll") for (int n = 0; n < 2; ++n) { if constexpr (F8 && !F8_LEGACY) { \
            dst##8[n] = __builtin_shufflevector(*(const PG8_LAS i32x4_*)(lds + PG8_SB(b, h) + boffk0 + n * 2048), *(const PG8_LAS i32x4_*)(lds + PG8_SB(b, h) + boffk1 + n * 2048), 0, 1, 2, 3, 4, 5, 6, 7); } \
        else { _Pragma("unroll") for (int k = 0; k < 2; ++k) dst[n][k] = *(const PG8_LAS bf16x8*)(lds + PG8_SB(b, h) + (k ? boffk1 : boffk0) + n * 2048); } } } while (0)
#define PG8_MMA_(ai, bj, At, Bt) do { if (F8 && F8_SAFE == 1) { asm volatile("s_waitcnt vmcnt(0) lgkmcnt(0)\n\ts_nop 15" ::: "memory"); __builtin_amdgcn_s_barrier(); } __builtin_amdgcn_s_setprio(1); _Pragma("unroll") for (int m = 0; m < 4; ++m) _Pragma("unroll") for (int n = 0; n < 2; ++n) { \
        if constexpr (F8 && F8_LEGACY) { _Pragma("unroll") for (int k = 0; k < 2; ++k) { typedef long l2_ __attribute__((ext_vector_type(2))); \
                const l2_ bq = __builtin_bit_cast(l2_, Bt[n][k]), aq = __builtin_bit_cast(l2_, At[m][k]); \
                if (F8_LEGACY == 2) { asm volatile("v_mfma_f32_16x16x32_fp8_fp8 %0, %1, %2, %0" : "+v"(acc[ai][bj][m][n]) : "v"(bq[0]), "v"(aq[0])); asm volatile("v_mfma_f32_16x16x32_fp8_fp8 %0, %1, %2, %0" : "+v"(acc[ai][bj][m][n]) : "v"(bq[1]), "v"(aq[1])); } else { \
                acc[ai][bj][m][n] = __builtin_amdgcn_mfma_f32_16x16x32_fp8_fp8(bq[0], aq[0], acc[ai][bj][m][n], 0, 0, 0); \
                acc[ai][bj][m][n] = __builtin_amdgcn_mfma_f32_16x16x32_fp8_fp8(bq[1], aq[1], acc[ai][bj][m][n], 0, 0, 0); } } } \
            else if constexpr (F8) { if (F8_BUILTIN) acc[ai][bj][m][n] = __builtin_amdgcn_mfma_scale_f32_16x16x128_f8f6f4(Bt##8[n], At##8[m], acc[ai][bj][m][n], 0, 0, 0, 0, 0, 0); \
                else asm volatile("v_mfma_f32_16x16x128_f8f6f4 %0, %1, %2, %0" : "+v"(acc[ai][bj][m][n]) : "v"(Bt##8[n]), "v"(At##8[m])); } \
        else { _Pragma("unroll") for (int k = 0; k < (DBG_HALF_MMA ? 1 : 2); ++k) acc[ai][bj][m][n] = __builtin_amdgcn_mfma_f32_16x16x32_bf16(Bt[n][k], At[m][k], acc[ai][bj][m][n], 0, 0, 0); } } \
        __builtin_amdgcn_s_setprio(0); if (F8 && F8_SAFE == 1) { asm volatile("s_nop 15\n\ts_nop 15\n\ts_nop 15" ::: "memory"); __builtin_amdgcn_s_barrier(); } } while (0)
#define PG8_F8R_At0 "{v[192:199]}"
#define PG8_F8R_At1 "{v[200:207]}"
#define PG8_F8R_At2 "{v[208:215]}"
#define PG8_F8R_At3 "{v[216:223]}"
#define PG8_F8R_B00 "{v[224:231]}"
#define PG8_F8R_B01 "{v[232:239]}"
#define PG8_F8R_B10 "{v[240:247]}"
#define PG8_F8R_B11 "{v[248:255]}"
#define PG8_F8MMA1(ai, bj, m, n, At, Bt) asm volatile("v_mfma_f32_16x16x128_f8f6f4 %0, %1, %2, %0" : "+v"(acc[ai][bj][m][n]) : PG8_F8R_##Bt##n(Bt##8[n]), PG8_F8R_##At##m(At##8[m]))
#define PG8_MMA_FIX(ai, bj, At, Bt) do { __builtin_amdgcn_s_setprio(1); \
        PG8_F8MMA1(ai, bj, 0, 0, At, Bt); PG8_F8MMA1(ai, bj, 0, 1, At, Bt); PG8_F8MMA1(ai, bj, 1, 0, At, Bt); PG8_F8MMA1(ai, bj, 1, 1, At, Bt); \
        PG8_F8MMA1(ai, bj, 2, 0, At, Bt); PG8_F8MMA1(ai, bj, 2, 1, At, Bt); PG8_F8MMA1(ai, bj, 3, 0, At, Bt); PG8_F8MMA1(ai, bj, 3, 1, At, Bt); \
        __builtin_amdgcn_s_setprio(0); } while (0)
#define PG8_MMA(ai, bj, At, Bt) do { if constexpr (F8 && F8_FIXREG) PG8_MMA_FIX(ai, bj, At, Bt); else if (F8 && F8_SAFE == 2) { if (wr == 0) PG8_MMA_(ai, bj, At, Bt); asm volatile("s_nop 15\n\ts_nop 15" ::: "memory"); __builtin_amdgcn_s_barrier(); if (wr == 1) PG8_MMA_(ai, bj, At, Bt); asm volatile("s_nop 15\n\ts_nop 15" ::: "memory"); __builtin_amdgcn_s_barrier(); } else PG8_MMA_(ai, bj, At, Bt); } while (0)
#define PG8_WAIT_V(n) asm volatile("s_waitcnt vmcnt(" #n ")" ::: "memory")
#define PG8_WAIT_L(n) asm volatile("s_waitcnt lgkmcnt(" #n ")" ::: "memory")
#define PG8_BAR __builtin_amdgcn_s_barrier()
#define PG8_SCHED __builtin_amdgcn_sched_barrier(0)
#ifdef EPI_DRAIN
#define PG8_EPI_DRAIN PG8_WAIT_V(0)
#else
#define PG8_EPI_DRAIN do {} while (0)
#endif
    Unit cur, nxt; int ui = 0;
    if (!S.next(0, cur)) return;
    f32x4 acc[2][2][4][2];
#pragma unroll
    for (int a = 0; a < 2; ++a)
#pragma unroll
        for (int b = 0; b < 2; ++b)
#pragma unroll
            for (int m = 0; m < 4; ++m)
#pragma unroll
                for (int n = 0; n < 2; ++n) acc[a][b][m][n] = (f32x4){0.f, 0.f, 0.f, 0.f};
    typedef int i32x4_ __attribute__((ext_vector_type(4))); typedef int i32x8_ __attribute__((ext_vector_type(8)));
    int sc127 = 0x7f7f7f7f; asm volatile("" : "+v"(sc127));
    bf16x8 At[4][2], B0[2][2], B1[2][2]; i32x8_ At8[4], B08[2], B18[2];
    const char* cA = (const char*)((CHAIN && cur.seg == 0) ? g.A2 : g.A) + (size_t)cur.pm * tstep; const char* cB = (const char*)((CHAIN && cur.seg == 0) ? g.Bt2 : g.Bt) + (size_t)cur.pn * tstep;
    int ntc = (CHAIN && cur.seg == 0) ? nt2 : nt;
    S.a_ready(cur);
    if constexpr (SP2) {
        PG8_STAGE(PG8_SB(0, 0), cB, voffB); PG8_STAGE(PG8_SB(0, 1), cB + hstep, voffB); PG8_STAGE(PG8_SA(0, 0), cA, voffA); PG8_STAGE(PG8_SA(0, 1), cA + hstep, voffA);
        if (wr == 1) PG8_BAR;
        PG8_WAIT_V(2); PG8_BAR;
        PG8_STAGE(PG8_SB(1, 0), cB + kstep, voffB); PG8_STAGE(PG8_SA(1, 0), cA + kstep, voffA); PG8_STAGE(PG8_SB(1, 1), cB + hstep + kstep, voffB);
        PG8_WAIT_V(6); PG8_BAR;
    } else {
        PG8_STAGE(PG8_SB(0, 0), cB, voffB); PG8_STAGE(PG8_SA(0, 0), cA, voffA); PG8_STAGE(PG8_SB(0, 1), cB + hstep, voffB); PG8_STAGE(PG8_SA(0, 1), cA + hstep, voffA);
        if (wr == 1) PG8_BAR;
        PG8_WAIT_V(4); PG8_BAR;
        PG8_STAGE(PG8_SB(1, 0), cB + kstep, voffB); PG8_STAGE(PG8_SA(1, 0), cA + kstep, voffA); PG8_STAGE(PG8_SB(1, 1), cB + hstep + kstep, voffB);
        PG8_WAIT_V(6); PG8_BAR;
    }
    for (;;) {
        const bool has_next = S.next(ui + 1, nxt);
        const char* nA = has_next ? (const char*)((CHAIN && nxt.seg == 0) ? g.A2 : g.A) + (size_t)nxt.pm * tstep : cA; const char* nB = has_next ? (const char*)((CHAIN && nxt.seg == 0) ? g.Bt2 : g.Bt) + (size_t)nxt.pn * tstep : cB;
        for (int t = 0; t < ntc; t += 2) {
            const bool last = (t == ntc - 2);
            const char* a1 = cA + (size_t)(t + 1) * kstep;
            const char* a2 = last ? nA : cA + (size_t)(t + 2) * kstep; const char* b2 = last ? nB : cB + (size_t)(t + 2) * kstep;
            const char* a3 = a2 + kstep; const char* b3 = b2 + kstep;
            if (last && has_next) S.a_ready(nxt);
            if constexpr (SP2) {
            PG8_LDB(B0, 0, 0); PG8_LDB(B1, 0, 1); PG8_SCHED; PG8_LDA(At, 0, 0); PG8_STAGE(PG8_SA(1, 1), a1 + hstep, voffA);
            PG8_WAIT_V(8); PG8_WAIT_L(0); PG8_BAR; PG8_MMA(0, 0, At, B0); PG8_MMA(0, 1, At, B1); PG8_BAR; PG8_SCHED;
            PG8_LDA(At, 0, 1); PG8_STAGE(PG8_SB(0, 0), b2, voffB); PG8_STAGE(PG8_SB(0, 1), b2 + hstep, voffB); PG8_STAGE(PG8_SA(0, 0), a2, voffA);
            PG8_WAIT_V(8); PG8_WAIT_L(0); PG8_BAR; PG8_MMA(1, 0, At, B0); PG8_MMA(1, 1, At, B1); PG8_BAR; PG8_SCHED;
            PG8_LDB(B0, 1, 0); PG8_LDB(B1, 1, 1); PG8_SCHED; PG8_LDA(At, 1, 0); PG8_STAGE(PG8_SA(0, 1), a2 + hstep, voffA);
            PG8_WAIT_V(8); PG8_WAIT_L(0); PG8_BAR; PG8_MMA(0, 0, At, B0); PG8_MMA(0, 1, At, B1); PG8_BAR; PG8_SCHED;
            PG8_LDA(At, 1, 1); PG8_STAGE(PG8_SB(1, 0), b3, voffB); PG8_STAGE(PG8_SB(1, 1), b3 + hstep, voffB); PG8_STAGE(PG8_SA(1, 0), a3, voffA);
            PG8_WAIT_V(8); PG8_WAIT_L(0); PG8_BAR; PG8_MMA(1, 0, At, B0); PG8_MMA(1, 1, At, B1); PG8_BAR; PG8_SCHED;
            } else {
            PG8_LDB(B0, 0, 0); PG8_SCHED; PG8_LDA(At, 0, 0); PG8_STAGE(PG8_SA(1, 1), a1 + hstep, voffA);
            PG8_WAIT_L(8); PG8_BAR; PG8_WAIT_L(0); PG8_MMA(0, 0, At, B0); PG8_BAR; PG8_SCHED;
            PG8_LDB(B1, 0, 1); PG8_STAGE(PG8_SB(0, 0), b2, voffB);
            PG8_BAR; PG8_WAIT_L(0); PG8_MMA(0, 1, At, B1); PG8_BAR;
            PG8_LDA(At, 0, 1); PG8_STAGE(PG8_SA(0, 0), a2, voffA);
            PG8_BAR; PG8_WAIT_L(0); PG8_MMA(1, 0, At, B0); PG8_BAR; PG8_SCHED;
            PG8_STAGE(PG8_SB(0, 1), b2 + hstep, voffB);
            PG8_WAIT_V(6); PG8_BAR; PG8_MMA(1, 1, At, B1); PG8_BAR;
            PG8_LDB(B0, 1, 0); PG8_SCHED; PG8_LDA(At, 1, 0); PG8_STAGE(PG8_SA(0, 1), a2 + hstep, voffA);
            PG8_WAIT_L(8); PG8_BAR; PG8_WAIT_L(0); PG8_MMA(0, 0, At, B0); PG8_BAR; PG8_SCHED;
            PG8_LDB(B1, 1, 1); PG8_STAGE(PG8_SB(1, 0), b3, voffB);
            PG8_BAR; PG8_WAIT_L(0); PG8_MMA(0, 1, At, B1); PG8_BAR;
            PG8_LDA(At, 1, 1); PG8_STAGE(PG8_SA(1, 0), a3, voffA);
            PG8_BAR; PG8_WAIT_L(0); PG8_MMA(1, 0, At, B0); PG8_BAR; PG8_SCHED;
            PG8_STAGE(PG8_SB(1, 1), b3 + hstep, voffB);
            PG8_WAIT_V(6); PG8_BAR; PG8_MMA(1, 1, At, B1); PG8_BAR;
            }
        }
        if constexpr (F8) asm volatile("s_nop 15\n\ts_nop 7" ::: "memory");
        if constexpr (ALIGN_EPI) { if (wr == 0) PG8_BAR; }
        bool keep_acc = false;
        if constexpr (CHAIN) { if (cur.seg == 0) { E.mid(acc, cur, wr, wc, fr, fq); keep_acc = true; } else { E(acc, cur, wr, wc, fr, fq); S.done(cur); } }
        else if constexpr (!Epi::AFTER_DRAIN) { E(acc, cur, wr, wc, fr, fq); S.done(cur); PG8_EPI_DRAIN; }
        if (!has_next) break;
        if (!keep_acc) {
#pragma unroll
        for (int a = 0; a < 2; ++a)
#pragma unroll
            for (int b = 0; b < 2; ++b)
#pragma unroll
                for (int m = 0; m < 4; ++m)
#pragma unroll
                    for (int n = 0; n < 2; ++n) acc[a][b][m][n] = (f32x4){0.f, 0.f, 0.f, 0.f};
        }
        cur = nxt; cA = nA; cB = nB; ++ui; if constexpr (CHAIN) ntc = (cur.seg == 0) ? nt2 : nt;
        if constexpr (ALIGN_EPI) { if (wr == 1) PG8_BAR; }
    }
    PG8_WAIT_V(0);
    if constexpr (!ALIGN_EPI) { if (wr == 0) PG8_BAR; }
    PG8_BAR;
    if constexpr (Epi::AFTER_DRAIN) { E.fused(acc, cur, wr, wc, fr, fq, lds, wid, lane); S.done(cur); }
#undef PG8_SA
#undef PG8_SB
#undef PG8_STAGE
#undef PG8_LDA
#undef PG8_LDB
#undef PG8_MMA
#undef PG8_WAIT_V
#undef PG8_WAIT_L
#undef PG8_BAR
#undef PG8_SCHED
}
}
#define GAS __attribute__((address_space(1)))
#define LAS __attribute__((address_space(3)))
typedef unsigned short bf16;
typedef unsigned v4u __attribute__((ext_vector_type(4)));
typedef float f32x4 __attribute__((ext_vector_type(4)));
typedef short bf16x8 __attribute__((ext_vector_type(8)));
typedef GAS unsigned gu32;
typedef GAS unsigned long long gu64;
#define RLX_AGENT __ATOMIC_RELAXED, __HIP_MEMORY_SCOPE_AGENT
#define LDS_WAIT() asm volatile("s_waitcnt lgkmcnt(0)" ::: "memory")
#define VM_WAIT() asm volatile("s_waitcnt vmcnt(0)" ::: "memory")
__device__ __forceinline__ unsigned long long rt() { return __builtin_amdgcn_s_memrealtime(); }
__device__ __forceinline__ unsigned f2bf(float f) { unsigned u = __builtin_bit_cast(unsigned, f); return (u + 0x7fffu + ((u >> 16) & 1u)) >> 16; }
__device__ __forceinline__ unsigned pk2(float lo, float hi) { return f2bf(lo) | (f2bf(hi) << 16); }
#define XB_TMO      128
#define XB_XCNT(j)  (256  + 64 * (j))
#define XB_XSUB(j)  (1280 + 64 * (j))
#define XB_XGEN(j)  (2304 + 64 * (j))
#define XB_TOP      3328
#define XB_TOPGEN   3392
#define XCD_BAR_WORDS 3456
#ifndef XB_SCOPE
#define XB_SCOPE "agent"
#endif
#define XB_SPIN_CAP (1u << 18)

__device__ __forceinline__ unsigned xb_ld(unsigned* p)              { return __hip_atomic_load(p, __ATOMIC_RELAXED, __HIP_MEMORY_SCOPE_AGENT); }
__device__ __forceinline__ unsigned xb_add(unsigned* p, unsigned v) { return __hip_atomic_fetch_add(p, v, __ATOMIC_RELAXED, __HIP_MEMORY_SCOPE_AGENT); }
__device__ __forceinline__ unsigned xb_xcc_id() { return (unsigned)__builtin_amdgcn_s_getreg((3 << 11) | 20) & 0xFu; }
#define XB_SPIN(cond, bar) do { unsigned _sp = 0; while (cond) { __builtin_amdgcn_s_sleep(1); \
    if ((++_sp & 255u) == 0u) { if (xb_ld(&(bar)[XB_TMO])) break; if (_sp > XB_SPIN_CAP) { atomicAdd(&(bar)[XB_TMO], 1u); break; } } } } while (0)

struct XcdBarrier {
    unsigned* bar; unsigned x;
    volatile LAS unsigned* st;
};

__device__ __forceinline__ XcdBarrier xcd_barrier_post(unsigned* bar, volatile LAS unsigned* st) {
    XcdBarrier b; b.bar = bar; b.x = xb_xcc_id(); b.st = st;
    if (threadIdx.x == 0) (void)xb_add(&bar[XB_XCNT(b.x)], 1u);
    return b;
}
__device__ __forceinline__ void xcd_barrier_complete(unsigned* bar, unsigned x, unsigned& nloc, unsigned& nx) {
    const unsigned G = gridDim.x * gridDim.y * gridDim.z;
    unsigned sum, cnt, mine, sp = 0u;
    for (;;) {
        sum = 0u; cnt = 0u; mine = 0u;
#pragma unroll
        for (unsigned j = 0; j < 16; ++j) { const unsigned c = xb_ld(&bar[XB_XCNT(j)]); sum += c; cnt += (c > 0u) ? 1u : 0u; mine = (j == x) ? c : mine; }
        if (sum == G) break;
        __builtin_amdgcn_s_sleep(1);
        if ((++sp & 255u) == 0u) { if (xb_ld(&bar[XB_TMO])) break; if (sp > XB_SPIN_CAP) { atomicAdd(&bar[XB_TMO], 1u); break; } }
    }
    nloc = mine > 0u ? mine : 1u; nx = cnt > 0u ? cnt : 1u;
}

__device__ __forceinline__ void xcd_barrier(const XcdBarrier& b) {
    asm volatile("s_waitcnt vmcnt(0)" ::: "memory");
    __syncthreads();
    if (threadIdx.x == 0) {
        unsigned* bar = b.bar;
        __builtin_amdgcn_s_waitcnt(0);
        unsigned nloc = b.st[0], nx = b.st[1];
        if (nloc == 0u) { xcd_barrier_complete(bar, b.x, nloc, nx); b.st[0] = nloc; b.st[1] = nx; }
        const unsigned old = xb_add(&bar[XB_XSUB(b.x)], 1u);
        const unsigned gen = old / nloc;
        if (old + 1u == (gen + 1u) * nloc) {
#ifdef XB_RELEASE_FENCE
            __builtin_amdgcn_fence(__ATOMIC_RELEASE, XB_SCOPE);
#endif
            asm volatile("s_waitcnt vmcnt(0)" ::: "memory");
            const unsigned og = xb_add(&bar[XB_TOP], 1u);
            const unsigned tg = og / nx;
            if (og + 1u == (tg + 1u) * nx) xb_add(&bar[XB_TOPGEN], 1u);
            else XB_SPIN(xb_ld(&bar[XB_TOPGEN]) == tg, bar);
            __builtin_amdgcn_fence(__ATOMIC_ACQUIRE, XB_SCOPE);
            xb_add(&bar[XB_XGEN(b.x)], 1u);
            asm volatile("s_waitcnt vmcnt(0)" ::: "memory");
        } else {
            XB_SPIN(xb_ld(&bar[XB_XGEN(b.x)]) == gen, bar);
            __builtin_amdgcn_fence(__ATOMIC_ACQUIRE, XB_SCOPE);
            asm volatile("s_waitcnt vmcnt(0)" ::: "memory");
        }
    }
    __syncthreads();
}

constexpr int NWAVES = 8;
constexpr int TOK = 16384, DM = 2048, SEQ = 8192, INC = 11264;
constexpr float EPS = 1e-6f;
#ifndef MK_PER_PHASE
#define MK_PER_PHASE 0
#endif
constexpr int N_PHASES = 10;
#ifndef PHASE_MASK
#define PHASE_MASK 0x3ff
#endif

constexpr size_t MiB = 1u << 20;
constexpr size_t WS_CTL = 0, CTL_ZERO_BYTES = 1 * MiB;
constexpr size_t WS_WMAIN = 2 * MiB;
constexpr size_t WS_WKV = 38 * MiB;
constexpr size_t WS_WRO = 50 * MiB;
constexpr size_t WS_WPO = 58 * MiB;
constexpr size_t WS_WOUT = 62 * MiB;
constexpr size_t WS_WQ = 70 * MiB;
constexpr size_t WS_LINT = 78 * MiB;
constexpr size_t WS_KEYS = 79 * MiB;
constexpr size_t WS_H = 80 * MiB;
constexpr size_t WS_Q = 144 * MiB;
constexpr size_t WS_K = 176 * MiB;
constexpr size_t WS_H8 = 208 * MiB;
constexpr size_t WS_VT = 240 * MiB;
#ifndef P5_EARLY
#define P5_EARLY 1
#endif
constexpr size_t WS_GRET = P5_EARLY ? 80 * MiB : 144 * MiB;
constexpr size_t WS_GPOOL = P5_EARLY ? 112 * MiB : 240 * MiB;
constexpr size_t WS_UT = 432 * MiB;
constexpr size_t WS_VTAB = 400 * MiB;
constexpr size_t WS_GR = 304 * MiB;
constexpr size_t WS_PIN = 368 * MiB;
constexpr size_t WS_ST = 400 * MiB;
constexpr size_t WS_POOLED = 464 * MiB;
constexpr size_t WS_RETN = 464 * MiB;
constexpr size_t WS_X1 = 400 * MiB;
constexpr size_t WS_SCR = 272 * MiB;
constexpr size_t WS_END = 528 * MiB;
#ifndef GATES_FP8
#define GATES_FP8 1
#endif
#ifndef P9_SLICED
#define P9_SLICED 1
#endif
constexpr int CW_BAR = 4096;
constexpr int CW_SUMSQ = 65536;

constexpr int LDS_BYTES = 147456;
constexpr int MISC_OFF = 143360;

struct Frame {
    LAS unsigned char* lds;
    int tid, lane, wave, G, vcu;
};
__device__ __forceinline__ float wave_sum(float v) {
#pragma unroll
    for (int o = 1; o < 64; o <<= 1) v += __shfl_xor(v, o);
    return v;
}
typedef GAS const v4u gcv4u;
typedef GAS v4u gv4u;
typedef GAS const f32x4 gcf4;
typedef GAS f32x4 gf4;
__device__ __forceinline__ float bflo(unsigned u) { return __builtin_bit_cast(float, u << 16); }
__device__ __forceinline__ float bfhi(unsigned u) { return __builtin_bit_cast(float, u & 0xffff0000u); }
__device__ __forceinline__ float log2_gamma(int h) { return pg8::log2_gamma(h); }

constexpr float U_SCALE = 256.0f, V_SCALE = 32.0f, H8_SCALE = 16.0f, WG8_SCALE = 512.0f;
__device__ __forceinline__ unsigned pk4_fp8(f32x4 a) { int p = __builtin_amdgcn_cvt_pk_fp8_f32(a[0], a[1], 0, false); p = __builtin_amdgcn_cvt_pk_fp8_f32(a[2], a[3], p, true); return (unsigned)p; }
__device__ __forceinline__ void win_rows(int c, int& rmain, int& rkv) {
    rmain = -1; rkv = -1;
    if (c < 2048) { const int isk = c >> 10, cc = c & 1023, hh = cc >> 7, r = cc & 127, half = r >> 6, i = r & 63;
        rmain = isk * 1024 + hh * 128 + 2 * i + half;
    }
    else if (c < 4096) rkv = c - 2048;
    else if (c < 6144) rmain = 2048 + (c - 4096);
    else if (c < 7168) rmain = 4096 + (c - 6144);
    else rmain = 5120 + (c - 7168);
}
struct P0Item { const float* W; const float* ksc; bf16* WT; bf16* WT2; int ldw, k0, n0, ldt, row_off, mode; float f8; };
__device__ __forceinline__ void p0_item_load(const P0Item& I, int lane, f32x4 (&v)[8]) {
#pragma unroll
    for (int i = 0; i < 8; ++i) { const int kk = 8 * i + (lane >> 3), nn = 4 * (lane & 7); v[i] = *(gcf4*)(I.W + (size_t)(I.k0 + kk) * I.ldw + I.n0 + nn); }
}
__device__ __forceinline__ void p0_item_store(const P0Item& I, int lane, const f32x4 (&v)[8], LAS float* scr) {
#pragma unroll
    for (int i = 0; i < 8; ++i) { const int kk = 8 * i + (lane >> 3), nn = 4 * (lane & 7); f32x4 x = v[i]; if (I.ksc) x = x * I.ksc[I.k0 + kk];
        scr[kk * 33 + nn] = x[0]; scr[kk * 33 + nn + 1] = x[1]; scr[kk * 33 + nn + 2] = x[2]; scr[kk * 33 + nn + 3] = x[3]; }
    LDS_WAIT(); asm volatile("" ::: "memory");
    const int c = lane & 7;
#pragma unroll
    for (int j = 0; j < 4; ++j) { const int n = (lane >> 3) + 8 * j; const LAS float* s = scr + (8 * c) * 33 + n;
        v4u o; o.x = pk2(s[0 * 33], s[1 * 33]); o.y = pk2(s[2 * 33], s[3 * 33]); o.z = pk2(s[4 * 33], s[5 * 33]); o.w = pk2(s[6 * 33], s[7 * 33]);
        if (I.mode == 0) {
            if (I.f8 > 0.f) { const f32x4 lo4 = (f32x4){s[0 * 33], s[1 * 33], s[2 * 33], s[3 * 33]} * I.f8, hi4 = (f32x4){s[4 * 33], s[5 * 33], s[6 * 33], s[7 * 33]} * I.f8;
                st8_wt((unsigned char*)I.WT + (size_t)(I.row_off + I.n0 + n) * I.ldt + I.k0 + 8 * c, (unsigned long long)pk4_fp8(lo4) | ((unsigned long long)pk4_fp8(hi4) << 32)); }
            else st16_wt(I.WT + (size_t)(I.row_off + I.n0 + n) * I.ldt + I.k0 + 8 * c, o); }
        else { int r1, r2; win_rows(I.n0 + n, r1, r2);
            const int g0 = r1 < 2048 ? 0 : r1 < 4096 ? 2048 : r1 < 5120 ? 4096 : 5120;
            const bool f8row = r1 >= 0 && (r1 < 2048 ? (MAIN_FP8 & 1) != 0 : r1 < 4096 ? (MAIN_FP8 & 2) != 0 : r1 < 5120 ? (MAIN_FP8 & 4) != 0 : GATES_FP8 != 0);
            if (f8row) {
                const f32x4 lo4 = (f32x4){s[0 * 33], s[1 * 33], s[2 * 33], s[3 * 33]} * WG8_SCALE, hi4 = (f32x4){s[4 * 33], s[5 * 33], s[6 * 33], s[7 * 33]} * WG8_SCALE;
                st8_wt((unsigned char*)(I.WT + (size_t)g0 * I.ldt) + (size_t)(r1 - g0) * 2048 + I.k0 + 8 * c, (unsigned long long)pk4_fp8(lo4) | ((unsigned long long)pk4_fp8(hi4) << 32)); }
            else if (r1 >= 0) st16_wt(I.WT + (size_t)r1 * I.ldt + I.k0 + 8 * c, o);
            if (r2 >= 0) {
                if (KV_FP8) { const f32x4 lo4 = (f32x4){s[0 * 33], s[1 * 33], s[2 * 33], s[3 * 33]} * WG8_SCALE, hi4 = (f32x4){s[4 * 33], s[5 * 33], s[6 * 33], s[7 * 33]} * WG8_SCALE;
                    st8_wt((unsigned char*)I.WT2 + (size_t)r2 * 2048 + I.k0 + 8 * c, (unsigned long long)pk4_fp8(lo4) | ((unsigned long long)pk4_fp8(hi4) << 32)); }
                else st16_wt(I.WT2 + (size_t)r2 * I.ldt + I.k0 + 8 * c, o); } } }
    LDS_WAIT(); asm volatile("" ::: "memory");
}
__device__ __forceinline__ void rms_rows_to_bf16(int lane, int m0, int mstep, const float* x, const float* w, bf16* h, unsigned char* h8) {
    const GAS f32x4* wr = (const GAS f32x4*)w + 2 * lane;
    f32x4 wv[8], v[8];
#pragma unroll
    for (int j = 0; j < 4; ++j) { wv[2 * j] = wr[128 * j]; wv[2 * j + 1] = wr[128 * j + 1]; }
    if (m0 < TOK) { const GAS f32x4* xr = (const GAS f32x4*)(x + (size_t)m0 * DM) + 2 * lane;
#pragma unroll
        for (int j = 0; j < 4; ++j) { v[2 * j] = xr[128 * j]; v[2 * j + 1] = xr[128 * j + 1]; } }
    for (int m = m0; m < TOK; m += mstep) {
        f32x4 c[8]; float s = 0.f;
#pragma unroll
        for (int j = 0; j < 8; ++j) { c[j] = v[j]; s += (v[j].x * v[j].x + v[j].y * v[j].y) + (v[j].z * v[j].z + v[j].w * v[j].w); }
        if (m + mstep < TOK) { const GAS f32x4* xr = (const GAS f32x4*)(x + (size_t)(m + mstep) * DM) + 2 * lane;
#pragma unroll
            for (int j = 0; j < 4; ++j) { v[2 * j] = xr[128 * j]; v[2 * j + 1] = xr[128 * j + 1]; } }
        const float rstd = __builtin_amdgcn_rsqf(wave_sum(s) * (1.f / DM) + EPS);
        bf16* orow = h + (size_t)m * DM; unsigned char* o8row = h8 + (size_t)m * DM;
#pragma unroll
        for (int j = 0; j < 4; ++j) { const f32x4 wa = wv[2 * j], wb = wv[2 * j + 1], a = c[2 * j], b = c[2 * j + 1];
            v4u o; o.x = pk2(a.x * rstd * wa.x, a.y * rstd * wa.y); o.y = pk2(a.z * rstd * wa.z, a.w * rstd * wa.w); o.z = pk2(b.x * rstd * wb.x, b.y * rstd * wb.y); o.w = pk2(b.z * rstd * wb.z, b.w * rstd * wb.w);
            st16_wt(orow + 512 * j + 8 * lane, o);
            if (GATES_FP8) st8_wt(o8row + 512 * j + 8 * lane, (unsigned long long)pk4_fp8(a * (rstd * H8_SCALE) * wa) | ((unsigned long long)pk4_fp8(b * (rstd * H8_SCALE) * wb) << 32)); }
    }
}
struct P0Args { const float *x, *norm1_w, *w_in, *w_ret_o, *w_pool_lin, *w_pool_o, *w_out, *norm2_w, *peer_w_q, *sub_keys;
    bf16 *Wmain, *Wkv, *Wro, *Wpo, *Wout, *Wq, *linT, *keys, *h; unsigned char* h8; };
__device__ __forceinline__ void p0_prologue(const Frame& F, const P0Args& a) {
    LAS float* scr = (LAS float*)(F.lds + F.wave * 16384);
    const int gw = F.vcu * NWAVES + F.wave, NGW = F.G * NWAVES;
    constexpr int I_IN = 32 * 352, I_SQ = 32 * 64, I_PO = 16 * 64, I_LIN = 4 * 4 * 8;
    constexpr int NITEMS = I_IN + 3 * I_SQ + I_PO + I_LIN;
    auto item_of = [&](int it) {
        P0Item I; int r = it; I.ksc = nullptr; I.WT2 = nullptr; I.row_off = 0; I.mode = 0; I.f8 = 0.f;
        if (r < I_IN) { I.W = a.w_in; I.ldw = INC; I.k0 = 64 * (r / 352); I.n0 = 32 * (r % 352); I.WT = a.Wmain; I.WT2 = a.Wkv; I.ldt = DM; I.mode = 1; return I; } r -= I_IN;
        if (r < I_SQ) { I.W = a.w_ret_o; I.ldw = DM; I.k0 = 64 * (r / 64); I.n0 = 32 * (r % 64); I.WT = a.Wro; I.ldt = DM; if (MIX_FP8) I.f8 = pg8::WB8_SCALE; return I; } r -= I_SQ;
        if (r < I_SQ) { I.W = a.w_out; I.ldw = DM; I.k0 = 64 * (r / 64); I.n0 = 32 * (r % 64); I.WT = a.Wout; I.ldt = DM; if (OUT_FP8) I.f8 = pg8::WO8_SCALE; return I; } r -= I_SQ;
        if (r < I_SQ) { I.W = a.peer_w_q; I.ldw = DM; I.k0 = 64 * (r / 64); I.n0 = 32 * (r % 64); I.WT = a.Wq; I.ldt = DM; I.ksc = a.norm2_w; return I; } r -= I_SQ;
        if (r < I_PO) { I.W = a.w_pool_o; I.ldw = DM; I.k0 = 64 * (r / 64); I.n0 = 32 * (r % 64); I.WT = a.Wpo; I.ldt = (MIX_FP8 && P6_CHAIN) ? 2048 : 1024; if (MIX_FP8) I.f8 = pg8::WB8_SCALE; return I; } r -= I_PO;
        { const int g = r >> 5; I.W = a.w_pool_lin + (size_t)g * 65536; I.ldw = 256; I.k0 = 64 * ((r >> 3) & 3); I.n0 = 32 * (r & 7); I.WT = a.linT; I.ldt = 256; I.row_off = g * 256; return I; }
    };
    {
        f32x4 v[8]; int it = gw; P0Item cur;
        if (it < NITEMS) { cur = item_of(it); p0_item_load(cur, F.lane, v); }
        for (; it < NITEMS; it += NGW) {
            f32x4 vc[8];
#pragma unroll
            for (int i = 0; i < 8; ++i) vc[i] = v[i];
            const P0Item now = cur;
            if (it + NGW < NITEMS) { cur = item_of(it + NGW); p0_item_load(cur, F.lane, v); }
            p0_item_store(now, F.lane, vc, scr);
        }
    }
    rms_rows_to_bf16(F.lane, gw, NGW, a.x, a.norm1_w, a.h, a.h8);
    for (int i = (gw * 64 + F.lane) * 2; i < 2 * 128 * 128; i += NGW * 64 * 2) st4_wt(a.keys + i, pk2(a.sub_keys[i], a.sub_keys[i + 1]));
}

constexpr int P2_PITCH = 272;
constexpr int P2_VOFF = 128 * P2_PITCH;
__device__ __forceinline__ void p2_kv_load(const Frame& F, int uu, const bf16* k, const bf16* vT, v4u (&rv)[8], v4u (&r)[4]) {
    const int bh = uu / 63, n = uu - bh * 63;
    const bf16* vb = vT + ((size_t)bh * 256) * 8192 + 128 * n;
#pragma unroll
    for (int i = 0; i < 8; ++i) { const int idx = F.tid + 512 * i, row = idx >> 4, ch = idx & 15; rv[i] = *(gcv4u*)(vb + (size_t)row * 8192 + ch * 8); }
    const int j = F.tid & 127, dg = F.tid >> 7;
    const bf16* src = k + ((size_t)bh * 8192 + 128 * n + j) * 128 + 32 * dg;
#pragma unroll
    for (int c = 0; c < 4; ++c) r[c] = *(gcv4u*)(src + 8 * c);
}
__device__ __forceinline__ void p2_kv_phase(const Frame& F, const bf16* k, const bf16* vT, bf16* st) {
    const int w = F.wave, fr = F.lane & 15, fq = F.lane >> 4;
    LAS unsigned char* KT = F.lds; LAS unsigned char* VT = F.lds + P2_VOFF;
    v4u rv[8], r[4];
    int uu = F.vcu;
    if (uu < 16 * 63) p2_kv_load(F, uu, k, vT, rv, r);
#pragma unroll 1
    for (; uu < 16 * 63; uu += F.G) {
        const int bh = uu / 63, n = uu - bh * 63, hh = bh & 7;
        {   const int j = F.tid & 127, dg = F.tid >> 7;
            const float zz = __builtin_amdgcn_exp2f((float)(127 - j) * log2_gamma(hh));
#pragma unroll
            for (int c = 0; c < 4; ++c) { const unsigned wv[4] = {r[c].x, r[c].y, r[c].z, r[c].w};
#pragma unroll
                for (int q = 0; q < 4; ++q) { const unsigned pk = pk2(bflo(wv[q]) * zz, bfhi(wv[q]) * zz); const int d = 32 * dg + 8 * c + 2 * q;
                    *(LAS unsigned short*)(KT + d * P2_PITCH + 2 * j) = (unsigned short)pk; *(LAS unsigned short*)(KT + (d + 1) * P2_PITCH + 2 * j) = (unsigned short)(pk >> 16); } }
#pragma unroll
            for (int i = 0; i < 8; ++i) { const int idx = F.tid + 512 * i, row = idx >> 4, ch = idx & 15; *(LAS v4u*)(VT + row * P2_PITCH + ch * 16) = rv[i]; }
        }
        __syncthreads();
        if (uu + F.G < 16 * 63) p2_kv_load(F, uu + F.G, k, vT, rv, r);
        f32x4 acc[8][2];
#pragma unroll
        for (int dt = 0; dt < 8; ++dt) { acc[dt][0] = (f32x4){0.f, 0.f, 0.f, 0.f}; acc[dt][1] = (f32x4){0.f, 0.f, 0.f, 0.f}; }
#pragma unroll 2
        for (int ks = 0; ks < 4; ++ks) {
            bf16x8 vf[2], kf[8];
#pragma unroll
            for (int t = 0; t < 2; ++t) vf[t] = *(LAS const bf16x8*)(VT + (32 * w + 16 * t + fr) * P2_PITCH + (32 * ks + 8 * fq) * 2);
#pragma unroll
            for (int dt = 0; dt < 8; ++dt) kf[dt] = *(LAS const bf16x8*)(KT + (32 * (dt >> 1) + 8 * (fr >> 2) + 4 * (dt & 1) + (fr & 3)) * P2_PITCH + (32 * ks + 8 * fq) * 2);
#pragma unroll
            for (int dt = 0; dt < 8; ++dt)
#pragma unroll
                for (int t = 0; t < 2; ++t) acc[dt][t] = __builtin_amdgcn_mfma_f32_16x16x32_bf16(kf[dt], vf[t], acc[dt][t], 0, 0, 0);
        }
        bf16* so = st + ((size_t)(bh * 64 + n) * 256 + 32 * w + fr) * 128 + 8 * fq;
#pragma unroll
        for (int pp = 0; pp < 4; ++pp)
#pragma unroll
            for (int t = 0; t < 2; ++t) { const f32x4 v0 = acc[2 * pp][t], v1 = acc[2 * pp + 1][t];
                v4u o; o.x = pk2(v0[0], v0[1]); o.y = pk2(v0[2], v0[3]); o.z = pk2(v1[0], v1[1]); o.w = pk2(v1[2], v1[3]);
                st16_wt(so + (size_t)(16 * t) * 128 + 32 * pp, o); }
        __syncthreads();
    }
}
template <int W>
__device__ __forceinline__ void p2_pool_g(const Frame& F, const bf16* pin, bf16* pooled, int g) {
    const int NT = F.G * NWAVES * 64;
    for (int item = F.vcu * NWAVES * 64 + F.tid; item < TOK * 32; item += NT) {
        const int tok = item >> 5, ch = item & 31, s = tok & 8191, cnt = (s + 1 < W) ? s + 1 : W;
        const bf16* p = pin + (size_t)tok * 1024 + g * 256 + 8 * ch;
        v4u r[W];
#pragma unroll
        for (int t = 0; t < W; ++t) { const int tt = (t < cnt) ? t : 0; r[t] = *(gcv4u*)(p - (size_t)tt * 1024); }
        float sm[8];
#pragma unroll
        for (int q = 0; q < 8; ++q) sm[q] = 0.f;
#pragma unroll
        for (int t = 0; t < W; ++t) { const float m = (t < cnt) ? 1.f : 0.f;
            sm[0] += m * bflo(r[t].x); sm[1] += m * bfhi(r[t].x); sm[2] += m * bflo(r[t].y); sm[3] += m * bfhi(r[t].y); sm[4] += m * bflo(r[t].z); sm[5] += m * bfhi(r[t].z); sm[6] += m * bflo(r[t].w); sm[7] += m * bfhi(r[t].w); }
        const float ic = 1.0f / (float)cnt;
        v4u o; o.x = pk2(sm[0] * ic - bflo(r[0].x), sm[1] * ic - bfhi(r[0].x)); o.y = pk2(sm[2] * ic - bflo(r[0].y), sm[3] * ic - bfhi(r[0].y));
        o.z = pk2(sm[4] * ic - bflo(r[0].z), sm[5] * ic - bfhi(r[0].z)); o.w = pk2(sm[6] * ic - bflo(r[0].w), sm[7] * ic - bfhi(r[0].w));
        st16_wt(pooled + ((size_t)g * TOK + tok) * 256 + 8 * ch, o);
    }
}
__device__ __forceinline__ void p2_pool(const Frame& F, const bf16* pin, bf16* pooled) {
    p2_pool_g<2>(F, pin, pooled, 0); p2_pool_g<4>(F, pin, pooled, 1); p2_pool_g<8>(F, pin, pooled, 2); p2_pool_g<16>(F, pin, pooled, 3);
}

__device__ __forceinline__ void p3_scan(const Frame& F, bf16* st) {
    const int NT = F.G * NWAVES * 64;
    for (int vid = F.vcu * NWAVES * 64 + F.tid; vid < 131072; vid += NT) {
        const int bh = vid >> 13, vec = vid & 8191, hh = bh & 7;
        const float gc = __builtin_amdgcn_exp2f(128.0f * log2_gamma(hh));
        bf16* p = st + (size_t)bh * 64 * 32768 + 4 * vec;
        float R[4] = {0.f, 0.f, 0.f, 0.f};
        unsigned long long cur[8], nxt[8];
#pragma unroll
        for (int t = 0; t < 8; ++t) cur[t] = *(const GAS unsigned long long*)(p + (size_t)t * 32768);
#pragma unroll 1
        for (int n0 = 0; n0 < 64; n0 += 8) {
#pragma unroll
            for (int t = 0; t < 8; ++t) nxt[t] = (n0 + 8 + t < 63) ? *(const GAS unsigned long long*)(p + (size_t)(n0 + 8 + t) * 32768) : 0ull;
#pragma unroll
            for (int t = 0; t < 8; ++t) {
                st8_wt(p + (size_t)(n0 + t) * 32768, (unsigned long long)pk2(R[0], R[1]) | ((unsigned long long)pk2(R[2], R[3]) << 32));
                const unsigned lo = (unsigned)cur[t], hi = (unsigned)(cur[t] >> 32);
                R[0] = gc * R[0] + bflo(lo); R[1] = gc * R[1] + bfhi(lo); R[2] = gc * R[2] + bflo(hi); R[3] = gc * R[3] + bfhi(hi);
            }
#pragma unroll
            for (int t = 0; t < 8; ++t) cur[t] = nxt[t];
        }
    }
}

constexpr int P4_PITCH = 272;
__device__ __forceinline__ void p4_unit(const Frame& F, int uu, const bf16* q, const bf16* k, const bf16* vT, const bf16* st, const bf16* grs, bf16* retn) {
    const int bh = uu >> 6, n = uu & 63, hh = bh & 7, b = bh >> 3;
    const int w = F.wave, wr = w >> 2, wc = w & 3, fr = F.lane & 15, fq = F.lane >> 4;
    const float lg = log2_gamma(hh);
    LAS unsigned char* P = F.lds;
    LAS float* stats = (LAS float*)(F.lds + 128 * P4_PITCH);
    const bf16* Qb = q + ((size_t)bh * 8192 + 128 * n) * 128;
    const bf16* Kb = k + ((size_t)bh * 8192 + 128 * n) * 128;
    {
        f32x4 sa[4][2];
#pragma unroll
        for (int it = 0; it < 4; ++it) { sa[it][0] = (f32x4){0.f, 0.f, 0.f, 0.f}; sa[it][1] = (f32x4){0.f, 0.f, 0.f, 0.f}; }
#pragma unroll
        for (int ks = 0; ks < 4; ++ks) {
            bf16x8 qf[4], kf[2];
#pragma unroll
            for (int it = 0; it < 4; ++it) qf[it] = *(GAS const bf16x8*)(Qb + (size_t)(64 * wr + 16 * it + fr) * 128 + 32 * ks + 8 * fq);
#pragma unroll
            for (int jt = 0; jt < 2; ++jt) kf[jt] = *(GAS const bf16x8*)(Kb + (size_t)(32 * wc + 16 * jt + fr) * 128 + 32 * ks + 8 * fq);
#pragma unroll
            for (int it = 0; it < 4; ++it)
#pragma unroll
                for (int jt = 0; jt < 2; ++jt) sa[it][jt] = __builtin_amdgcn_mfma_f32_16x16x32_bf16(kf[jt], qf[it], sa[it][jt], 0, 0, 0);
        }
#pragma unroll
        for (int it = 0; it < 4; ++it)
#pragma unroll
            for (int jt = 0; jt < 2; ++jt) {
                const int i = 64 * wr + 16 * it + fr, j0 = 32 * wc + 16 * jt + 4 * fq;
                float pv[4];
#pragma unroll
                for (int r = 0; r < 4; ++r) { const int dlt = i - (j0 + r); pv[r] = (dlt >= 0) ? sa[it][jt][r] * __builtin_amdgcn_exp2f((float)dlt * lg) : 0.f; }
                *(LAS unsigned long long*)(P + i * P4_PITCH + j0 * 2) = (unsigned long long)pk2(pv[0], pv[1]) | ((unsigned long long)pk2(pv[2], pv[3]) << 32);
            }
    }
    __syncthreads();
    f32x4 acc[4][4];
#pragma unroll
    for (int it = 0; it < 4; ++it)
#pragma unroll
        for (int et = 0; et < 4; ++et) acc[it][et] = (f32x4){0.f, 0.f, 0.f, 0.f};
    const bf16* RTb = st + ((size_t)(bh * 64 + n)) * 32768;
    const bf16* vTb = vT + ((size_t)bh * 256) * 8192 + 128 * n;
    int esrc[4];
#pragma unroll
    for (int et = 0; et < 4; ++et) esrc[et] = 64 * wc + 32 * (et >> 1) + 8 * (fr >> 2) + 4 * (et & 1) + (fr & 3);
#pragma unroll
    for (int ks = 0; ks < 4; ++ks) {
        bf16x8 qf[4], rf[4];
#pragma unroll
        for (int it = 0; it < 4; ++it) qf[it] = *(GAS const bf16x8*)(Qb + (size_t)(64 * wr + 16 * it + fr) * 128 + 32 * ks + 8 * fq);
#pragma unroll
        for (int et = 0; et < 4; ++et) rf[et] = *(GAS const bf16x8*)(RTb + (size_t)esrc[et] * 128 + 32 * ks + 8 * fq);
#pragma unroll
        for (int it = 0; it < 4; ++it)
#pragma unroll
            for (int et = 0; et < 4; ++et) acc[it][et] = __builtin_amdgcn_mfma_f32_16x16x32_bf16(rf[et], qf[it], acc[it][et], 0, 0, 0);
    }
#pragma unroll
    for (int it = 0; it < 4; ++it) { const float xi = __builtin_amdgcn_exp2f((float)(64 * wr + 16 * it + fr + 1) * lg);
#pragma unroll
        for (int et = 0; et < 4; ++et) acc[it][et] = acc[it][et] * xi; }
#pragma unroll
    for (int ks = 0; ks < 4; ++ks) {
        bf16x8 pf[4], vf[4];
#pragma unroll
        for (int it = 0; it < 4; ++it) pf[it] = *(LAS const bf16x8*)(P + (64 * wr + 16 * it + fr) * P4_PITCH + (32 * ks + 8 * fq) * 2);
#pragma unroll
        for (int et = 0; et < 4; ++et) vf[et] = *(GAS const bf16x8*)(vTb + (size_t)esrc[et] * 8192 + 32 * ks + 8 * fq);
#pragma unroll
        for (int it = 0; it < 4; ++it)
#pragma unroll
            for (int et = 0; et < 4; ++et) acc[it][et] = __builtin_amdgcn_mfma_f32_16x16x32_bf16(vf[et], pf[it], acc[it][et], 0, 0, 0);
    }
#pragma unroll
    for (int it = 0; it < 4; ++it) {
        float s1 = 0.f, s2 = 0.f;
#pragma unroll
        for (int et = 0; et < 4; ++et)
#pragma unroll
            for (int r = 0; r < 4; ++r) { const float v = acc[it][et][r]; s1 += v; s2 += v * v; }
        s1 += __shfl_xor(s1, 16); s1 += __shfl_xor(s1, 32); s2 += __shfl_xor(s2, 16); s2 += __shfl_xor(s2, 32);
        if (fq == 0) { const int i = 64 * wr + 16 * it + fr; stats[(i * 4 + wc) * 2] = s1; stats[(i * 4 + wc) * 2 + 1] = s2; }
    }
    __syncthreads();
#pragma unroll
    for (int it = 0; it < 4; ++it) {
        const int i = 64 * wr + 16 * it + fr;
        float s1 = 0.f, s2 = 0.f;
#pragma unroll
        for (int c = 0; c < 4; ++c) { s1 += stats[(i * 4 + c) * 2]; s2 += stats[(i * 4 + c) * 2 + 1]; }
        const float mu = s1 * (1.f / 256.f), var = s2 * (1.f / 256.f) - mu * mu, rstd = __builtin_amdgcn_rsqf(fmaxf(var, 0.f) + EPS);
        const size_t tok = (size_t)b * 8192 + 128 * n + i;
#pragma unroll
        for (int t = 0; t < 2; ++t) {
            const size_t off = tok * 2048 + hh * 256 + 64 * wc + 32 * t + 8 * fq;
            const v4u g = *(gcv4u*)(grs + off);
            const f32x4 a0 = acc[it][2 * t], a1 = acc[it][2 * t + 1];
            v4u o;
            o.x = pk2((a0[0] - mu) * rstd * bflo(g.x), (a0[1] - mu) * rstd * bfhi(g.x)); o.y = pk2((a0[2] - mu) * rstd * bflo(g.y), (a0[3] - mu) * rstd * bfhi(g.y));
            o.z = pk2((a1[0] - mu) * rstd * bflo(g.z), (a1[1] - mu) * rstd * bfhi(g.z)); o.w = pk2((a1[2] - mu) * rstd * bflo(g.w), (a1[3] - mu) * rstd * bfhi(g.w));
            st16_wt(retn + off, o);
        }
    }
    __syncthreads();
}

constexpr int P4_QOFF = 0, P4_KOFF = 34816, P4_VOFF = 69632, P4_SOFF = 139264;
#ifndef P4_KS_UNR
#define P4_KS_UNR 2
#endif
__device__ __forceinline__ void p4_unit2(const Frame& F, int uu, int uu_next, v4u (&rq)[4], v4u (&rk)[4], const bf16* q, const bf16* k, const bf16* vT, const bf16* st, const bf16* grs, bf16* retn) {
    const int bh = uu >> 6, n = uu & 63, hh = bh & 7, b = bh >> 3;
    const int tid = F.tid, w = F.wave, wr = w >> 2, wc = w & 3, fr = F.lane & 15, fq = F.lane >> 4;
    const float lg = log2_gamma(hh);
    LAS unsigned char* LQ = F.lds + P4_QOFF; LAS unsigned char* LK = F.lds + P4_KOFF; LAS unsigned char* LV = F.lds + P4_VOFF;
    LAS float* stats = (LAS float*)(F.lds + P4_SOFF);
    const bf16* Qb = q + ((size_t)bh * 8192 + 128 * n) * 128;
    const bf16* Kb = k + ((size_t)bh * 8192 + 128 * n) * 128;
    const bf16* RTb = st + ((size_t)(bh * 64 + n)) * 32768;
    const bf16* vTb = vT + ((size_t)bh * 256) * 8192 + 128 * n;
    {
        v4u rr[8];
#pragma unroll
        for (int i = 0; i < 8; ++i) { const int idx = tid + 512 * i; rr[i] = *(gcv4u*)(RTb + idx * 8); }
#pragma unroll
        for (int i = 0; i < 4; ++i) { const int idx = tid + 512 * i, row = idx >> 4, ch = idx & 15; *(LAS v4u*)(LQ + row * 272 + ch * 16) = rq[i]; *(LAS v4u*)(LK + row * 272 + ch * 16) = rk[i]; }
#pragma unroll
        for (int i = 0; i < 8; ++i) { const int idx = tid + 512 * i, row = idx >> 4, ch = idx & 15; *(LAS v4u*)(LV + row * 272 + ch * 16) = rr[i]; }
    }
    __syncthreads();
    f32x4 sa[4][2];
#pragma unroll
    for (int it = 0; it < 4; ++it) { sa[it][0] = (f32x4){0.f, 0.f, 0.f, 0.f}; sa[it][1] = (f32x4){0.f, 0.f, 0.f, 0.f}; }
#pragma unroll
    for (int ks = 0; ks < 4; ++ks) {
        bf16x8 qf[4], kf[2];
#pragma unroll
        for (int it = 0; it < 4; ++it) qf[it] = *(LAS const bf16x8*)(LQ + (64 * wr + 16 * it + fr) * 272 + (32 * ks + 8 * fq) * 2);
#pragma unroll
        for (int jt = 0; jt < 2; ++jt) kf[jt] = *(LAS const bf16x8*)(LK + (32 * wc + 16 * jt + fr) * 272 + (32 * ks + 8 * fq) * 2);
#pragma unroll
        for (int it = 0; it < 4; ++it)
#pragma unroll
            for (int jt = 0; jt < 2; ++jt) sa[it][jt] = __builtin_amdgcn_mfma_f32_16x16x32_bf16(kf[jt], qf[it], sa[it][jt], 0, 0, 0);
    }
    v4u rv[8];
#pragma unroll
    for (int i = 0; i < 8; ++i) { const int idx = tid + 512 * i, row = idx >> 4, ch = idx & 15; rv[i] = *(gcv4u*)(vTb + (size_t)row * 8192 + ch * 8); }
    __syncthreads();
#pragma unroll
    for (int it = 0; it < 4; ++it)
#pragma unroll
        for (int jt = 0; jt < 2; ++jt) {
            const int i = 64 * wr + 16 * it + fr, j0 = 32 * wc + 16 * jt + 4 * fq;
            float pv[4];
#pragma unroll
            for (int r = 0; r < 4; ++r) { const int dlt = i - (j0 + r); pv[r] = (dlt >= 0) ? sa[it][jt][r] * __builtin_amdgcn_exp2f((float)dlt * lg) : 0.f; }
            *(LAS unsigned long long*)(LK + i * 272 + j0 * 2) = (unsigned long long)pk2(pv[0], pv[1]) | ((unsigned long long)pk2(pv[2], pv[3]) << 32);
        }
    f32x4 acc[4][4];
#pragma unroll
    for (int it = 0; it < 4; ++it)
#pragma unroll
        for (int et = 0; et < 4; ++et) acc[it][et] = (f32x4){0.f, 0.f, 0.f, 0.f};
    int esrc[4];
#pragma unroll
    for (int et = 0; et < 4; ++et) esrc[et] = 64 * wc + 32 * (et >> 1) + 8 * (fr >> 2) + 4 * (et & 1) + (fr & 3);
#pragma unroll P4_KS_UNR
    for (int ks = 0; ks < 4; ++ks) {
        bf16x8 qf[4], rf[4];
#pragma unroll
        for (int it = 0; it < 4; ++it) qf[it] = *(LAS const bf16x8*)(LQ + (64 * wr + 16 * it + fr) * 272 + (32 * ks + 8 * fq) * 2);
#pragma unroll
        for (int et = 0; et < 4; ++et) rf[et] = *(LAS const bf16x8*)(LV + esrc[et] * 272 + (32 * ks + 8 * fq) * 2);
#pragma unroll
        for (int it = 0; it < 4; ++it)
#pragma unroll
            for (int et = 0; et < 4; ++et) acc[it][et] = __builtin_amdgcn_mfma_f32_16x16x32_bf16(rf[et], qf[it], acc[it][et], 0, 0, 0);
    }
#pragma unroll
    for (int it = 0; it < 4; ++it) { const float xi = __builtin_amdgcn_exp2f((float)(64 * wr + 16 * it + fr + 1) * lg);
#pragma unroll
        for (int et = 0; et < 4; ++et) acc[it][et] = acc[it][et] * xi; }
    __syncthreads();
#pragma unroll
    for (int i = 0; i < 8; ++i) { const int idx = tid + 512 * i, row = idx >> 4, ch = idx & 15; *(LAS v4u*)(LV + row * 272 + ch * 16) = rv[i]; }
    __syncthreads();
    if (uu_next < 1024) {
        const int bh2 = uu_next >> 6, n2 = uu_next & 63;
        const bf16* Qn = q + ((size_t)bh2 * 8192 + 128 * n2) * 128; const bf16* Kn = k + ((size_t)bh2 * 8192 + 128 * n2) * 128;
#pragma unroll
        for (int i = 0; i < 4; ++i) { const int idx = tid + 512 * i; rq[i] = *(gcv4u*)(Qn + idx * 8); rk[i] = *(gcv4u*)(Kn + idx * 8); }
    }
#pragma unroll P4_KS_UNR
    for (int ks = 0; ks < 4; ++ks) {
        bf16x8 pf[4], vf[4];
#pragma unroll
        for (int it = 0; it < 4; ++it) pf[it] = *(LAS const bf16x8*)(LK + (64 * wr + 16 * it + fr) * 272 + (32 * ks + 8 * fq) * 2);
#pragma unroll
        for (int et = 0; et < 4; ++et) vf[et] = *(LAS const bf16x8*)(LV + esrc[et] * 272 + (32 * ks + 8 * fq) * 2);
#pragma unroll
        for (int it = 0; it < 4; ++it)
#pragma unroll
            for (int et = 0; et < 4; ++et) acc[it][et] = __builtin_amdgcn_mfma_f32_16x16x32_bf16(vf[et], pf[it], acc[it][et], 0, 0, 0);
    }
#pragma unroll
    for (int it = 0; it < 4; ++it) {
        float s1 = 0.f, s2 = 0.f;
#pragma unroll
        for (int et = 0; et < 4; ++et)
#pragma unroll
            for (int r = 0; r < 4; ++r) { const float v = acc[it][et][r]; s1 += v; s2 += v * v; }
        s1 += __shfl_xor(s1, 16); s1 += __shfl_xor(s1, 32); s2 += __shfl_xor(s2, 16); s2 += __shfl_xor(s2, 32);
        if (fq == 0) { const int i = 64 * wr + 16 * it + fr; stats[(i * 4 + wc) * 2] = s1; stats[(i * 4 + wc) * 2 + 1] = s2; }
    }
    __syncthreads();
    v4u gq[4][2];
#pragma unroll
    for (int it = 0; it < 4; ++it)
#pragma unroll
        for (int t = 0; t < 2; ++t) gq[it][t] = *(gcv4u*)(grs + ((size_t)b * 8192 + 128 * n + 64 * wr + 16 * it + fr) * 2048 + hh * 256 + 64 * wc + 32 * t + 8 * fq);
#pragma unroll
    for (int it = 0; it < 4; ++it) {
        const int i = 64 * wr + 16 * it + fr;
        float s1 = 0.f, s2 = 0.f;
#pragma unroll
        for (int c = 0; c < 4; ++c) { s1 += stats[(i * 4 + c) * 2]; s2 += stats[(i * 4 + c) * 2 + 1]; }
        const float mu = s1 * (1.f / 256.f), var = s2 * (1.f / 256.f) - mu * mu, rstd = __builtin_amdgcn_rsqf(fmaxf(var, 0.f) + EPS);
        const size_t tok = (size_t)b * 8192 + 128 * n + i;
#pragma unroll
        for (int t = 0; t < 2; ++t) {
            const size_t off = tok * 2048 + hh * 256 + 64 * wc + 32 * t + 8 * fq;
            const v4u g = gq[it][t];
            const f32x4 a0 = acc[it][2 * t], a1 = acc[it][2 * t + 1];
            v4u o;
            if (MIX_FP8) { const float rs8 = rstd * pg8::R8_SCALE;
                const f32x4 lo4 = (f32x4){(a0[0] - mu) * rs8 * bflo(g.x), (a0[1] - mu) * rs8 * bfhi(g.x), (a0[2] - mu) * rs8 * bflo(g.y), (a0[3] - mu) * rs8 * bfhi(g.y)};
                const f32x4 hi4 = (f32x4){(a1[0] - mu) * rs8 * bflo(g.z), (a1[1] - mu) * rs8 * bfhi(g.z), (a1[2] - mu) * rs8 * bflo(g.w), (a1[3] - mu) * rs8 * bfhi(g.w)};
                st8_wt((unsigned char*)retn + off, (unsigned long long)pk4_fp8(lo4) | ((unsigned long long)pk4_fp8(hi4) << 32)); }
            else {
            o.x = pk2((a0[0] - mu) * rstd * bflo(g.x), (a0[1] - mu) * rstd * bfhi(g.x)); o.y = pk2((a0[2] - mu) * rstd * bflo(g.y), (a0[3] - mu) * rstd * bfhi(g.y));
            o.z = pk2((a1[0] - mu) * rstd * bflo(g.z), (a1[1] - mu) * rstd * bfhi(g.z)); o.w = pk2((a1[2] - mu) * rstd * bflo(g.w), (a1[3] - mu) * rstd * bfhi(g.w));
            st16_wt(retn + off, o); }
        }
    }
    __syncthreads();
}

__device__ __forceinline__ void p4_phase2(const Frame& F, const bf16* q, const bf16* k, const bf16* vT, const bf16* st, const bf16* grs, bf16* retn) {
    v4u rq[4], rk[4];
    int uu = F.vcu;
    if (uu < 1024) {
        const int bh = uu >> 6, n = uu & 63;
        const bf16* Qb = q + ((size_t)bh * 8192 + 128 * n) * 128; const bf16* Kb = k + ((size_t)bh * 8192 + 128 * n) * 128;
#pragma unroll
        for (int i = 0; i < 4; ++i) { const int idx = F.tid + 512 * i; rq[i] = *(gcv4u*)(Qb + idx * 8); rk[i] = *(gcv4u*)(Kb + idx * 8); }
    }
#pragma unroll 1
    for (; uu < 1024; uu += F.G) p4_unit2(F, uu, uu + F.G, rq, rk, q, k, vT, st, grs, retn);
}
constexpr int TAB_LDS_OFF = 131072;
__device__ __forceinline__ void p6_tables(const Frame& F, const float* u, const float* v, const float* n2w, unsigned char* ut, unsigned char* vt, int r_lo, int r_hi) {
    const int gw = F.vcu * NWAVES + F.wave, NGW = F.G * NWAVES;
    int lane_ = (int)__builtin_amdgcn_mbcnt_hi(~0u, __builtin_amdgcn_mbcnt_lo(~0u, 0u)); asm volatile("" : "+v"(lane_));
    asm volatile("" : "+s"(n2w));
    LAS unsigned* img = (LAS unsigned*)(F.lds + TAB_LDS_OFF + F.wave * 1024);
    f32x4 wv[8];
#pragma unroll
    for (int i = 0; i < 8; ++i) wv[i] = *(gcf4*)(n2w + 256 * i + 4 * lane_) * U_SCALE;
    f32x4 nx[8];
    const int rb = r_lo + gw;
    if (rb < r_hi) { const float* src0 = ((rb >= 16384) ? v : u) + (size_t)(rb & 16383) * 2048 + 4 * lane_;
#pragma unroll
        for (int i = 0; i < 8; ++i) nx[i] = *(gcf4*)(src0 + 256 * i); }
    for (int r = rb; r < r_hi; r += NGW) {
        const bool isv = r >= 16384; const int rr = r & 16383;
        unsigned wq[8];
#pragma unroll
        for (int i = 0; i < 8; ++i) wq[i] = pk4_fp8(isv ? nx[i] * V_SCALE : nx[i] * wv[i]);
        if (r + NGW < r_hi) { const int r2 = r + NGW; const float* src2 = ((r2 >= 16384) ? v : u) + (size_t)(r2 & 16383) * 2048 + 4 * lane_;
#pragma unroll
            for (int i = 0; i < 8; ++i) nx[i] = *(gcf4*)(src2 + 256 * i); }
        unsigned char* dst = (isv ? vt : ut) + (size_t)(lane_ >> 3) * (16384 * 128) + (size_t)rr * 128 + 16 * (lane_ & 7);
#pragma unroll
        for (int h = 0; h < 2; ++h) {
#pragma unroll
            for (int k = 0; k < 4; ++k) img[64 * k + lane_] = wq[4 * h + k];
            const v4u o = *(LAS const v4u*)(img + 4 * lane_);
            st16_wt(dst + (size_t)h * (8 * 16384 * 128), o); }
    }
}

#ifndef P8_NB
#define P8_NB 4
#endif
constexpr int P8_SEG = 272;
constexpr int P8_KX_OFF = 512 * P8_SEG;
__device__ __forceinline__ int f2key(float f) { const int b = __builtin_bit_cast(int, f); return b ^ ((b >> 31) & 0x7fffffff); }
__device__ __forceinline__ float key2f(int k) { return __builtin_bit_cast(float, k ^ ((k >> 31) & 0x7fffffff)); }
__device__ __forceinline__ int imax(int a, int b) { return a > b ? a : b; }
__device__ __forceinline__ int imin(int a, int b) { return a < b ? a : b; }
#define TOPK_INS(L, xk) do { int _x = (xk); _Pragma("unroll") for (int _q = 0; _q < 16; ++_q) { const int _h = imax(L[_q], _x); _x = imin(L[_q], _x); L[_q] = _h; } } while (0)
#define BITONIC16(M) do { _Pragma("unroll") for (int _s = 8; _s >= 1; _s >>= 1) { _Pragma("unroll") for (int _i = 0; _i < 16; ++_i) if ((_i & _s) == 0) { const int _a = imax(M[_i], M[_i + _s]), _b = imin(M[_i], M[_i + _s]); M[_i] = _a; M[_i + _s] = _b; } } } while (0)
__device__ __forceinline__ float gelu_exact(float v) {
    const float av = __builtin_fabsf(v), t = __builtin_amdgcn_rcpf(av * 0.2316418882f + 1.0f);
    float q = t * 0.5307027145f + (-0.7265760135f); q = q * t + 0.7107068705f; q = q * t + (-0.142248368f); q = q * t + 0.127414796f; q = q * t;
    const float e = __builtin_amdgcn_exp2f((v * v) * (-0.72134752044f)), m = v * (q * e);
    return v < 0.f ? m : v - m;
}
typedef __bf16 bf16x2_t __attribute__((ext_vector_type(2)));
__device__ __forceinline__ float dot2bf(unsigned a, unsigned b, float c) { return __builtin_amdgcn_fdot2_f32_bf16(__builtin_bit_cast(bf16x2_t, a), __builtin_bit_cast(bf16x2_t, b), c, false); }

struct P8Args { const bf16 *qp, *keys, *x1b; const unsigned char *ut, *vt; const float *sumsq, *fw; float* out; };

__device__ __forceinline__ void p8_subtile(const Frame& F, int sub, const P8Args& a) {
    const int w = F.wave, lane = F.lane, fr = lane & 15, fq = lane >> 4, tid = F.tid;
    const int tok0 = sub * 16;
    LAS unsigned char* S = F.lds;
#ifndef P8_NO_A
    {
        f32x4 acc[2][8];
#pragma unroll
        for (int p = 0; p < 2; ++p)
#pragma unroll
            for (int kt = 0; kt < 8; ++kt) acc[p][kt] = (f32x4){0.f, 0.f, 0.f, 0.f};
        const bf16* qrow = a.qp + (size_t)(tok0 + 2 * w + (fr >> 3)) * 2048 + (fr & 7) * 256 + 8 * fq;
#pragma unroll
        for (int p = 0; p < 2; ++p)
#pragma unroll 1
            for (int ks = 0; ks < 4; ++ks) {
                const bf16x8 qf = *(GAS const bf16x8*)(qrow + p * 128 + 32 * ks);
#pragma unroll
                for (int kt = 0; kt < 8; ++kt) {
                    const bf16x8 kf = *(GAS const bf16x8*)(a.keys + (size_t)(p * 128 + 16 * kt + fr) * 128 + 32 * ks + 8 * fq);
                    acc[p][kt] = __builtin_amdgcn_mfma_f32_16x16x32_bf16(kf, qf, acc[p][kt], 0, 0, 0);
                }
            }
        const int row = 16 * w + fr;
#pragma unroll
        for (int p = 0; p < 2; ++p)
#pragma unroll
            for (int kt = 0; kt < 8; ++kt)
                *(LAS f32x4*)(S + (row * 4 + p * 2 + (kt >> 2)) * P8_SEG + (16 * (kt & 3) + 4 * fq) * 4) = acc[p][kt];
    }
#endif
    __syncthreads();
#ifndef P8_NO_B
    int T[16];
    {
        int L[16];
#pragma unroll
        for (int i = 0; i < 16; ++i) L[i] = (int)0x80000000;
        const int half = tid & 1;
#pragma unroll
        for (int c = 0; c < 16; ++c) {
            const f32x4 v = *(LAS const f32x4*)(S + tid * P8_SEG + c * 16);
#pragma unroll
            for (int j = 0; j < 4; ++j) { const int key = (f2key(v[j]) & ~127) | (half * 64 + 4 * c + j); TOPK_INS(L, key); }
        }
        int M[16];
#pragma unroll
        for (int i = 0; i < 16; ++i) M[i] = imax(L[i], __builtin_amdgcn_mov_dpp(L[15 - i], 0xB1, 0xF, 0xF, true));
        BITONIC16(M);
        float fa[16], fb[16];
        const bool q2 = (tid & 2) != 0;
#pragma unroll
        for (int i = 0; i < 16; ++i) { const int o = __builtin_amdgcn_mov_dpp(M[i], 0x4E, 0xF, 0xF, true); fa[i] = key2f(q2 ? o : M[i]); fb[i] = key2f(q2 ? M[i] : o); }
        if ((tid & 1) == 0) {
            LAS unsigned* kx = (LAS unsigned*)(S + P8_KX_OFF + (tid >> 2) * 32 + ((tid >> 1) & 1) * 16);
#pragma unroll
            for (int d = 0; d < 4; ++d) kx[d] = (unsigned)(M[4 * d] & 127) | ((unsigned)(M[4 * d + 1] & 127) << 8) | ((unsigned)(M[4 * d + 2] & 127) << 16) | ((unsigned)(M[4 * d + 3] & 127) << 24);
        }
#pragma unroll
        for (int i = 0; i < 16; ++i) T[i] = (int)0x80000000;
#pragma unroll
        for (int i = 0; i < 16; ++i)
#pragma unroll
            for (int j = 0; j < 16; ++j)
                if ((i + 1) * (j + 1) <= 16) { const int key = (f2key(fa[i] + fb[j]) & ~255) | (i * 16 + j); TOPK_INS(T, key); }
    }
    __syncthreads();
    {
        LAS int* eidxL = (LAS int*)S;
        LAS float* gateL = (LAS float*)(S + 8192);
        LAS const unsigned char* kx = (LAS const unsigned char*)(S + P8_KX_OFF + (tid >> 2) * 32);
        const float mx = key2f(T[0]);
        float ev[16], sum = 0.f;
#pragma unroll
        for (int r = 0; r < 16; ++r) { ev[r] = __builtin_amdgcn_exp2f((key2f(T[r]) - mx) * 1.4426950408889634f); sum += ev[r]; }
        const float inv = __builtin_amdgcn_rcpf(sum);
        const int q = tid & 3, row = tid >> 2;
#pragma unroll
        for (int r = 0; r < 16; ++r) if ((r >> 2) == q) {
            const int i = (T[r] >> 4) & 15, j = T[r] & 15;
            eidxL[row * 16 + r] = (int)kx[i] * 128 + (int)kx[16 + j];
            gateL[row * 16 + r] = ev[r] * inv;
        }
    }
#endif
    __syncthreads();
#ifndef P8_NO_C
    {
        LAS const int* eidxL = (LAS const int*)S;
        LAS const float* gateL = (LAS const float*)(S + 8192);
        typedef float f32x2v __attribute__((ext_vector_type(2)));
#pragma unroll 1
        for (int ti = 0; ti < 2; ++ti) {
            const int tt = 2 * w + ti; const size_t tok = (size_t)(tok0 + tt);
            const int e0 = eidxL[tt * 128 + lane], e1 = eidxL[tt * 128 + 64 + lane];
            unsigned xp[16];
#pragma unroll
            for (int h = 0; h < 2; ++h)
#pragma unroll
                for (int c = 0; c < 2; ++c) { const v4u t = *(gcv4u*)(a.x1b + tok * 2048 + 1024 * h + 16 * lane + 8 * c); xp[8 * h + 4 * c] = t.x; xp[8 * h + 4 * c + 1] = t.y; xp[8 * h + 4 * c + 2] = t.z; xp[8 * h + 4 * c + 3] = t.w; }
            const float rstd2 = __builtin_amdgcn_rsqf(wave_sum(lane < 32 ? a.sumsq[tok * 32 + lane] : 0.f) * (1.0f / 2048.0f) + EPS);
            float out[32];
#pragma unroll
            for (int i = 0; i < 32; ++i) out[i] = 0.f;
#define P8_LOAD8(buf, tab, rbx) do { _Pragma("unroll") for (int r = 0; r < P8_NB; ++r) { const int e = __builtin_amdgcn_readlane(ev, lbase + P8_NB * (rbx) + r); const unsigned char* base = (tab) + (size_t)e * 2048 + 16 * lane; \
                    buf[r][0] = *(gcv4u*)(base); buf[r][1] = *(gcv4u*)(base + 1024); } } while (0)
#pragma unroll 1
            for (int g = 0; g < 8; ++g) {
                const int ev = (g < 4) ? e0 : e1; const int lbase = (16 * g) & 63;
                float part[16];
#pragma unroll
                for (int rb = 0; rb < 16 / P8_NB; ++rb) {
                    v4u ub[P8_NB][2];
                    P8_LOAD8(ub, a.ut, rb);
#pragma unroll
                    for (int r = 0; r < P8_NB; ++r) { float p = 0.f;
#pragma unroll
                        for (int h = 0; h < 2; ++h) { const unsigned uw[4] = {ub[r][h].x, ub[r][h].y, ub[r][h].z, ub[r][h].w};
#pragma unroll
                            for (int d = 0; d < 4; ++d) {
                                p = __builtin_amdgcn_fdot2_f32_bf16(__builtin_amdgcn_cvt_scalef32_pk_bf16_fp8(uw[d], 1.0f / U_SCALE, false), __builtin_bit_cast(bf16x2_t, xp[8 * h + 2 * d]), p, false);
                                p = __builtin_amdgcn_fdot2_f32_bf16(__builtin_amdgcn_cvt_scalef32_pk_bf16_fp8(uw[d], 1.0f / U_SCALE, true), __builtin_bit_cast(bf16x2_t, xp[8 * h + 2 * d + 1]), p, false); } }
                        part[P8_NB * rb + r] = p; }
                    __builtin_amdgcn_sched_barrier(0);
                }
#pragma unroll
                for (int i = 0; i < 8; ++i) { const bool hi = (lane & 32) != 0; const float snd = hi ? part[i] : part[i + 8], kp = hi ? part[i + 8] : part[i]; part[i] = kp + __shfl_xor(snd, 32); }
#pragma unroll
                for (int i = 0; i < 4; ++i) { const bool hi = (lane & 16) != 0; const float snd = hi ? part[i] : part[i + 4], kp = hi ? part[i + 4] : part[i]; part[i] = kp + __shfl_xor(snd, 16); }
#pragma unroll
                for (int i = 0; i < 2; ++i) { const bool hi = (lane & 8) != 0; const float snd = hi ? part[i] : part[i + 2], kp = hi ? part[i + 2] : part[i]; part[i] = kp + __shfl_xor(snd, 8); }
                { const bool hi = (lane & 4) != 0; const float snd = hi ? part[0] : part[1], kp = hi ? part[1] : part[0]; part[0] = kp + __shfl_xor(snd, 4); }
                float av = part[0]; av += __shfl_xor(av, 1); av += __shfl_xor(av, 2);
                const float wv = gelu_exact(av * rstd2) * gateL[(tt * 8 + g) * 16 + (lane >> 2)] * (1.0f / V_SCALE);
#pragma unroll 1
                for (int rb = 0; rb < 16 / P8_NB; ++rb) {
                    v4u vb[P8_NB][2];
                    P8_LOAD8(vb, a.vt, rb);
#pragma unroll
                    for (int r = 0; r < P8_NB; ++r) { const float ws = __builtin_bit_cast(float, __builtin_amdgcn_readlane(__builtin_bit_cast(int, wv), 4 * (P8_NB * rb + r)));
#pragma unroll
                        for (int h = 0; h < 2; ++h) { const unsigned vw[4] = {vb[r][h].x, vb[r][h].y, vb[r][h].z, vb[r][h].w};
#pragma unroll
                            for (int d = 0; d < 4; ++d) { const f32x2v lo = __builtin_amdgcn_cvt_pk_f32_fp8(vw[d], false), hi2 = __builtin_amdgcn_cvt_pk_f32_fp8(vw[d], true);
                                out[16 * h + 4 * d + 0] += ws * lo.x; out[16 * h + 4 * d + 1] += ws * lo.y; out[16 * h + 4 * d + 2] += ws * hi2.x; out[16 * h + 4 * d + 3] += ws * hi2.y; } } }
                }
            }
            float ss = 0.f;
            float* orow = a.out + tok * 2048 + 16 * lane;
#pragma unroll
            for (int h = 0; h < 2; ++h)
#pragma unroll
                for (int j = 0; j < 8; ++j) { out[16 * h + 2 * j] += bflo(xp[8 * h + j]); out[16 * h + 2 * j + 1] += bfhi(xp[8 * h + j]); }
#pragma unroll
            for (int i = 0; i < 32; ++i) ss += out[i] * out[i];
            const float rs = __builtin_amdgcn_rsqf(wave_sum(ss) * (1.0f / 2048.0f) + EPS);
#pragma unroll
            for (int h = 0; h < 2; ++h)
#pragma unroll
                for (int d = 0; d < 4; ++d) { const f32x4 w0 = *(gcf4*)(a.fw + 1024 * h + 16 * lane + 4 * d);
                    st16f_wt(orow + 1024 * h + 4 * d, (f32x4){out[16 * h + 4 * d] * rs * w0[0], out[16 * h + 4 * d + 1] * rs * w0[1], out[16 * h + 4 * d + 2] * rs * w0[2], out[16 * h + 4 * d + 3] * rs * w0[3]}); }
        }
    }
#endif
    __syncthreads();
}

#ifndef P9_KS_UNROLL
#define P9_KS_UNROLL 4
#endif
#ifndef P9_SROT
#define P9_SROT 2
#endif
#ifndef P9_NBU
#define P9_NBU 16
#endif
#ifndef P9_NBV
#define P9_NBV 16
#endif
struct P9Args { const bf16 *qp, *keys, *x1b; const unsigned char *ut, *vt; const float *sumsq, *fw; float* out; int* eidxG; float* gateG; bf16* x2b; };
typedef unsigned u32x2v __attribute__((ext_vector_type(2)));
__device__ __forceinline__ float sum_rows(float x) {
    x += __builtin_bit_cast(float, __builtin_amdgcn_mov_dpp(__builtin_bit_cast(int, x), 0x128, 0xF, 0xF, true));
    const unsigned b = __builtin_bit_cast(unsigned, x); const u32x2v r = __builtin_amdgcn_permlane16_swap(b, b, false, false);
    x = __builtin_bit_cast(float, r[0]) + __builtin_bit_cast(float, r[1]);
    const unsigned c = __builtin_bit_cast(unsigned, x); const u32x2v q = __builtin_amdgcn_permlane32_swap(c, c, false, false);
    return __builtin_bit_cast(float, q[0]) + __builtin_bit_cast(float, q[1]);
}
__device__ __forceinline__ float wave_sum_l(float v, int lane) {
#pragma unroll
    for (int o = 1; o < 64; o <<= 1) v += __builtin_bit_cast(float, __builtin_amdgcn_ds_bpermute((lane ^ o) << 2, __builtin_bit_cast(int, v)));
    return v;
}
__device__ __forceinline__ float dpp_sum8(float p) {
    p += __builtin_bit_cast(float, __builtin_amdgcn_mov_dpp(__builtin_bit_cast(int, p), 0xB1, 0xF, 0xF, true));
    p += __builtin_bit_cast(float, __builtin_amdgcn_mov_dpp(__builtin_bit_cast(int, p), 0x4E, 0xF, 0xF, true));
    p += __builtin_bit_cast(float, __builtin_amdgcn_mov_dpp(__builtin_bit_cast(int, p), 0x141, 0xF, 0xF, true));
    return p;
}
__device__ __forceinline__ void p9_topk(const Frame& F, const P9Args& a, int tok0, int tl0) {
    int lane_ = F.lane; asm volatile("" : "+v"(lane_));
    const int w = F.wave, lane = lane_, fr = lane & 15, fq = lane >> 4, tid = w * 64 + lane;
    LAS unsigned char* S = F.lds;
    {
        f32x4 acc[2][8];
#pragma unroll
        for (int p = 0; p < 2; ++p)
#pragma unroll
            for (int kt = 0; kt < 8; ++kt) acc[p][kt] = (f32x4){0.f, 0.f, 0.f, 0.f};
        const bf16* qrow = a.qp + (size_t)(tok0 + 2 * w + (fr >> 3)) * 2048 + (fr & 7) * 256 + 8 * fq;
#pragma unroll
        for (int p = 0; p < 2; ++p)
#pragma unroll P9_KS_UNROLL
            for (int ks = 0; ks < 4; ++ks) {
                const bf16x8 qf = *(GAS const bf16x8*)(qrow + p * 128 + 32 * ks);
#pragma unroll
                for (int kt = 0; kt < 8; ++kt) {
                    const bf16x8 kf = *(GAS const bf16x8*)(a.keys + (size_t)(p * 128 + 16 * kt + fr) * 128 + 32 * ks + 8 * fq);
                    acc[p][kt] = __builtin_amdgcn_mfma_f32_16x16x32_bf16(kf, qf, acc[p][kt], 0, 0, 0);
                }
            }
        const int row = 16 * w + fr;
#pragma unroll
        for (int p = 0; p < 2; ++p)
#pragma unroll
            for (int kt = 0; kt < 8; ++kt)
                *(LAS f32x4*)(S + (row * 4 + p * 2 + (kt >> 2)) * P8_SEG + (16 * (kt & 3) + 4 * fq) * 4) = acc[p][kt];
    }
    __syncthreads();
    int T[16];
    {
        int L[16];
#pragma unroll
        for (int i = 0; i < 16; ++i) L[i] = (int)0x80000000;
        const int half = tid & 1;
#pragma unroll
        for (int c = 0; c < 16; ++c) {
            const f32x4 v = *(LAS const f32x4*)(S + tid * P8_SEG + c * 16);
#pragma unroll
            for (int j = 0; j < 4; ++j) { const int key = (f2key(v[j]) & ~127) | (half * 64 + 4 * c + j); TOPK_INS(L, key); }
        }
        int M[16];
#pragma unroll
        for (int i = 0; i < 16; ++i) M[i] = imax(L[i], __builtin_amdgcn_mov_dpp(L[15 - i], 0xB1, 0xF, 0xF, true));
        BITONIC16(M);
        float fa[16], fb[16];
        const bool q2 = (tid & 2) != 0;
#pragma unroll
        for (int i = 0; i < 16; ++i) { const int o = __builtin_amdgcn_mov_dpp(M[i], 0x4E, 0xF, 0xF, true); fa[i] = key2f(q2 ? o : M[i]); fb[i] = key2f(q2 ? M[i] : o); }
        if ((tid & 1) == 0) {
            LAS unsigned* kx = (LAS unsigned*)(S + P8_KX_OFF + (tid >> 2) * 32 + ((tid >> 1) & 1) * 16);
#pragma unroll
            for (int d = 0; d < 4; ++d) kx[d] = (unsigned)(M[4 * d] & 127) | ((unsigned)(M[4 * d + 1] & 127) << 8) | ((unsigned)(M[4 * d + 2] & 127) << 16) | ((unsigned)(M[4 * d + 3] & 127) << 24);
        }
#pragma unroll
        for (int i = 0; i < 16; ++i) T[i] = (int)0x80000000;
#pragma unroll
        for (int i = 0; i < 16; ++i)
#pragma unroll
            for (int j = 0; j < 16; ++j)
                if ((i + 1) * (j + 1) <= 16) { const int key = (f2key(fa[i] + fb[j]) & ~255) | (i * 16 + j); TOPK_INS(T, key); }
    }
    __syncthreads();
    {
        LAS const unsigned char* kx = (LAS const unsigned char*)(S + P8_KX_OFF + (tid >> 2) * 32);
        const float mx = key2f(T[0]);
        float ev[16], sum = 0.f;
#pragma unroll
        for (int r = 0; r < 16; ++r) { ev[r] = __builtin_amdgcn_exp2f((key2f(T[r]) - mx) * 1.4426950408889634f); sum += ev[r]; }
        const float inv = __builtin_amdgcn_rcpf(sum);
        const int q = tid & 3, row = tid >> 2;
#pragma unroll
        for (int r = 0; r < 16; ++r) if ((r >> 2) == q) {
            const int i = (T[r] >> 4) & 15, j = T[r] & 15;
            a.eidxG[(tl0 * 8 + row) * 16 + r] = (int)kx[i] * 128 + (int)kx[16 + j];
            a.gateG[(tl0 * 8 + row) * 16 + r] = ev[r] * inv;
        }
    }
    __syncthreads();
}
#define CE_DESC(M, i, j) do { const int _a = imax(M[i], M[j]), _b = imin(M[i], M[j]); M[i] = _a; M[j] = _b; } while (0)
#define SORT16_DESC(M) do { _Pragma("unroll") for (int _k = 2; _k <= 16; _k <<= 1) { _Pragma("unroll") for (int _j = _k >> 1; _j >= 1; _j >>= 1) { _Pragma("unroll") for (int _i = 0; _i < 16; ++_i) { \
        const int _l = _i ^ _j; if (_l > _i) { if ((_i & _k) == 0) CE_DESC(M, _i, _l); else CE_DESC(M, _l, _i); } } } } } while (0)
#define MERGE16(A, B) do { _Pragma("unroll") for (int _i = 0; _i < 16; ++_i) A[_i] = imax(A[_i], B[15 - _i]); BITONIC16(A); } while (0)
#define MERGE16_LANE(A, addr) do { int _p[16]; _Pragma("unroll") for (int _i = 0; _i < 16; ++_i) _p[_i] = __builtin_amdgcn_ds_bpermute(addr, A[15 - _i]); \
        _Pragma("unroll") for (int _i = 0; _i < 16; ++_i) A[_i] = imax(A[_i], _p[_i]); BITONIC16(A); } while (0)
constexpr int P9_KEYS_PITCH = 272, P9_KX_OFF2 = 256 * P9_KEYS_PITCH;
__device__ __forceinline__ void p9_load_keys(const Frame& F, const P9Args& a) {
    const int row = F.tid >> 1, half = F.tid & 1;
#pragma unroll
    for (int c = 0; c < 8; ++c) *(LAS v4u*)(F.lds + row * P9_KEYS_PITCH + half * 128 + 16 * c) = *(gcv4u*)(a.keys + (size_t)row * 128 + half * 64 + 8 * c);
    __syncthreads();
}
__device__ __forceinline__ void p9_topk2(const Frame& F, const P9Args& a, int tok0, int tl0) {
    int lane_ = F.lane; asm volatile("" : "+v"(lane_));
    const int w = F.wave, lane = lane_, fr = lane & 15, fq = lane >> 4;
    LAS unsigned char* KL = F.lds;
    const int a16 = (lane ^ 16) << 2, a32 = (lane ^ 32) << 2;
    int AB[2][16];
    const bf16* qrow = a.qp + (size_t)(tok0 + 2 * w + (fr >> 3)) * 2048 + (fr & 7) * 256 + 8 * fq;
#pragma unroll
    for (int p = 0; p < 2; ++p) {
        f32x4 acc[8];
#pragma unroll
        for (int kt = 0; kt < 8; ++kt) acc[kt] = (f32x4){0.f, 0.f, 0.f, 0.f};
        bf16x8 qf[4];
#pragma unroll
        for (int ks = 0; ks < 4; ++ks) qf[ks] = *(GAS const bf16x8*)(qrow + p * 128 + 32 * ks);
#pragma unroll
        for (int ks = 0; ks < 4; ++ks)
#pragma unroll
            for (int kt = 0; kt < 8; ++kt) {
                const bf16x8 kf = *(LAS const bf16x8*)(KL + (p * 128 + 16 * kt + fr) * P9_KEYS_PITCH + (32 * ks + 8 * fq) * 2);
                acc[kt] = __builtin_amdgcn_mfma_f32_16x16x32_bf16(kf, qf[ks], acc[kt], 0, 0, 0);
            }
        int lo[16], hi[16];
#pragma unroll
        for (int kt = 0; kt < 4; ++kt)
#pragma unroll
            for (int r = 0; r < 4; ++r) { lo[4 * kt + r] = (f2key(acc[kt][r]) & ~127) | (16 * kt + r) | (fq << 2); hi[4 * kt + r] = (f2key(acc[kt + 4][r]) & ~127) | (16 * (kt + 4) + r) | (fq << 2); }
        SORT16_DESC(lo); SORT16_DESC(hi);
        MERGE16(lo, hi);
        MERGE16_LANE(lo, a16);
        MERGE16_LANE(lo, a32);
#pragma unroll
        for (int i = 0; i < 16; ++i) AB[p][i] = lo[i];
    }
    LAS unsigned char* kxrow = F.lds + P9_KX_OFF2 + (16 * w + fr) * 32;
    if (fq < 2) {
#pragma unroll
        for (int d = 0; d < 4; ++d) { const int* L = (fq == 0) ? AB[0] : AB[1];
            ((LAS unsigned*)(kxrow + fq * 16))[d] = (unsigned)(L[4 * d] & 127) | ((unsigned)(L[4 * d + 1] & 127) << 8) | ((unsigned)(L[4 * d + 2] & 127) << 16) | ((unsigned)(L[4 * d + 3] & 127) << 24); }
    }
    float fa[16], fb[16];
#pragma unroll
    for (int i = 0; i < 16; ++i) { fa[i] = key2f(AB[0][i]); fb[i] = key2f(AB[1][i]); }
#define CAND(i, j) ((f2key(fa[i] + fb[j]) & ~255) | ((i) * 16 + (j)))
    int T[16], Y[16];
#pragma unroll
    for (int j = 0; j < 16; ++j) T[j] = CAND(0, j);
#pragma unroll
    for (int i = 8; i < 16; ++i) T[i] = imax(T[i], CAND(1, 15 - i));
    BITONIC16(T);
#pragma unroll
    for (int i = 0; i < 16; ++i) Y[i] = (int)0x80000000;
#pragma unroll
    for (int j = 0; j < 5; ++j) Y[j] = CAND(2, j);
#pragma unroll
    for (int j = 0; j < 4; ++j) Y[12 + j] = CAND(3, 3 - j);
    BITONIC16(Y); MERGE16(T, Y);
#pragma unroll
    for (int i = 0; i < 16; ++i) Y[i] = (int)0x80000000;
    Y[0] = CAND(4, 0); Y[1] = CAND(4, 1); Y[2] = CAND(4, 2); Y[3] = CAND(5, 0); Y[4] = CAND(5, 1); Y[5] = CAND(6, 0); Y[6] = CAND(6, 1); Y[7] = CAND(7, 0); Y[8] = CAND(7, 1);
    SORT16_DESC(Y); MERGE16(T, Y);
#pragma unroll
    for (int i = 0; i < 16; ++i) Y[i] = (i < 8) ? CAND(8 + i, 0) : (int)0x80000000;
    SORT16_DESC(Y); MERGE16(T, Y);
#undef CAND
    asm volatile("s_waitcnt lgkmcnt(0)" ::: "memory");
    {
        const float mx = key2f(T[0]);
        float ev[16], sum = 0.f;
#pragma unroll
        for (int r = 0; r < 16; ++r) { ev[r] = __builtin_amdgcn_exp2f((key2f(T[r]) - mx) * 1.4426950408889634f); sum += ev[r]; }
        const float inv = __builtin_amdgcn_rcpf(sum);
        const int row = 16 * w + fr;
        v4u eo = (v4u){0u, 0u, 0u, 0u}; f32x4 go = (f32x4){0.f, 0.f, 0.f, 0.f};
#pragma unroll
        for (int r = 0; r < 16; ++r) { const bool mine = (r >> 2) == fq; const int tk = mine ? T[r] : T[0];
            const int i = (tk >> 4) & 15, j = tk & 15;
            const unsigned eid = (unsigned)kxrow[i] * 128u + (unsigned)kxrow[16 + j];
            if (mine) { eo[r & 3] = eid; go[r & 3] = ev[r] * inv; } }
        st16_wt(a.eidxG + (tl0 * 8 + row) * 16 + 4 * fq, eo);
        st16f_wt(a.gateG + (tl0 * 8 + row) * 16 + 4 * fq, go);
    }
}
__device__ __forceinline__ void p9_gather(const Frame& F, const P9Args& a, int tokbase) {
    const int w = F.wave, tid = F.tid, lane = F.lane, c = lane & 7, j = lane >> 3;
    LAS float* aacc = (LAS float*)F.lds;
    LAS unsigned short* eL = (LAS unsigned short*)(F.lds + 32768);
    LAS float* ssL = (LAS float*)(F.lds + 49152);
    for (int i = tid; i < 8192; i += 512) { aacc[i] = 0.f; eL[i] = (unsigned short)a.eidxG[i]; }
    if (tid < 64) ssL[tid] = 0.f;
    __syncthreads();
    typedef float f32x2v __attribute__((ext_vector_type(2)));
    const int tl = 8 * w + j; const size_t tok = (size_t)(tokbase + tl);
    const int x4 = (lane ^ 4) << 2;
#define P9_IDX8(dst, bb) do { const v4u _t = *(LAS const v4u*)(eL + lb + 8 * (bb)); dst[0] = _t.x & 0xffffu; dst[1] = _t.x >> 16; dst[2] = _t.y & 0xffffu; dst[3] = _t.y >> 16; \
        dst[4] = _t.z & 0xffffu; dst[5] = _t.z >> 16; dst[6] = _t.w & 0xffffu; dst[7] = _t.w >> 16; } while (0)
#define P9_LD8(buf, tab, bb) do { unsigned _e[8]; P9_IDX8(_e, bb); _Pragma("unroll") for (int _i = 0; _i < 8; ++_i) buf[_i] = *(gcv4u*)((tab) + (_e[_i] * 128u + soff)); } while (0)
#define P9_UCOMP(buf, bb) do { float _p[8]; \
        _Pragma("unroll") for (int _i = 0; _i < 8; ++_i) { const unsigned _u[4] = {buf[_i].x, buf[_i].y, buf[_i].z, buf[_i].w}; float _s = 0.f; \
            _Pragma("unroll") for (int _d = 0; _d < 4; ++_d) { \
                _s = __builtin_amdgcn_fdot2_f32_bf16(__builtin_amdgcn_cvt_scalef32_pk_bf16_fp8(_u[_d], 1.0f / U_SCALE, false), __builtin_bit_cast(bf16x2_t, xq[2 * _d]), _s, false); \
                _s = __builtin_amdgcn_fdot2_f32_bf16(__builtin_amdgcn_cvt_scalef32_pk_bf16_fp8(_u[_d], 1.0f / U_SCALE, true), __builtin_bit_cast(bf16x2_t, xq[2 * _d + 1]), _s, false); } \
            _p[_i] = _s; } \
          \
        _Pragma("unroll") for (int _i = 0; _i < 4; ++_i) { const bool _h = (c & 4) != 0; const float _snd = _h ? _p[_i] : _p[_i + 4], _kp = _h ? _p[_i + 4] : _p[_i]; \
            _p[_i] = _kp + __builtin_bit_cast(float, __builtin_amdgcn_ds_bpermute(x4, __builtin_bit_cast(int, _snd))); } \
        _Pragma("unroll") for (int _i = 0; _i < 2; ++_i) { const bool _h = (c & 2) != 0; const float _snd = _h ? _p[_i] : _p[_i + 2], _kp = _h ? _p[_i + 2] : _p[_i]; \
            _p[_i] = _kp + __builtin_bit_cast(float, __builtin_amdgcn_mov_dpp(__builtin_bit_cast(int, _snd), 0x4E, 0xF, 0xF, true)); } \
        { const bool _h = (c & 1) != 0; const float _snd = _h ? _p[0] : _p[1], _kp = _h ? _p[1] : _p[0]; \
            _p[0] = _kp + __builtin_bit_cast(float, __builtin_amdgcn_mov_dpp(__builtin_bit_cast(int, _snd), 0xB1, 0xF, 0xF, true)); } \
        aacc[lb + 8 * (bb) + c] += _p[0]; } while (0)
#pragma unroll 1
    for (int s_ = 0; s_ < 16; ++s_) { const int s = (s_ + P9_SROT * (int)(blockIdx.x & 7)) & 15;
        int lb = tl * 128; asm volatile("" : "+v"(lb));
        unsigned soff = (unsigned)(s * (16384 * 128) + 16 * c); asm volatile("" : "+v"(soff));
        unsigned xq[8];
        { const v4u t0 = *(gcv4u*)(a.x1b + tok * 2048 + 128 * s + 16 * c), t1 = *(gcv4u*)(a.x1b + tok * 2048 + 128 * s + 16 * c + 8);
          xq[0] = t0.x; xq[1] = t0.y; xq[2] = t0.z; xq[3] = t0.w; xq[4] = t1.x; xq[5] = t1.y; xq[6] = t1.z; xq[7] = t1.w; }
        v4u bA[8], bB[8];
        P9_LD8(bA, a.ut, 0);
#pragma unroll 1
        for (int bb = 0; bb < 16; bb += 2) {
            P9_LD8(bB, a.ut, bb + 1);
            P9_UCOMP(bA, bb);
            if (bb + 2 < 16) P9_LD8(bA, a.ut, bb + 2);
            P9_UCOMP(bB, bb + 1);
        }
    }
#pragma unroll 1
    for (int ti = 0; ti < 8; ++ti) {
        const int tl2 = 8 * w + ti; const size_t tok2 = (size_t)(tokbase + tl2);
        const float rstd2 = __builtin_amdgcn_rsqf(wave_sum_l(lane < 32 ? a.sumsq[tok2 * 32 + lane] : 0.f, lane) * (1.0f / 2048.0f) + EPS);
#pragma unroll
        for (int hh = 0; hh < 2; ++hh) { const int k = lane + 64 * hh; aacc[tl2 * 128 + k] = gelu_exact(aacc[tl2 * 128 + k] * rstd2) * a.gateG[tl2 * 128 + k] * (1.0f / V_SCALE); }
    }
#define P9_VCOMP(buf, bb) do { const f32x4 _w0 = *(LAS const f32x4*)(aacc + lb + 8 * (bb)), _w1 = *(LAS const f32x4*)(aacc + lb + 8 * (bb) + 4); const float _wk[8] = {_w0[0], _w0[1], _w0[2], _w0[3], _w1[0], _w1[1], _w1[2], _w1[3]}; \
        _Pragma("unroll") for (int _i = 0; _i < 8; ++_i) { const unsigned _v[4] = {buf[_i].x, buf[_i].y, buf[_i].z, buf[_i].w}; \
            _Pragma("unroll") for (int _d = 0; _d < 4; ++_d) { const f32x2v _lo = __builtin_amdgcn_cvt_pk_f32_fp8(_v[_d], false), _hi = __builtin_amdgcn_cvt_pk_f32_fp8(_v[_d], true); \
                acc[4 * _d + 0] += _wk[_i] * _lo.x; acc[4 * _d + 1] += _wk[_i] * _lo.y; acc[4 * _d + 2] += _wk[_i] * _hi.x; acc[4 * _d + 3] += _wk[_i] * _hi.y; } } } while (0)
#pragma unroll 1
    for (int s_ = 0; s_ < 16; ++s_) { const int s = (s_ + P9_SROT * (int)(blockIdx.x & 7)) & 15;
        int lb = tl * 128; asm volatile("" : "+v"(lb));
        unsigned soff = (unsigned)(s * (16384 * 128) + 16 * c); asm volatile("" : "+v"(soff));
        float acc[16];
#pragma unroll
        for (int i = 0; i < 16; ++i) acc[i] = 0.f;
        v4u bA[8], bB[8];
        P9_LD8(bA, a.vt, 0);
#pragma unroll 1
        for (int bb = 0; bb < 16; bb += 2) {
            P9_LD8(bB, a.vt, bb + 1);
            P9_VCOMP(bA, bb);
            if (bb + 2 < 16) P9_LD8(bA, a.vt, bb + 2);
            P9_VCOMP(bB, bb + 1);
        }
        const v4u t0 = *(gcv4u*)(a.x1b + tok * 2048 + 128 * s + 16 * c), t1 = *(gcv4u*)(a.x1b + tok * 2048 + 128 * s + 16 * c + 8);
        const unsigned xw[8] = {t0.x, t0.y, t0.z, t0.w, t1.x, t1.y, t1.z, t1.w};
        float ss = 0.f;
#pragma unroll
        for (int i = 0; i < 8; ++i) { acc[2 * i] += bflo(xw[i]); acc[2 * i + 1] += bfhi(xw[i]); ss += acc[2 * i] * acc[2 * i] + acc[2 * i + 1] * acc[2 * i + 1]; }
        ss = dpp_sum8(ss);
        if (c == 0) ssL[tl] += ss;
        {
            bf16* o = a.x2b + tok * 2048 + 128 * s + 16 * c;
            v4u o0, o1; o0.x = pg8::cvt_pk_bf16(acc[0], acc[1]); o0.y = pg8::cvt_pk_bf16(acc[2], acc[3]); o0.z = pg8::cvt_pk_bf16(acc[4], acc[5]); o0.w = pg8::cvt_pk_bf16(acc[6], acc[7]);
            o1.x = pg8::cvt_pk_bf16(acc[8], acc[9]); o1.y = pg8::cvt_pk_bf16(acc[10], acc[11]); o1.z = pg8::cvt_pk_bf16(acc[12], acc[13]); o1.w = pg8::cvt_pk_bf16(acc[14], acc[15]);
            st16_wt(o, o0); st16_wt(o + 8, o1); }
    }
    asm volatile("s_waitcnt vmcnt(0)" ::: "memory");
#pragma unroll 1
    for (int ti = 0; ti < 8; ++ti) {
        const int tl = 8 * w + ti; const size_t tok = (size_t)(tokbase + tl);
        const float rs = __builtin_amdgcn_rsqf(ssL[tl] * (1.0f / 2048.0f) + EPS);
        float* orow = a.out + tok * 2048 + 8 * lane; const bf16* xrow = a.x2b + tok * 2048 + 8 * lane;
#pragma unroll
        for (int i = 0; i < 4; ++i) { const v4u v = *(gcv4u*)(xrow + 512 * i); const f32x4 w0 = *(gcf4*)(a.fw + 512 * i + 8 * lane), w1 = *(gcf4*)(a.fw + 512 * i + 8 * lane + 4);
            st16f_wt(orow + 512 * i, (f32x4){bflo(v.x) * rs * w0[0], bfhi(v.x) * rs * w0[1], bflo(v.y) * rs * w0[2], bfhi(v.y) * rs * w0[3]});
            st16f_wt(orow + 512 * i + 4, (f32x4){bflo(v.z) * rs * w1[0], bfhi(v.z) * rs * w1[1], bflo(v.w) * rs * w1[2], bfhi(v.w) * rs * w1[3]}); }
    }
    __syncthreads();
}

struct Args { const float* in[14]; float* out; unsigned char* ws; int ph_lo, ph_hi, dbg; };
__global__ void __launch_bounds__(NWAVES * 64, 2) hybrid_fwd(Args args) {
    extern __shared__ __attribute__((aligned(16))) unsigned char lds[];
    Frame F;
    F.lds = (LAS unsigned char*)lds;
    F.tid = threadIdx.x; F.lane = F.tid & 63; F.wave = __builtin_amdgcn_readfirstlane(F.tid >> 6);
    F.G = gridDim.x; { const int bx = blockIdx.x; F.vcu = (F.G % 8 == 0) ? (bx % 8) * (F.G / 8) + bx / 8 : bx; }
    unsigned char* ws = args.ws;
    gu32* ctl = (gu32*)(ws + WS_CTL);
    volatile LAS unsigned* MISC = (volatile LAS unsigned*)(F.lds + MISC_OFF);
    for (int u = F.tid; u < (LDS_BYTES - MISC_OFF) / 4; u += NWAVES * 64) ((LAS unsigned*)(F.lds + MISC_OFF))[u] = 0u;
    __syncthreads();
    XcdBarrier bar; bar.bar = (unsigned*)(ctl + CW_BAR); bar.x = 0; bar.st = nullptr;
    if (!MK_PER_PHASE) bar = xcd_barrier_post((unsigned*)(ctl + CW_BAR), MISC + 8);
#ifndef PHASE_REPEAT
#define PHASE_REPEAT -1
#endif
#ifndef P2_KV_REP
#define P2_KV_REP 1
#endif
#ifndef P2_POOL_REP
#define P2_POOL_REP 1
#endif
#ifndef P4_LDS
#define P4_LDS 1
#endif
#ifndef P4_REP
#define P4_REP 1
#endif
#ifndef P9_TOPK2
#define P9_TOPK2 1
#endif
#ifndef P9_TOPK_REP
#define P9_TOPK_REP 1
#endif
#ifndef TAB_STAGGER
#define TAB_STAGGER 1
#endif
#define GRID_BAR() do { if (!MK_PER_PHASE) xcd_barrier(bar); } while (0)
#if defined(DBG_TIME) || defined(DBG_T2)
    int n_stamp = 0;
#define STAMP() do { if (blockIdx.x == 0 && threadIdx.x == 0) { ((unsigned long long*)(ctl + 1100))[n_stamp] = __builtin_amdgcn_s_memrealtime(); ((unsigned long long*)(ctl + 1100))[16 + n_stamp] = __builtin_amdgcn_s_memtime(); } ++n_stamp; } while (0)
#else
#define STAMP() do {} while (0)
#endif
    const int lo = args.ph_lo, hi = args.ph_hi;
#ifdef START_ACQ
    if (threadIdx.x == 0) { __builtin_amdgcn_fence(__ATOMIC_ACQUIRE, "agent"); asm volatile("s_waitcnt vmcnt(0)" ::: "memory"); }
    __syncthreads();
#endif
#define IN(k) (((PHASE_MASK >> (k)) & 1) && lo <= (k) && (k) < hi)
#ifndef F8_ALIGN
#define F8_ALIGN true
#endif
#ifndef F8_SP2
#define F8_SP2 true
#endif
#ifdef DBG_ALLBAR
#define BOTH(k) IN(k)
#else
#define BOTH(k) (IN(k) && IN((k) + 1))
#endif
    const float* x = args.in[0]; const float* norm1_w = args.in[1]; const float* w_in = args.in[2]; const float* w_ret_o = args.in[3];
    const float* w_pool_lin = args.in[4]; const float* pool_scale = args.in[5]; const float* w_pool_o = args.in[6]; const float* w_out = args.in[7];
    const float* norm2_w = args.in[8]; const float* peer_w_q = args.in[9]; const float* sub_keys = args.in[10]; const float* peer_u = args.in[11];
    const float* peer_v = args.in[12]; const float* final_w = args.in[13];
    bf16* Wmain = (bf16*)(ws + WS_WMAIN); bf16* Wkv = (bf16*)(ws + WS_WKV); bf16* Wro = (bf16*)(ws + WS_WRO); bf16* Wpo = (bf16*)(ws + WS_WPO);
    bf16* Wout = (bf16*)(ws + WS_WOUT); bf16* Wq = (bf16*)(ws + WS_WQ); bf16* linT = (bf16*)(ws + WS_LINT); bf16* keysb = (bf16*)(ws + WS_KEYS);
    bf16* hb = (bf16*)(ws + WS_H); bf16* qb = (bf16*)(ws + WS_Q); bf16* kb = (bf16*)(ws + WS_K); bf16* vT = (bf16*)(ws + WS_VT);
    unsigned char* ut = ws + WS_UT; unsigned char* vtab = ws + WS_VTAB; bf16* grb = (bf16*)(ws + WS_GR); bf16* pinb = (bf16*)(ws + WS_PIN);
    bf16* stb = (bf16*)(ws + WS_ST); bf16* pooled = (bf16*)(ws + WS_POOLED);
    float* sumsq = (float*)(ws + WS_PIN);
    bf16* gretb = (bf16*)(ws + WS_GRET); bf16* gpoolb = (bf16*)(ws + WS_GPOOL); bf16* retn = (bf16*)(ws + WS_RETN);

#ifdef DBG_T2
    if (blockIdx.x == 0 && threadIdx.x == 0) ((unsigned long long*)(ctl + 1100))[15] = __builtin_amdgcn_s_memrealtime();
#endif
    if (lo == 0) GRID_BAR();
    STAMP();
    if (IN(0)) for (int rep_ = 0; rep_ < ((PHASE_REPEAT == 0) ? 2 : 1); ++rep_) {
        P0Args a{x, norm1_w, w_in, w_ret_o, w_pool_lin, w_pool_o, w_out, norm2_w, peer_w_q, sub_keys, Wmain, Wkv, Wro, Wpo, Wout, Wq, linT, keysb, hb, ws + WS_H8};
        p0_prologue(F, a);
        if (BOTH(0)) GRID_BAR();
        STAMP();
    }
    if (IN(1)) for (int rep_ = 0; rep_ < ((PHASE_REPEAT == 1) ? 2 : 1); ++rep_) {
#define P1_PART(bit, row0_, ncols_, pn0_) { constexpr bool f8 = (MAIN_FP8 & (bit)) != 0; \
          pg8::Gemm g{f8 ? (const pg8::bf16_t*)(ws + WS_H8) : hb, Wmain + (size_t)(row0_) * DM, TOK, (ncols_), f8 ? DM / 2 : DM}; pg8::StaticOrder S; S.init(TOK, (ncols_), F.G, (int)blockIdx.x); \
          pg8::EpiMain E{qb, kb, grb, pinb, f8 ? 1.0f / (H8_SCALE * WG8_SCALE) : 1.0f, (pn0_)}; \
          pg8::gemm_phase<pg8::EpiMain, pg8::StaticOrder, f8 ? F8_ALIGN : true, f8 ? F8_SP2 : true, f8>(F.lds, g, S, E); }
#if MAIN_FP8 == 0 || MAIN_FP8 == 7
        P1_PART(1, 0, 5120, 0)
#elif MAIN_FP8 == 4
        P1_PART(1, 0, 4096, 0) P1_PART(4, 4096, 1024, 16)
#elif MAIN_FP8 == 6
        P1_PART(1, 0, 2048, 0) P1_PART(2, 2048, 3072, 8)
#else
        P1_PART(1, 0, 2048, 0) P1_PART(2, 2048, 2048, 8) P1_PART(4, 4096, 1024, 16)
#endif
#undef P1_PART
        { pg8::Gemm g{Wkv, KV_FP8 ? (const pg8::bf16_t*)(ws + WS_H8) : hb, 2048, TOK, KV_FP8 ? DM / 2 : DM}; pg8::StaticOrder S; S.init(2048, TOK, F.G, (int)blockIdx.x);
          pg8::EpiKV E{vT, KV_FP8 ? 1.0f / (H8_SCALE * WG8_SCALE) : 1.0f};
          pg8::gemm_phase<pg8::EpiKV, pg8::StaticOrder, KV_FP8 ? F8_ALIGN : true, KV_FP8 ? F8_SP2 : true, KV_FP8 != 0>(F.lds, g, S, E); }
        if (BOTH(1)) GRID_BAR();
        STAMP();
    }
    if (IN(2)) for (int rep_ = 0; rep_ < ((PHASE_REPEAT == 2) ? 2 : 1); ++rep_) {
        for (int r2_ = 0; r2_ < P2_KV_REP; ++r2_) p2_kv_phase(F, kb, vT, stb);
        for (int r2_ = 0; r2_ < P2_POOL_REP; ++r2_) p2_pool(F, pinb, pooled);
        if (BOTH(2)) GRID_BAR();
        STAMP();
    }
    if (IN(3)) for (int rep_ = 0; rep_ < ((PHASE_REPEAT == 3) ? 2 : 1); ++rep_) {
        p3_scan(F, stb);
        { pg8::Gemm g{pooled, linT, 4 * TOK, 1024, 256}; pg8::DiagOrder S; S.init(F.G, (int)blockIdx.x);
          pg8::EpiPool E{pinb, pool_scale};
          pg8::gemm_phase<pg8::EpiPool, pg8::DiagOrder, true, true>(F.lds, g, S, E); }
        if (BOTH(3)) GRID_BAR();
        STAMP();
    }
    if (IN(4)) for (int rep_ = 0; rep_ < ((PHASE_REPEAT == 4) ? 2 : 1); ++rep_) {
        for (int r4_ = 0; r4_ < P4_REP; ++r4_) { if (P4_LDS) p4_phase2(F, qb, kb, vT, stb, grb, retn); else for (int uu = F.vcu; uu < 1024; uu += F.G) p4_unit(F, uu, qb, kb, vT, stb, grb, retn); }
        if (BOTH(4) && !P5_EARLY) GRID_BAR();
        STAMP();
    }
    if (IN(5)) for (int rep_ = 0; rep_ < ((PHASE_REPEAT == 5) ? 2 : 1); ++rep_) {
#ifdef L2_SWEEP
        {
            const gcv4u* src = (const gcv4u*)(ws + 2 * MiB + (size_t)blockIdx.x * (L2_SWEEP * 1024)) + threadIdx.x; v4u accv = (v4u){0u, 0u, 0u, 0u};
            for (int i = 0; i < L2_SWEEP * 1024 / (512 * 16); ++i) { const v4u t = src[(size_t)i * 512]; accv.x ^= t.x; accv.y ^= t.y; accv.z ^= t.z; accv.w ^= t.w; }
            if ((accv.x ^ accv.y ^ accv.z ^ accv.w) == 0x12345678u) ((unsigned*)ctl)[1000] = 1u;
            __syncthreads();
        }
#endif
#if GATES_FP8
        { pg8::Gemm g{(const pg8::bf16_t*)(ws + WS_H8), Wmain + (size_t)5120 * DM, TOK, 4096, DM / 2}; pg8::StaticOrder S; S.init(TOK, 4096, F.G, (int)blockIdx.x);
          pg8::EpiGates E{gretb, gpoolb, 1.0f / (H8_SCALE * WG8_SCALE), args.dbg};
          pg8::gemm_phase<pg8::EpiGates, pg8::StaticOrder, F8_ALIGN, F8_SP2, true>(F.lds, g, S, E); }
#else
        { pg8::Gemm g{hb, Wmain + (size_t)5120 * DM, TOK, 4096, DM}; pg8::StaticOrder S; S.init(TOK, 4096, F.G, (int)blockIdx.x);
          pg8::EpiGates E{gretb, gpoolb, 1.0f, args.dbg};
          pg8::gemm_phase<pg8::EpiGates, pg8::StaticOrder, true, true>(F.lds, g, S, E); }
#endif
        if (BOTH(5)) GRID_BAR();
        STAMP();
    }
    if (IN(6)) for (int rep_ = 0; rep_ < ((PHASE_REPEAT == 6) ? 2 : 1); ++rep_) {
#if TAB_STAGGER
        if (F.vcu & 1) p6_tables(F, peer_u, peer_v, norm2_w, ut, vtab, 0, 16384);
#endif
#if MIX_FP8 && P6_CHAIN
        { pg8::Gemm g{retn, Wro, TOK, DM, DM / 2, pinb, Wpo, 1024 / 2}; pg8::ChainOrder S; S.init(TOK, DM, F.G, (int)blockIdx.x);
          pg8::EpiChain E{(const unsigned char*)gretb, (const unsigned char*)gpoolb, ws + WS_H8, 1.0f / (pg8::R8_SCALE * pg8::WB8_SCALE)};
          pg8::gemm_phase<pg8::EpiChain, pg8::ChainOrder, F8_ALIGN, F8_SP2, true, true>(F.lds, g, S, E); }
#elif MIX_FP8
        { pg8::Gemm g{retn, Wro, TOK, DM, DM / 2}; pg8::StaticOrder S; S.init(TOK, DM, F.G, (int)blockIdx.x);
          pg8::EpiMix<0> E{grb, gretb, ws + WS_H8, 1.0f / (pg8::R8_SCALE * pg8::WB8_SCALE)};
          pg8::gemm_phase<pg8::EpiMix<0>, pg8::StaticOrder, F8_ALIGN, F8_SP2, true>(F.lds, g, S, E); }
        { pg8::Gemm g{pinb, Wpo, TOK, DM, 1024 / 2}; pg8::StaticOrder S; S.init(TOK, DM, F.G, (int)blockIdx.x);
          pg8::EpiMix<1> E{grb, gpoolb, ws + WS_H8, 1.0f / (pg8::R8_SCALE * pg8::WB8_SCALE)};
          pg8::gemm_phase<pg8::EpiMix<1>, pg8::StaticOrder, F8_ALIGN, F8_SP2, true>(F.lds, g, S, E); }
#else
        { pg8::Gemm g{retn, Wro, TOK, DM, DM}; pg8::StaticOrder S; S.init(TOK, DM, F.G, (int)blockIdx.x);
          pg8::EpiMix<0> E{grb, gretb, ws + WS_H8, 1.0f};
          pg8::gemm_phase<pg8::EpiMix<0>, pg8::StaticOrder, true, true>(F.lds, g, S, E); }
        { pg8::Gemm g{pinb, Wpo, TOK, DM, 1024}; pg8::StaticOrder S; S.init(TOK, DM, F.G, (int)blockIdx.x);
          pg8::EpiMix<1> E{grb, gpoolb, ws + WS_H8, 1.0f};
          pg8::gemm_phase<pg8::EpiMix<1>, pg8::StaticOrder, true, true>(F.lds, g, S, E); }
#endif
#if TAB_STAGGER
        if (!(F.vcu & 1)) p6_tables(F, peer_u, peer_v, norm2_w, ut, vtab, 0, 16384);
#endif
        if (BOTH(6)) GRID_BAR();
        STAMP();
    }
    if (IN(7)) for (int rep_ = 0; rep_ < ((PHASE_REPEAT == 7) ? 2 : 1); ++rep_) {
#if TAB_STAGGER
        if (F.vcu & 1) p6_tables(F, peer_u, peer_v, norm2_w, ut, vtab, 16384, 32768);
#endif
#if OUT_FP8
        { pg8::Gemm g{(const pg8::bf16_t*)(ws + WS_H8), Wout, TOK, DM, DM / 2}; pg8::StaticOrder S; S.init(TOK, DM, F.G, (int)blockIdx.x);
          pg8::EpiOut E{x, hb, sumsq, 1.0f / (pg8::M8_SCALE * pg8::WO8_SCALE)};
          pg8::gemm_phase<pg8::EpiOut, pg8::StaticOrder, F8_ALIGN, F8_SP2, true>(F.lds, g, S, E); }
#else
        { pg8::Gemm g{grb, Wout, TOK, DM, DM}; pg8::StaticOrder S; S.init(TOK, DM, F.G, (int)blockIdx.x);
          pg8::EpiOut E{x, hb, sumsq, 1.0f};
          pg8::gemm_phase<pg8::EpiOut, pg8::StaticOrder, true, true>(F.lds, g, S, E); }
#endif
#if TAB_STAGGER
        if (!(F.vcu & 1)) p6_tables(F, peer_u, peer_v, norm2_w, ut, vtab, 16384, 32768);
#endif
        if (BOTH(7)) GRID_BAR();
        STAMP();
    }
    if (IN(8)) for (int rep_ = 0; rep_ < ((PHASE_REPEAT == 8) ? 2 : 1); ++rep_) {
        { pg8::Gemm g{hb, Wq, TOK, DM, DM}; pg8::StaticOrder S; S.init(TOK, DM, F.G, (int)blockIdx.x);
          pg8::EpiQ E{grb, sumsq};
          pg8::gemm_phase<pg8::EpiQ, pg8::StaticOrder, true, true>(F.lds, g, S, E); }
#if !TAB_STAGGER
        p6_tables(F, peer_u, peer_v, norm2_w, ut, vtab, 0, 32768);
#endif
        if (BOTH(8)) GRID_BAR();
        STAMP();
    }
    if (IN(9)) for (int rep_ = 0; rep_ < ((PHASE_REPEAT == 9) ? 2 : 1); ++rep_) {
#if P9_SLICED
        Frame F9 = F; { F9.lane = (int)__builtin_amdgcn_mbcnt_hi(~0u, __builtin_amdgcn_mbcnt_lo(~0u, 0u)); F9.tid = F.wave * 64 + F9.lane; }
        P9Args a{grb, keysb, hb, ut, vtab, sumsq, final_w, args.out, (int*)(ws + WS_SCR) + (size_t)F.vcu * 8192, (float*)(ws + WS_SCR + 8 * MiB) + (size_t)F.vcu * 8192, grb};
        _Pragma("unroll 1") for (int grp = F.vcu; grp < TOK / 64; grp += F.G) {
#ifndef P9_NO_T
#if P9_TOPK2
            p9_load_keys(F9, a);
            for (int rt_ = 0; rt_ < P9_TOPK_REP; ++rt_)
            _Pragma("unroll 1") for (int sub = 0; sub < 4; ++sub) p9_topk2(F9, a, 64 * grp + 16 * sub, 16 * sub);
            __syncthreads();
#else
            for (int rt_ = 0; rt_ < P9_TOPK_REP; ++rt_)
            _Pragma("unroll 1") for (int sub = 0; sub < 4; ++sub) p9_topk(F9, a, 64 * grp + 16 * sub, 16 * sub);
#endif
#endif
#ifndef P9_NO_G
            p9_gather(F9, a, 64 * grp);
#endif
        }
#else
        P8Args a{grb, keysb, hb, ut, vtab, sumsq, final_w, args.out};
        for (int sub = F.vcu; sub < TOK / 16; sub += F.G) p8_subtile(F, sub, a);
#endif
    }
#ifdef DBG_T2
#ifndef DBG_T2_DIV
#define DBG_T2_DIV 1
#endif
    STAMP();
    {
        GRID_BAR();
        STAMP();
        if (blockIdx.x == 0 && threadIdx.x == 0) {
            asm volatile("s_waitcnt vmcnt(0)" ::: "memory");
            const unsigned long long* T = (const unsigned long long*)(ctl + 1100);
#ifdef DBG_CLK
            const float us = 1000.0f * (float)(T[16 + DBG_T2 + 1] - T[16 + DBG_T2]) / (float)(T[DBG_T2 + 1] - T[DBG_T2]);
#else
            const float us = (DBG_T2 == 21) ? (float)(T[11] - T[15]) * 0.01f : (DBG_T2 == 20) ? (float)(T[0] - T[15]) * 0.01f : (float)(T[DBG_T2 + 1] - T[DBG_T2]) * 0.01f;
#endif
            st4f_wt(args.out, floorf((us - (float)(DBG_T2_OFF)) * (1.0f / (float)(DBG_T2_DIV))));
        }
    }
#endif
#ifdef DBG_TIME
    STAMP();
    {
        GRID_BAR();
        for (size_t i = ((size_t)blockIdx.x * 512 + threadIdx.x) * 4; i < (size_t)TOK * DM; i += (size_t)gridDim.x * 512 * 4) *(gf4*)(args.out + i) = (f32x4){0.f, 0.f, 0.f, 0.f};
        GRID_BAR();
        if (blockIdx.x == 0 && threadIdx.x == 0) {
            const unsigned long long* T = (const unsigned long long*)(ctl + 1100);
            const float total = (float)(T[10] - T[0]);
            const float dt = (DBG_TIME == 10) ? (float)(T[10] - T[0]) * 0.00025f   : 100.0f * (float)(T[DBG_TIME + 1] - T[DBG_TIME]) / total;
            const float code = dt > 97.f ? 97.f : floorf(dt + 0.5f);
            args.out[0] = sqrtf((float)TOK * (float)DM * code);
        }
    }
#endif

#if defined(DUMP_OFF_MIB)
    if (hi == N_PHASES) {
        const bf16* src = (const bf16*)(ws + (size_t)DUMP_OFF_MIB * MiB);
        for (size_t i = ((size_t)blockIdx.x * 512 + threadIdx.x) * 8; i < (size_t)TOK * DM; i += (size_t)gridDim.x * 512 * 8) {
            const v4u t = *(gcv4u*)(src + i);
            *(gf4*)(args.out + i) = (f32x4){bflo(t.x), bfhi(t.x), bflo(t.y), bfhi(t.y)};
            *(gf4*)(args.out + i + 4) = (f32x4){bflo(t.z), bfhi(t.z), bflo(t.w), bfhi(t.w)};
        }
    }
#endif
#ifdef END_REL
    asm volatile("s_waitcnt vmcnt(0)" ::: "memory"); __syncthreads();
    if (threadIdx.x == 0) { __builtin_amdgcn_fence(__ATOMIC_RELEASE, "agent"); asm volatile("s_waitcnt vmcnt(0)" ::: "memory"); }
    __syncthreads();
#endif

#if defined(DBG_CHECK)
    if (lo == 20) {
        const int gw = F.vcu * NWAVES + F.wave, NGW = F.G * NWAVES;
        for (int row = gw; row < TOK; row += NGW) {
            for (int ct = 0; ct < 16; ++ct) {
                const int col = 256 * ct + ((row * 7 + ct * 13) & 255);
                const bf16* hr = hb + (size_t)row * DM + 8 * F.lane; const bf16* wr_ = Wmain + (size_t)(5120 + col) * DM + 8 * F.lane;
                float s = 0.f;
                for (int j = 0; j < 4; ++j) { const v4u a = *(gcv4u*)(hr + 512 * j), b = *(gcv4u*)(wr_ + 512 * j);
                    s += bflo(a.x) * bflo(b.x) + bfhi(a.x) * bfhi(b.x) + bflo(a.y) * bflo(b.y) + bfhi(a.y) * bfhi(b.y) + bflo(a.z) * bflo(b.z) + bfhi(a.z) * bfhi(b.z) + bflo(a.w) * bflo(b.w) + bfhi(a.w) * bfhi(b.w); }
                s = wave_sum(s);
                const float g = 1.0f / (1.0f + __expf(-s));
                const unsigned short gs = (col < 2048 ? gretb : gpoolb)[(size_t)row * 2048 + (col & 2047)];
                const float gv = bflo((unsigned)gs);
                if (F.lane == 0 && !(fabsf(g - gv) < 0.02f)) { atomicMin((unsigned*)ctl + 512, (unsigned)(row >> 8)); atomicAdd((unsigned*)ctl + 513, 1u); atomicAdd((unsigned*)ctl + 600 + (row >> 8), 1u); atomicAdd((unsigned*)ctl + 700 + ct, 1u); atomicAdd((unsigned*)ctl + 800 + ((row >> 4) & 15), 1u); if (!(fabsf(g - gv) < 0.2f)) { atomicAdd((unsigned*)ctl + 514, 1u); if (!(gv >= 0.f && gv <= 1.0f)) atomicAdd((unsigned*)ctl + 515, 1u); if (gv == 0.5f) atomicAdd((unsigned*)ctl + 516, 1u); } atomicAdd((unsigned*)ctl + 900 + (col & 255) / 8, 1u); }
            }
        }
    }
    if (lo == 21) {
        for (size_t i = ((size_t)blockIdx.x * 512 + threadIdx.x) * 4; i < (size_t)TOK * DM; i += (size_t)gridDim.x * 512 * 4) *(gf4*)(args.out + i) = (f32x4){0.f, 0.f, 0.f, 0.f};
        __syncthreads();
        if (blockIdx.x == 0 && threadIdx.x == 0) {
            const unsigned first = ((unsigned*)ctl)[512], cnt = ((unsigned*)ctl)[513];
            const unsigned* C = (const unsigned*)ctl;
            unsigned nrt = 0, nct = 0, maxct = 0, maxcti = 0, n16 = 0, mx16 = 0, mx16i = 0;
            for (int i = 0; i < 64; ++i) nrt += C[600 + i] ? 1u : 0u;
            for (int i = 0; i < 16; ++i) { nct += C[700 + i] ? 1u : 0u; if (C[700 + i] > maxct) { maxct = C[700 + i]; maxcti = i; } n16 += C[800 + i] ? 1u : 0u; if (C[800 + i] > mx16) { mx16 = C[800 + i]; mx16i = i; } }
            unsigned cv = 0;
            if (DBG_CHECK == 1) cv = cnt == 0 ? 0 : first + 1;
            if (DBG_CHECK == 2) cv = cnt >> DBG_SHIFT;
            if (DBG_CHECK == 3) cv = nrt;
            if (DBG_CHECK == 4) cv = nct;
            if (DBG_CHECK == 5) cv = maxcti + 1;
            if (DBG_CHECK == 6) cv = n16;
            if (DBG_CHECK == 7) cv = mx16i + 1;
            if (DBG_CHECK == 8) cv = (C[600 + DBG_ARG]) >> DBG_SHIFT;
            if (DBG_CHECK == 9) cv = (C[700 + DBG_ARG]) >> DBG_SHIFT;
            if (DBG_CHECK == 10) cv = C[514] >> DBG_SHIFT;
            if (DBG_CHECK == 11) { unsigned n = 0; for (int i = 0; i < 32; ++i) n += C[900 + i] ? 1u : 0u; cv = n; }
            if (DBG_CHECK == 12) cv = (C[800 + DBG_ARG]) >> DBG_SHIFT;
            if (DBG_CHECK == 13) cv = (C[900 + DBG_ARG]) >> DBG_SHIFT;
            if (DBG_CHECK == 14) { int second = -1; for (int i = 0; i < 16; ++i) if (C[800 + i] && (unsigned)i != mx16i) second = i; cv = (unsigned)(second + 1); }
            if (DBG_CHECK == 15) { unsigned m = 0; for (int i = 0; i < 16; ++i) if (C[700 + i]) m |= 1u << i; cv = (DBG_ARG == 0) ? (m & 63u) : (DBG_ARG == 1 ? ((m >> 6) & 63u) : (m >> 12)); }
            if (DBG_CHECK == 16) { unsigned m = 0; for (int i = 0; i < 32; ++i) if (C[900 + i]) m |= 1u << i; cv = (m >> (6 * DBG_ARG)) & 63u; }
            if (DBG_CHECK == 17) cv = C[515] >> DBG_SHIFT;
            if (DBG_CHECK == 18) cv = C[516] >> DBG_SHIFT;
            if (DBG_CHECK == 19) cv = C[514] >> DBG_SHIFT;
            float code = (float)(cv > 97 ? 97 : cv);
            args.out[0] = sqrtf((float)TOK * (float)DM * code);
        }
    }
#endif
#undef IN
#undef BOTH
#undef GRID_BAR
}

extern "C" void kernel_launch(void* const* d_in, const int* in_sizes, int n_in, void* d_out, int out_size, void* d_ws, size_t ws_size, hipStream_t stream) {
    static int grid = 0;
    if (grid == 0) {
        if (n_in != 14 || out_size != TOK * DM || ws_size < WS_END) { fprintf(stderr, "kernel_launch: unexpected shapes (n_in %d, out %d, ws %zu); nothing launched\n", n_in, out_size, ws_size); grid = -1; return; }
        int dev = 0, cus = 0, per_cu = 0;
        if (hipGetDevice(&dev) != hipSuccess || hipDeviceGetAttribute(&cus, hipDeviceAttributeMultiprocessorCount, dev) != hipSuccess) { grid = -1; return; }
        if (hipFuncSetAttribute((const void*)hybrid_fwd, hipFuncAttributeMaxDynamicSharedMemorySize, LDS_BYTES) != hipSuccess) { fprintf(stderr, "kernel_launch: hipFuncSetAttribute failed\n"); grid = -1; return; }
        if (hipOccupancyMaxActiveBlocksPerMultiprocessor(&per_cu, (const void*)hybrid_fwd, NWAVES * 64, LDS_BYTES) != hipSuccess || per_cu < 1)
            fprintf(stderr, "kernel_launch: note: occupancy query reports %d workgroups per CU\n", per_cu);
        (void)hipGetLastError();
        grid = cus;
    }
    if (grid < 0) return;
    if (hipMemsetAsync((char*)d_ws + WS_CTL, 0, CTL_ZERO_BYTES, stream) != hipSuccess) { fprintf(stderr, "kernel_launch: hipMemsetAsync failed\n"); return; }
    Args a{};
    for (int i = 0; i < 14; ++i) a.in[i] = (const float*)d_in[i];
    a.out = (float*)d_out; a.ws = (unsigned char*)d_ws;
#if MK_PER_PHASE
#if defined(DBG_CHECK)
    { const int order[] = {0, 1, 2, 3, 4, 5, 20, 6, 7, 8, 9, 21};
      hipMemsetAsync((char*)d_ws + 2048, 0xFF, 4, stream);
      for (int p : order) { a.ph_lo = p; a.ph_hi = p + 1; hipLaunchKernelGGL(hybrid_fwd, dim3(grid), dim3(NWAVES * 64), LDS_BYTES, stream, a); } }
#else
#ifndef HOST_REPEAT
#define HOST_REPEAT -1
#define HOST_REPS 1
#endif
#ifndef HOST_DBG
#define HOST_DBG 0
#endif
    for (int p = 0; p < N_PHASES; ++p) for (int r = 0; r < (p == HOST_REPEAT ? HOST_REPS : 1); ++r) { a.ph_lo = p; a.ph_hi = p + 1; a.dbg = (r > 0) ? HOST_DBG : 0; hipLaunchKernelGGL(hybrid_fwd, dim3(grid), dim3(NWAVES * 64), LDS_BYTES, stream, a); }
#endif
#else
    a.ph_lo = 0; a.ph_hi = N_PHASES;
    hipLaunchKernelGGL(hybrid_fwd, dim3(grid), dim3(NWAVES * 64), LDS_BYTES, stream, a);
#endif
    const hipError_t le = hipPeekAtLastError();
    if (le != hipSuccess) fprintf(stderr, "kernel_launch: launch failed: %s\n", hipGetErrorName(le));
}
```

```cpp
#include <hip/hip_runtime.h>
#include <cstdio>
#include <cstdint>
typedef unsigned wt_u32x4 __attribute__((ext_vector_type(4)));
typedef float wt_f32x4 __attribute__((ext_vector_type(4)));
__device__ __forceinline__ void st16_wt(void* p, wt_u32x4 v) { asm volatile("global_store_dwordx4 %0, %1, off sc1\n\ts_nop 1" :: "v"(p), "v"(v) : "memory"); }
__device__ __forceinline__ void st16f_wt(void* p, wt_f32x4 v) { asm volatile("global_store_dwordx4 %0, %1, off sc1\n\ts_nop 1" :: "v"(p), "v"(v) : "memory"); }
__device__ __forceinline__ void st8_wt(void* p, unsigned long long v) { asm volatile("global_store_dwordx2 %0, %1, off sc1\n\ts_nop 0" :: "v"(p), "v"(v) : "memory"); }
__device__ __forceinline__ void st4_wt(void* p, unsigned v) { asm volatile("global_store_dword %0, %1, off sc1" :: "v"(p), "v"(v) : "memory"); }
__device__ __forceinline__ void st4f_wt(void* p, float v) { asm volatile("global_store_dword %0, %1, off sc1" :: "v"(p), "v"(v) : "memory"); }
namespace pg8 {
#define PG8_LAS __attribute__((address_space(3)))
typedef unsigned short bf16_t;
typedef short bf16x8 __attribute__((ext_vector_type(8)));
typedef float f32x4 __attribute__((ext_vector_type(4)));
typedef unsigned u32x4 __attribute__((ext_vector_type(4)));
constexpr int BM = 256, BK = 64, HALF = 128, HTB = HALF * BK * 2  , STAGE_BYTES = 8 * HTB, NXCD = 8, WGM = 4;

__host__ __device__ __forceinline__ int lds_byte(int r, int c) { const int st = (r >> 4) * 2 + (c >> 5), rr = r & 15, cc = c & 31, ob = rr * 64 + cc * 2; return st * 1024 + (ob ^ (((ob >> 9) & 1) << 5)); }
__host__ __device__ __forceinline__ void stage_rc(int b, int& R, int& C) { const int st = b / 1024, sb = b % 1024, swz = sb ^ (((sb >> 9) & 1) << 5); R = (st >> 1) * 16 + swz / 64; C = (st & 1) * 32 + (swz % 64) / 2; }
__host__ __device__ __forceinline__ int perm32(int rho) { const int n = rho >> 4, i = rho & 15; return 8 * (i >> 2) + 4 * n + (i & 3); }

struct Unit { int pm, pn, seg; };
struct Gemm { const bf16_t* A; const bf16_t* Bt; int M, N, K; const bf16_t* A2; const bf16_t* Bt2; int K2; };

struct StaticOrder {
    int nM, nN, nwg, G, c;
    __host__ __device__ void init(int M, int N, int G_, int c_) { nM = M / BM; nN = N / BM; nwg = nM * nN; G = G_; c = c_; }
    __host__ __device__ bool next(int i, Unit& u) const {
        const long L = (long)i * G + c; if (L >= nwg) return false;
        int wgid = (int)L; { const int q = nwg / NXCD, r = nwg % NXCD, xcd = wgid % NXCD, off = wgid / NXCD; wgid = (xcd < r ? xcd * (q + 1) : r * (q + 1) + (xcd - r) * q) + off; }
        const int nig = WGM * nN, gid = wgid / nig, fm = gid * WGM, gsz = (nM - fm) < WGM ? (nM - fm) : WGM;
        u.pm = fm + ((wgid % nig) % gsz); u.pn = (wgid % nig) / gsz; return true;
    }
    __device__ __forceinline__ void a_ready(const Unit&) const {}
    __device__ __forceinline__ void done(const Unit&) const {}
};
struct DiagOrder {
    int G, c;
    __device__ void init(int G_, int c_) { G = G_; c = c_; }
    __device__ bool next(int i, Unit& u) const { const int L = i * G + c; if (L >= 256) return false; u.pm = L; u.pn = L >> 6; return true; }
    __device__ __forceinline__ void a_ready(const Unit&) const {}
    __device__ __forceinline__ void done(const Unit&) const {}
};

struct ChainOrder {
    StaticOrder S;
    __device__ void init(int M, int N, int G_, int c_) { S.init(M, N, G_, c_); }
    __device__ bool next(int i, Unit& u) const { if (!S.next(i >> 1, u)) return false; u.seg = i & 1; return true; }
    __device__ __forceinline__ void a_ready(const Unit&) const {}
    __device__ __forceinline__ void done(const Unit&) const {}
};

__device__ __forceinline__ unsigned cvt_pk_bf16(float lo, float hi) { unsigned r; asm volatile("v_cvt_pk_bf16_f32 %0, %1, %2" : "=v"(r) : "v"(lo), "v"(hi)); return r; }
__device__ __forceinline__ u32x4 pack8(const f32x4 v0, const f32x4 v1) { u32x4 w; w.x = cvt_pk_bf16(v0[0], v0[1]); w.y = cvt_pk_bf16(v0[2], v0[3]); w.z = cvt_pk_bf16(v1[0], v1[1]); w.w = cvt_pk_bf16(v1[2], v1[3]); return w; }
__device__ __forceinline__ float bf_lo(unsigned u) { return __builtin_bit_cast(float, u << 16); }
__device__ __forceinline__ float bf_hi(unsigned u) { return __builtin_bit_cast(float, u & 0xffff0000u); }
__device__ __forceinline__ void unpack8(const u32x4 w, f32x4& v0, f32x4& v1) { v0 = (f32x4){bf_lo(w.x), bf_hi(w.x), bf_lo(w.y), bf_hi(w.y)}; v1 = (f32x4){bf_lo(w.z), bf_hi(w.z), bf_lo(w.w), bf_hi(w.w)}; }
__device__ __forceinline__ float fast_sigmoid(float v) { return __builtin_amdgcn_rcpf(1.0f + __builtin_amdgcn_exp2f(-1.4426950408889634f * v)); }
__device__ __forceinline__ float log2_gamma(int h) { const float x = __builtin_amdgcn_exp2f((float)(-5 - h)); return -1.4426950408889634f * x * (1.f + x * (0.5f + x * (0.33333333f + x * (0.25f + x * 0.2f)))); }
constexpr float ROPE_C = 0.20762050593046014f;
constexpr float INV_2PI = 0.15915494309189535f;
constexpr float DK_SCALE = 0.08838834764831845f;

#ifndef MAIN_FP8
#define MAIN_FP8 3
#endif
struct EpiMain {
    static constexpr bool PERM = true, AFTER_DRAIN = false;
    bf16_t *q, *k, *gr, *pin; float asc; int pn0;
    __device__ __forceinline__ void operator()(const f32x4 (&acc)[2][2][4][2], const Unit& u, int wr, int wc, int fr, int fq) const {
        asm volatile("" : "+v"(fr), "+v"(fq));
        const int row0 = u.pm * BM + wr * 64 + fr, cl = wc * 32 + 8 * fq, pn = u.pn + pn0;
        if (pn < 8) {
            const bool isk = pn >= 4; bf16_t* base = isk ? k : q; const float sc = (isk ? DK_SCALE : 1.0f) * asc; const int pnl = pn & 3;
            float invf[4];
#pragma unroll
            for (int p = 0; p < 4; ++p) invf[p] = __builtin_amdgcn_exp2f(-(float)(16 * wc + 4 * fq + p) * ROPE_C) * INV_2PI;
#pragma unroll
            for (int ai = 0; ai < 2; ++ai)
#pragma unroll
                for (int m = 0; m < 4; ++m) {
                    const int row = row0 + ai * HALF + m * 16, s = row & 8191, b = row >> 13;
                    float cs[4], sn[4];
#pragma unroll
                    for (int p = 0; p < 4; ++p) { const float r = __builtin_amdgcn_fractf((float)s * invf[p]); cs[p] = __builtin_amdgcn_cosf(r) * sc; sn[p] = __builtin_amdgcn_sinf(r) * sc; }
#pragma unroll
                    for (int bj = 0; bj < 2; ++bj) {
                        const int hh = 2 * pnl + bj; const f32x4 v0 = acc[ai][bj][m][0], v1 = acc[ai][bj][m][1];
                        f32x4 o0, o1;
                        o0[0] = v0[0] * cs[0] - v0[1] * sn[0]; o0[1] = v0[0] * sn[0] + v0[1] * cs[0];
                        o0[2] = v0[2] * cs[1] - v0[3] * sn[1]; o0[3] = v0[2] * sn[1] + v0[3] * cs[1];
                        o1[0] = v1[0] * cs[2] - v1[1] * sn[2]; o1[1] = v1[0] * sn[2] + v1[1] * cs[2];
                        o1[2] = v1[2] * cs[3] - v1[3] * sn[3]; o1[3] = v1[2] * sn[3] + v1[3] * cs[3];
                        st16_wt(base + ((size_t)((b * 8 + hh) * 8192 + s)) * 128 + cl, pack8(o0, o1));
                    }
                }
        } else if (pn < 16) {
            const int c0 = (pn - 8) * BM + cl;
#pragma unroll
            for (int ai = 0; ai < 2; ++ai)
#pragma unroll
                for (int m = 0; m < 4; ++m) { bf16_t* rowp = gr + (size_t)(row0 + ai * HALF + m * 16) * 2048 + c0;
#pragma unroll
                    for (int bj = 0; bj < 2; ++bj) { f32x4 v0 = acc[ai][bj][m][0] * asc, v1 = acc[ai][bj][m][1] * asc;
#pragma unroll
                        for (int j = 0; j < 4; ++j) { v0[j] = v0[j] * fast_sigmoid(v0[j]); v1[j] = v1[j] * fast_sigmoid(v1[j]); }
                        st16_wt(rowp + bj * HALF, pack8(v0, v1)); } }
        } else {
            const int c0 = (pn - 16) * BM + cl;
#pragma unroll
            for (int ai = 0; ai < 2; ++ai)
#pragma unroll
                for (int m = 0; m < 4; ++m) { bf16_t* rowp = pin + (size_t)(row0 + ai * HALF + m * 16) * 1024 + c0;
#pragma unroll
                    for (int bj = 0; bj < 2; ++bj) st16_wt(rowp + bj * HALF, pack8(acc[ai][bj][m][0] * asc, acc[ai][bj][m][1] * asc)); }
        }
    }
};
#ifndef GATES_U8
#define GATES_U8 1
#endif
__device__ __forceinline__ unsigned pk4_u8(f32x4 g) {
    const unsigned b0 = (unsigned)fminf(g[0] * 256.f, 255.f), b1 = (unsigned)fminf(g[1] * 256.f, 255.f), b2 = (unsigned)fminf(g[2] * 256.f, 255.f), b3 = (unsigned)fminf(g[3] * 256.f, 255.f);
    return b0 | (b1 << 8) | (b2 << 16) | (b3 << 24); }
__device__ __forceinline__ f32x4 unpk4_u8(unsigned w) { return (f32x4){(float)(w & 0xffu) + 0.5f, (float)((w >> 8) & 0xffu) + 0.5f, (float)((w >> 16) & 0xffu) + 0.5f, (float)(w >> 24) + 0.5f}; }
struct EpiGates {
    static constexpr bool PERM = true, AFTER_DRAIN = false;
    bf16_t *gret, *gpool; float sc; int dbg;
    __device__ __forceinline__ void operator()(const f32x4 (&acc)[2][2][4][2], const Unit& u, int wr, int wc, int fr, int fq) const {
        const int row0 = u.pm * BM + wr * 64 + fr, c0 = (u.pn & 7) * BM + wc * 32 + 8 * fq; bf16_t* gates = (u.pn < 8) ? gret : gpool;
#pragma unroll
        for (int ai_ = 0; ai_ < 2; ++ai_)
#pragma unroll
            for (int m_ = 0; m_ < 4; ++m_) {
#ifdef GATES_REV
                const int ai = 1 - ai_, m = 3 - m_;
#else
                const int ai = ai_, m = m_;
#endif
                bf16_t* rowp = gates + (size_t)(row0 + ai * HALF + m * 16) * 2048 + c0;
#pragma unroll
                for (int bj = 0; bj < 2; ++bj) { f32x4 v0 = acc[ai][bj][m][0], v1 = acc[ai][bj][m][1];
#pragma unroll
                    for (int j = 0; j < 4; ++j) { v0[j] = fast_sigmoid(v0[j] * sc); v1[j] = fast_sigmoid(v1[j] * sc); }
                    if (dbg == 1) { asm volatile("" :: "v"(v0), "v"(v1)); continue; }
                    if (GATES_U8) st8_wt((unsigned char*)gates + (size_t)(row0 + ai * HALF + m * 16) * 2048 + c0 + bj * HALF, (unsigned long long)pk4_u8(v0) | ((unsigned long long)pk4_u8(v1) << 32));
                    else st16_wt(rowp + bj * HALF, pack8(v0, v1));
                } }
    }
};

#ifndef KV_FP8
#define KV_FP8 1
#endif
struct EpiKV {
    static constexpr bool PERM = true, AFTER_DRAIN = false;
    bf16_t* vT; float asc;
    __device__ __forceinline__ void operator()(const f32x4 (&acc)[2][2][4][2], const Unit& u, int wr, int wc, int fr, int fq) const {
        const int b = u.pn >> 5, sl = wc * 32 + 8 * fq, sbase = (u.pn & 31) * BM;
#pragma unroll
        for (int ai = 0; ai < 2; ++ai)
#pragma unroll
            for (int m = 0; m < 4; ++m) {
                const int R = u.pm * BM + ai * HALF + wr * 64 + m * 16 + fr;
                bf16_t* rowp = vT + ((size_t)(b * 2048 + R)) * 8192 + sbase + sl;
#pragma unroll
                for (int bj = 0; bj < 2; ++bj) st16_wt(rowp + bj * HALF, pack8(acc[ai][bj][m][0] * asc, acc[ai][bj][m][1] * asc));
            }
    }
};

#ifndef P6_CHAIN
#define P6_CHAIN 1
#endif
#ifndef MIX_FP8
#define MIX_FP8 1
#endif
constexpr float R8_SCALE = 16.0f, WB8_SCALE = 512.0f;
__device__ __forceinline__ unsigned pk4_fp8_(f32x4 a) { int p = __builtin_amdgcn_cvt_pk_fp8_f32(a[0], a[1], 0, false); p = __builtin_amdgcn_cvt_pk_fp8_f32(a[2], a[3], p, true); return (unsigned)p; }
struct EpiPool {
    static constexpr bool PERM = true, AFTER_DRAIN = false;
    bf16_t* out; const float* scale;
    __device__ __forceinline__ void operator()(const f32x4 (&acc)[2][2][4][2], const Unit& u, int wr, int wc, int fr, int fq) const {
        const int g = u.pm >> 6, tok0 = (u.pm & 63) * BM + wr * 64 + fr, c0 = g * 256 + wc * 32 + 8 * fq;
        f32x4 sv[2][2];
#pragma unroll
        for (int bj = 0; bj < 2; ++bj)
#pragma unroll
            for (int n = 0; n < 2; ++n) sv[bj][n] = *(const f32x4*)(scale + c0 + bj * HALF + 4 * n);
#pragma unroll
        for (int ai = 0; ai < 2; ++ai)
#pragma unroll
            for (int m = 0; m < 4; ++m) { bf16_t* rowp = out + (size_t)(tok0 + ai * HALF + m * 16) * 1024 + c0;
#pragma unroll
                for (int bj = 0; bj < 2; ++bj) {
                    if (MIX_FP8) st8_wt((unsigned char*)out + (size_t)(tok0 + ai * HALF + m * 16) * (P6_CHAIN ? 2048 : 1024) + c0 + bj * HALF, (unsigned long long)pk4_fp8_(acc[ai][bj][m][0] * sv[bj][0] * R8_SCALE) | ((unsigned long long)pk4_fp8_(acc[ai][bj][m][1] * sv[bj][1] * R8_SCALE) << 32));
                    else st16_wt(rowp + bj * HALF, pack8(acc[ai][bj][m][0] * sv[bj][0], acc[ai][bj][m][1] * sv[bj][1])); } }
    }
};

#ifndef OUT_FP8
#define OUT_FP8 1
#endif
constexpr float M8_SCALE = 32.0f, WO8_SCALE = 512.0f;
template <int PASS> struct EpiMix {
    static constexpr bool PERM = true, AFTER_DRAIN = false;
    bf16_t* mixed; const bf16_t* gates; unsigned char* m8; float sc;
    __device__ __forceinline__ void operator()(const f32x4 (&acc)[2][2][4][2], const Unit& u, int wr, int wc, int fr, int fq) const {
        const int row0 = u.pm * BM + wr * 64 + fr, c0 = u.pn * BM + wc * 32 + 8 * fq;
#pragma unroll
        for (int ai = 0; ai < 2; ++ai) {
            unsigned long long gw8[4][2]; u32x4 gw16[4][2], pw[4][2];
#pragma unroll
            for (int m = 0; m < 4; ++m) { const size_t row = (size_t)(row0 + ai * HALF + m * 16);
#pragma unroll
                for (int bj = 0; bj < 2; ++bj) {
                    if (GATES_U8) gw8[m][bj] = *(const unsigned long long*)((const unsigned char*)gates + row * 2048 + c0 + bj * HALF);
                    else gw16[m][bj] = *(const u32x4*)(gates + row * 2048 + c0 + bj * HALF);
                    if (PASS == 1) pw[m][bj] = *(const u32x4*)(mixed + row * 2048 + c0 + bj * HALF); } }
#pragma unroll
            for (int m = 0; m < 4; ++m) { const size_t row = (size_t)(row0 + ai * HALF + m * 16);
#pragma unroll
                for (int bj = 0; bj < 2; ++bj) {
                    f32x4 g0, g1; float scg = sc;
                    if (GATES_U8) { g0 = unpk4_u8((unsigned)gw8[m][bj]); g1 = unpk4_u8((unsigned)(gw8[m][bj] >> 32)); scg = sc * (1.0f / 256.0f); }
                    else unpack8(gw16[m][bj], g0, g1);
                    f32x4 v0 = acc[ai][bj][m][0] * (g0 * scg), v1 = acc[ai][bj][m][1] * (g1 * scg);
                    bf16_t* p = mixed + row * 2048 + c0 + bj * HALF;
                    if (PASS == 1) { f32x4 t0, t1; unpack8(pw[m][bj], t0, t1); v0 += t0; v1 += t1; }
                    if (PASS == 1 && OUT_FP8) st8_wt(m8 + row * 2048 + c0 + bj * HALF, (unsigned long long)pk4_fp8_(v0 * M8_SCALE) | ((unsigned long long)pk4_fp8_(v1 * M8_SCALE) << 32));
                    else st16_wt(p, pack8(v0, v1)); } }
        }
    }
};

struct EpiChain {
    static constexpr bool PERM = true, AFTER_DRAIN = false;
    const unsigned char* gret; const unsigned char* gpool; unsigned char* m8; float sc;
    __device__ __forceinline__ void mid(f32x4 (&acc)[2][2][4][2], const Unit& u, int wr, int wc, int fr, int fq) const {
        const int row0 = u.pm * BM + wr * 64 + fr, c0 = u.pn * BM + wc * 32 + 8 * fq;
#pragma unroll
        for (int ai = 0; ai < 2; ++ai) {
            unsigned long long gr8[4][2], gp8[4][2];
#pragma unroll
            for (int m = 0; m < 4; ++m) { const size_t off = (size_t)(row0 + ai * HALF + m * 16) * 2048 + c0;
#pragma unroll
                for (int bj = 0; bj < 2; ++bj) { gr8[m][bj] = *(const unsigned long long*)(gret + off + bj * HALF); gp8[m][bj] = *(const unsigned long long*)(gpool + off + bj * HALF); } }
#pragma unroll
            for (int m = 0; m < 4; ++m)
#pragma unroll
                for (int bj = 0; bj < 2; ++bj) {
                    const f32x4 r0 = unpk4_u8((unsigned)gr8[m][bj]), r1 = unpk4_u8((unsigned)(gr8[m][bj] >> 32)), p0 = unpk4_u8((unsigned)gp8[m][bj]), p1 = unpk4_u8((unsigned)(gp8[m][bj] >> 32));
#pragma unroll
                    for (int j = 0; j < 4; ++j) { acc[ai][bj][m][0][j] *= p0[j] * __builtin_amdgcn_rcpf(r0[j]); acc[ai][bj][m][1][j] *= p1[j] * __builtin_amdgcn_rcpf(r1[j]); } }
        }
    }
    __device__ __forceinline__ void operator()(const f32x4 (&acc)[2][2][4][2], const Unit& u, int wr, int wc, int fr, int fq) const {
        const int row0 = u.pm * BM + wr * 64 + fr, c0 = u.pn * BM + wc * 32 + 8 * fq;
        const float scg = sc * (M8_SCALE / 256.0f);
#pragma unroll
        for (int ai = 0; ai < 2; ++ai) {
            unsigned long long gr8[4][2];
#pragma unroll
            for (int m = 0; m < 4; ++m)
#pragma unroll
                for (int bj = 0; bj < 2; ++bj) gr8[m][bj] = *(const unsigned long long*)(gret + (size_t)(row0 + ai * HALF + m * 16) * 2048 + c0 + bj * HALF);
#pragma unroll
            for (int m = 0; m < 4; ++m)
#pragma unroll
                for (int bj = 0; bj < 2; ++bj) {
                    const f32x4 r0 = unpk4_u8((unsigned)gr8[m][bj]), r1 = unpk4_u8((unsigned)(gr8[m][bj] >> 32));
                    st8_wt(m8 + (size_t)(row0 + ai * HALF + m * 16) * 2048 + c0 + bj * HALF, (unsigned long long)pk4_fp8_(acc[ai][bj][m][0] * (r0 * scg)) | ((unsigned long long)pk4_fp8_(acc[ai][bj][m][1] * (r1 * scg)) << 32)); }
        }
    }
};

struct EpiOut {
    static constexpr bool PERM = true, AFTER_DRAIN = false;
    const float* x; bf16_t* x1b; float* sumsq; float sc;
    __device__ __forceinline__ void operator()(const f32x4 (&acc)[2][2][4][2], const Unit& u, int wr, int wc, int fr, int fq) const {
        const int row0 = u.pm * BM + wr * 64 + fr, c0 = u.pn * BM + wc * 32 + 8 * fq;
#pragma unroll
        for (int aim = 0; aim < 4; ++aim)
        {   const int ai = aim >> 1, mb = 2 * (aim & 1);
            f32x4 xv[4][2][2];
#pragma unroll
            for (int m = mb; m < mb + 2; ++m)
#pragma unroll
                for (int bj = 0; bj < 2; ++bj) { const size_t off = (size_t)(row0 + ai * HALF + m * 16) * 2048 + c0 + bj * HALF; xv[m][bj][0] = *(const f32x4*)(x + off); xv[m][bj][1] = *(const f32x4*)(x + off + 4); }
#pragma unroll
            for (int m = mb; m < mb + 2; ++m) { const size_t row = (size_t)(row0 + ai * HALF + m * 16); float ss = 0.f;
#pragma unroll
                for (int bj = 0; bj < 2; ++bj) {
                    const size_t off = row * 2048 + c0 + bj * HALF;
                    const f32x4 v0 = acc[ai][bj][m][0] * sc + xv[m][bj][0], v1 = acc[ai][bj][m][1] * sc + xv[m][bj][1];
                    st16_wt(x1b + off, pack8(v0, v1));
                    ss += (v0[0] * v0[0] + v0[1] * v0[1]) + (v0[2] * v0[2] + v0[3] * v0[3]) + (v1[0] * v1[0] + v1[1] * v1[1]) + (v1[2] * v1[2] + v1[3] * v1[3]); }
                ss += __shfl_xor(ss, 16); ss += __shfl_xor(ss, 32);
                if (fq == 0) st4f_wt(sumsq + row * 32 + u.pn * 4 + wc, ss); }
        }
    }
};

struct EpiQ {
    static constexpr bool PERM = true, AFTER_DRAIN = false;
    bf16_t* qp; const float* sumsq;
    __device__ __forceinline__ void operator()(const f32x4 (&acc)[2][2][4][2], const Unit& u, int wr, int wc, int fr, int fq) const {
        const int row0 = u.pm * BM + wr * 64 + fr, c0 = u.pn * BM + wc * 32 + 8 * fq;
        float rsv[2][4];
#pragma unroll
        for (int ai = 0; ai < 2; ++ai)
#pragma unroll
            for (int m = 0; m < 4; ++m) { const size_t row = (size_t)(row0 + ai * HALF + m * 16);
                const f32x4 p0 = *(const f32x4*)(sumsq + row * 32 + fq * 8), p1 = *(const f32x4*)(sumsq + row * 32 + fq * 8 + 4);
                float st = ((p0[0] + p0[1]) + (p0[2] + p0[3])) + ((p1[0] + p1[1]) + (p1[2] + p1[3]));
                st += __shfl_xor(st, 16); st += __shfl_xor(st, 32);
                rsv[ai][m] = __builtin_amdgcn_rsqf(st * (1.0f / 2048.0f) + 1e-6f); }
#pragma unroll
        for (int ai = 0; ai < 2; ++ai)
#pragma unroll
            for (int m = 0; m < 4; ++m) { const size_t row = (size_t)(row0 + ai * HALF + m * 16); const float rs = rsv[ai][m];
#pragma unroll
                for (int bj = 0; bj < 2; ++bj) st16_wt(qp + row * 2048 + c0 + bj * HALF, pack8(acc[ai][bj][m][0] * rs, acc[ai][bj][m][1] * rs)); }
    }
};

#ifndef F8_CONTIG_K
#define F8_CONTIG_K 0
#endif
template <class Epi, class Sched, bool ALIGN_EPI = false, bool SP2 = false, bool F8 = false, bool CHAIN = false>
__device__ __forceinline__ void gemm_phase(PG8_LAS unsigned char* lds, const Gemm g, const Sched& S, const Epi& E) {
    int tid_ = threadIdx.x; asm volatile("" : "+v"(tid_));
    const int tid = tid_, wid = __builtin_amdgcn_readfirstlane(tid >> 6), lane = tid & 63, wr = wid >> 2, wc = wid & 3, fr = lane & 15, fq = lane >> 4;
    int K_ = g.K; asm volatile("" : "+s"(K_));
    const int K = K_, nt = K / BK; int K2_ = g.K2; asm volatile("" : "+s"(K2_)); const int nt2 = K2_ / BK;
    unsigned voffA[2], voffB[2];
#pragma unroll
    for (int i = 0; i < 2; ++i) { int R, C; stage_rc(tid * 16 + i * 8192, R, C); const int Rb = Epi::PERM ? ((R & ~31) + perm32(R & 31)) : R;
        voffA[i] = (unsigned)(R * K + C) * 2u; voffB[i] = (unsigned)(Rb * K + C) * 2u; }
    const size_t kstep = (size_t)(BK * 2);
    const size_t hstep = (size_t)HALF * K * 2;
    const size_t tstep = 2 * hstep;
    const unsigned ldsw = (unsigned)wid * 1024u;
    const int aoff = lds_byte(wr * 64 + fr, fq * 8), boff = lds_byte(wc * 32 + fr, fq * 8);
    const int aoffk0 = (F8 && F8_CONTIG_K) ? lds_byte(wr * 64 + fr, 16 * fq) : aoff, aoffk1 = (F8 && F8_CONTIG_K) ? lds_byte(wr * 64 + fr, 16 * fq + 8) : aoff + 1024;
    const int boffk0 = (F8 && F8_CONTIG_K) ? lds_byte(wc * 32 + fr, 16 * fq) : boff, boffk1 = (F8 && F8_CONTIG_K) ? lds_byte(wc * 32 + fr, 16 * fq + 8) : boff + 1024;
#ifndef F8_LEGACY
#define F8_LEGACY 0
#endif
#ifndef DBG_HALF_MMA
#define DBG_HALF_MMA 0
#endif
#ifndef F8_SAFE
#define F8_SAFE 0
#endif
#ifndef F8_FIXREG
#define F8_FIXREG 1
#endif
#ifndef F8_BUILTIN
#define F8_BUILTIN 0
#endif
#define PG8_SA(b, h) (((b) * 2 + (h)) * HTB)
#define PG8_SB(b, h) ((4 + (b) * 2 + (h)) * HTB)
#define PG8_STAGE(bufoff, gbase, voff) do { _Pragma("unroll") for (int _i = 0; _i < 2; ++_i) \
        __builtin_amdgcn_global_load_lds((const unsigned*)((const char*)(gbase) + (voff)[_i]), (PG8_LAS unsigned*)(lds + (bufoff) + ldsw + _i * 8192), 16, 0, 0); } while (0)
#define PG8_LDA(dst, b, h) do { _Pragma("unroll") for (int m = 0; m < 4; ++m) { if constexpr (F8 && !F8_LEGACY) { \
            dst##8[m] = __builtin_shufflevector(*(const PG8_LAS i32x4_*)(lds + PG8_SA(b, h) + aoffk0 + m * 2048), *(const PG8_LAS i32x4_*)(lds + PG8_SA(b, h) + aoffk1 + m * 2048), 0, 1, 2, 3, 4, 5, 6, 7); } \
        else { _Pragma("unroll") for (int k = 0; k < 2; ++k) dst[m][k] = *(const PG8_LAS bf16x8*)(lds + PG8_SA(b, h) + (k ? aoffk1 : aoffk0) + m * 2048); } } } while (0)
#define PG8_LDB(dst, b, h) do { _Pragma("unroll") for (int n = 0; n < 2; ++n) { if constexpr (F8 && !F8_LEGACY) { \
            dst##8[n] = __builtin_shufflevector(*(const PG8_LAS i32x4_*)(lds + PG8_SB(b, h) + boffk0 + n * 2048), *(const PG8_LAS i32x4_*)(lds + PG8_SB(b, h) + boffk1 + n * 2048), 0, 1, 2, 3, 4, 5, 6, 7); } \
        else { _Pragma("unroll") for (int k = 0; k < 2; ++k) dst[n][k] = *(const PG8_LAS bf16x8*)(lds + PG8_SB(b, h) + (k ? boffk1 : boffk0) + n * 2048); } } } while (0)
#define PG8_MMA_(ai, bj, At, Bt) do { if (F8 && F8_SAFE == 1) { asm volatile("s_waitcnt vmcnt(0) lgkmcnt(0)\n\ts_nop 15" ::: "memory"); __builtin_amdgcn_s_barrier(); } __builtin_amdgcn_s_setprio(1); _Pragma("unroll") for (int m = 0; m < 4; ++m) _Pragma("unroll") for (int n = 0; n < 2; ++n) { \
        if constexpr (F8 && F8_LEGACY) { _Pragma("unroll") for (int k = 0; k < 2; ++k) { typedef long l2_ __attribute__((ext_vector_type(2))); \
                const l2_ bq = __builtin_bit_cast(l2_, Bt[n][k]), aq = __builtin_bit_cast(l2_, At[m][k]); \
                if (F8_LEGACY == 2) { asm volatile("v_mfma_f32_16x16x32_fp8_fp8 %0, %1, %2, %0" : "+v"(acc[ai][bj][m][n]) : "v"(bq[0]), "v"(aq[0])); asm volatile("v_mfma_f32_16x16x32_fp8_fp8 %0, %1, %2, %0" : "+v"(acc[ai][bj][m][n]) : "v"(bq[1]), "v"(aq[1])); } else { \
                acc[ai][bj][m][n] = __builtin_amdgcn_mfma_f32_16x16x32_fp8_fp8(bq[0], aq[0], acc[ai][bj][m][n], 0, 0, 0); \
                acc[ai][bj][m][n] = __builtin_amdgcn_mfma_f32_16x16x32_fp8_fp8(bq[1], aq[1], acc[ai][bj][m][n], 0, 0, 0); } } } \
            else if constexpr (F8) { if (F8_BUILTIN) acc[ai][bj][m][n] = __builtin_amdgcn_mfma_scale_f32_16x16x128_f8f6f4(Bt##8[n], At##8[m], acc[ai][bj][m][n], 0, 0, 0, 0, 0, 0); \
                else asm volatile("v_mfma_f32_16x16x128_f8f6f4 %0, %1, %2, %0" : "+v"(acc[ai][bj][m][n]) : "v"(Bt##8[n]), "v"(At##8[m])); } \
        else { _Pragma("unroll") for (int k = 0; k < (DBG_HALF_MMA ? 1 : 2); ++k) acc[ai][bj][m][n] = __builtin_amdgcn_mfma_f32_16x16x32_bf16(Bt[n][k], At[m][k], acc[ai][bj][m][n], 0, 0, 0); } } \
        __builtin_amdgcn_s_setprio(0); if (F8 && F8_SAFE == 1) { asm volatile("s_nop 15\n\ts_nop 15\n\ts_nop 15" ::: "memory"); __builtin_amdgcn_s_barrier(); } } while (0)
#define PG8_F8R_At0 "{v[192:199]}"
#define PG8_F8R_At1 "{v[200:207]}"
#define PG8_F8R_At2 "{v[208:215]}"
#define PG8_F8R_At3 "{v[216:223]}"
#define PG8_F8R_B00 "{v[224:231]}"
#define PG8_F8R_B01 "{v[232:239]}"
#define PG8_F8R_B10 "{v[240:247]}"
#define PG8_F8R_B11 "{v[248:255]}"
#define PG8_F8MMA1(ai, bj, m, n, At, Bt) asm volatile("v_mfma_f32_16x16x128_f8f6f4 %0, %1, %2, %0" : "+v"(acc[ai][bj][m][n]) : PG8_F8R_##Bt##n(Bt##8[n]), PG8_F8R_##At##m(At##8[m]))
#define PG8_MMA_FIX(ai, bj, At, Bt) do { __builtin_amdgcn_s_setprio(1); \
        PG8_F8MMA1(ai, bj, 0, 0, At, Bt); PG8_F8MMA1(ai, bj, 0, 1, At, Bt); PG8_F8MMA1(ai, bj, 1, 0, At, Bt); PG8_F8MMA1(ai, bj, 1, 1, At, Bt); \
        PG8_F8MMA1(ai, bj, 2, 0, At, Bt); PG8_F8MMA1(ai, bj, 2, 1, At, Bt); PG8_F8MMA1(ai, bj, 3, 0, At, Bt); PG8_F8MMA1(ai, bj, 3, 1, At, Bt); \
        __builtin_amdgcn_s_setprio(0); } while (0)
#define PG8_MMA(ai, bj, At, Bt) do { if constexpr (F8 && F8_FIXREG) PG8_MMA_FIX(ai, bj, At, Bt); else if (F8 && F8_SAFE == 2) { if (wr == 0) PG8_MMA_(ai, bj, At, Bt); asm volatile("s_nop 15\n\ts_nop 15" ::: "memory"); __builtin_amdgcn_s_barrier(); if (wr == 1) PG8_MMA_(ai, bj, At, Bt); asm volatile("s_nop 15\n\ts_nop 15" ::: "memory"); __builtin_amdgcn_s_barrier(); } else PG8_MMA_(ai, bj, At, Bt); } while (0)
#define PG8_WAIT_V(n) asm volatile("s_waitcnt vmcnt(" #n ")" ::: "memory")
#define PG8_WAIT_L(n) asm volatile("s_waitcnt lgkmcnt(" #n ")" ::: "memory")
#define PG8_BAR __builtin_amdgcn_s_barrier()
#define PG8_SCHED __builtin_amdgcn_sched_barrier(0)
#ifdef EPI_DRAIN
#define PG8_EPI_DRAIN PG8_WAIT_V(0)
#else
#define PG8_EPI_DRAIN do {} while (0)
#endif
    Unit cur, nxt; int ui = 0;
    if (!S.next(0, cur)) return;
    f32x4 acc[2][2][4][2];
#pragma unroll
    for (int a = 0; a < 2; ++a)
#pragma unroll
        for (int b = 0; b < 2; ++b)
#pragma unroll
            for (int m = 0; m < 4; ++m)
#pragma unroll
                for (int n = 0; n < 2; ++n) acc[a][b][m][n] = (f32x4){0.f, 0.f, 0.f, 0.f};
    typedef int i32x4_ __attribute__((ext_vector_type(4))); typedef int i32x8_ __attribute__((ext_vector_type(8)));
    int sc127 = 0x7f7f7f7f; asm volatile("" : "+v"(sc127));
    bf16x8 At[4][2], B0[2][2], B1[2][2]; i32x8_ At8[4], B08[2], B18[2];
    const char* cA = (const char*)((CHAIN && cur.seg == 0) ? g.A2 : g.A) + (size_t)cur.pm * tstep; const char* cB = (const char*)((CHAIN && cur.seg == 0) ? g.Bt2 : g.Bt) + (size_t)cur.pn * tstep;
    int ntc = (CHAIN && cur.seg == 0) ? nt2 : nt;
    S.a_ready(cur);
    if constexpr (SP2) {
        PG8_STAGE(PG8_SB(0, 0), cB, voffB); PG8_STAGE(PG8_SB(0, 1), cB + hstep, voffB); PG8_STAGE(PG8_SA(0, 0), cA, voffA); PG8_STAGE(PG8_SA(0, 1), cA + hstep, voffA);
        if (wr == 1) PG8_BAR;
        PG8_WAIT_V(2); PG8_BAR;
        PG8_STAGE(PG8_SB(1, 0), cB + kstep, voffB); PG8_STAGE(PG8_SA(1, 0), cA + kstep, voffA); PG8_STAGE(PG8_SB(1, 1), cB + hstep + kstep, voffB);
        PG8_WAIT_V(6); PG8_BAR;
    } else {
        PG8_STAGE(PG8_SB(0, 0), cB, voffB); PG8_STAGE(PG8_SA(0, 0), cA, voffA); PG8_STAGE(PG8_SB(0, 1), cB + hstep, voffB); PG8_STAGE(PG8_SA(0, 1), cA + hstep, voffA);
        if (wr == 1) PG8_BAR;
        PG8_WAIT_V(4); PG8_BAR;
        PG8_STAGE(PG8_SB(1, 0), cB + kstep, voffB); PG8_STAGE(PG8_SA(1, 0), cA + kstep, voffA); PG8_STAGE(PG8_SB(1, 1), cB + hstep + kstep, voffB);
        PG8_WAIT_V(6); PG8_BAR;
    }
    for (;;) {
        const bool has_next = S.next(ui + 1, nxt);
        const char* nA = has_next ? (const char*)((CHAIN && nxt.seg == 0) ? g.A2 : g.A) + (size_t)nxt.pm * tstep : cA; const char* nB = has_next ? (const char*)((CHAIN && nxt.seg == 0) ? g.Bt2 : g.Bt) + (size_t)nxt.pn * tstep : cB;
        for (int t = 0; t < ntc; t += 2) {
            const bool last = (t == ntc - 2);
            const char* a1 = cA + (size_t)(t + 1) * kstep;
            const char* a2 = last ? nA : cA + (size_t)(t + 2) * kstep; const char* b2 = last ? nB : cB + (size_t)(t + 2) * kstep;
            const char* a3 = a2 + kstep; const char* b3 = b2 + kstep;
            if (last && has_next) S.a_ready(nxt);
            if constexpr (SP2) {
            PG8_LDB(B0, 0, 0); PG8_LDB(B1, 0, 1); PG8_SCHED; PG8_LDA(At, 0, 0); PG8_STAGE(PG8_SA(1, 1), a1 + hstep, voffA);
            PG8_WAIT_V(8); PG8_WAIT_L(0); PG8_BAR; PG8_MMA(0, 0, At, B0); PG8_MMA(0, 1, At, B1); PG8_BAR; PG8_SCHED;
            PG8_LDA(At, 0, 1); PG8_STAGE(PG8_SB(0, 0), b2, voffB); PG8_STAGE(PG8_SB(0, 1), b2 + hstep, voffB); PG8_STAGE(PG8_SA(0, 0), a2, voffA);
            PG8_WAIT_V(8); PG8_WAIT_L(0); PG8_BAR; PG8_MMA(1, 0, At, B0); PG8_MMA(1, 1, At, B1); PG8_BAR; PG8_SCHED;
            PG8_LDB(B0, 1, 0); PG8_LDB(B1, 1, 1); PG8_SCHED; PG8_LDA(At, 1, 0); PG8_STAGE(PG8_SA(0, 1), a2 + hstep, voffA);
            PG8_WAIT_V(8); PG8_WAIT_L(0); PG8_BAR; PG8_MMA(0, 0, At, B0); PG8_MMA(0, 1, At, B1); PG8_BAR; PG8_SCHED;
            PG8_LDA(At, 1, 1); PG8_STAGE(PG8_SB(1, 0), b3, voffB); PG8_STAGE(PG8_SB(1, 1), b3 + hstep, voffB); PG8_STAGE(PG8_SA(1, 0), a3, voffA);
            PG8_WAIT_V(8); PG8_WAIT_L(0); PG8_BAR; PG8_MMA(1, 0, At, B0); PG8_MMA(1, 1, At, B1); PG8_BAR; PG8_SCHED;
            } else {
            PG8_LDB(B0, 0, 0); PG8_SCHED; PG8_LDA(At, 0, 0); PG8_STAGE(PG8_SA(1, 1), a1 + hstep, voffA);
            PG8_WAIT_L(8); PG8_BAR; PG8_WAIT_L(0); PG8_MMA(0, 0, At, B0); PG8_BAR; PG8_SCHED;
            PG8_LDB(B1, 0, 1); PG8_STAGE(PG8_SB(0, 0), b2, voffB);
            PG8_BAR; PG8_WAIT_L(0); PG8_MMA(0, 1, At, B1); PG8_BAR;
            PG8_LDA(At, 0, 1); PG8_STAGE(PG8_SA(0, 0), a2, voffA);
            PG8_BAR; PG8_WAIT_L(0); PG8_MMA(1, 0, At, B0); PG8_BAR; PG8_SCHED;
            PG8_STAGE(PG8_SB(0, 1), b2 + hstep, voffB);
            PG8_WAIT_V(6); PG8_BAR; PG8_MMA(1, 1, At, B1); PG8_BAR;
            PG8_LDB(B0, 1, 0); PG8_SCHED; PG8_LDA(At, 1, 0); PG8_STAGE(PG8_SA(0, 1), a2 + hstep, voffA);
            PG8_WAIT_L(8); PG8_BAR; PG8_WAIT_L(0); PG8_MMA(0, 0, At, B0); PG8_BAR; PG8_SCHED;
            PG8_LDB(B1, 1, 1); PG8_STAGE(PG8_SB(1, 0), b3, voffB);
            PG8_BAR; PG8_WAIT_L(0); PG8_MMA(0, 1, At, B1); PG8_BAR;
            PG8_LDA(At, 1, 1); PG8_STAGE(PG8_SA(1, 0), a3, voffA);
            PG8_BAR; PG8_WAIT_L(0); PG8_MMA(1, 0, At, B0); PG8_BAR; PG8_SCHED;
            PG8_STAGE(PG8_SB(1, 1), b3 + hstep, voffB);
            PG8_WAIT_V(6); PG8_BAR; PG8_MMA(1, 1, At, B1); PG8_BAR;
            }
        }
        if constexpr (F8) asm volatile("s_nop 15\n\ts_nop 7" ::: "memory");
        if constexpr (ALIGN_EPI) { if (wr == 0) PG8_BAR; }
        bool keep_acc = false;
        if constexpr (CHAIN) { if (cur.seg == 0) { E.mid(acc, cur, wr, wc, fr, fq); keep_acc = true; } else { E(acc, cur, wr, wc, fr, fq); S.done(cur); } }
        else if constexpr (!Epi::AFTER_DRAIN) { E(acc, cur, wr, wc, fr, fq); S.done(cur); PG8_EPI_DRAIN; }
        if (!has_next) break;
        if (!keep_acc) {
#pragma unroll
        for (int a = 0; a < 2; ++a)
#pragma unroll
            for (int b = 0; b < 2; ++b)
#pragma unroll
                for (int m = 0; m < 4; ++m)
#pragma unroll
                    for (int n = 0; n < 2; ++n) acc[a][b][m][n] = (f32x4){0.f, 0.f, 0.f, 0.f};
        }
        cur = nxt; cA = nA; cB = nB; ++ui; if constexpr (CHAIN) ntc = (cur.seg == 0) ? nt2 : nt;
        if constexpr (ALIGN_EPI) { if (wr == 1) PG8_BAR; }
    }
    PG8_WAIT_V(0);
    if constexpr (!ALIGN_EPI) { if (wr == 0) PG8_BAR; }
    PG8_BAR;
    if constexpr (Epi::AFTER_DRAIN) { E.fused(acc, cur, wr, wc, fr, fq, lds, wid, lane); S.done(cur); }
#undef PG8_SA
#undef PG8_SB
#undef PG8_STAGE
#undef PG8_LDA
#undef PG8_LDB
#undef PG8_MMA
#undef PG8_WAIT_V
#undef PG8_WAIT_L
#undef PG8_BAR
#undef PG8_SCHED
}
}
#define GAS __attribute__((address_space(1)))
#define LAS __attribute__((address_space(3)))
typedef unsigned short bf16;
typedef unsigned v4u __attribute__((ext_vector_type(4)));
typedef float f32x4 __attribute__((ext_vector_type(4)));
typedef short bf16x8 __attribute__((ext_vector_type(8)));
typedef GAS unsigned gu32;
typedef GAS unsigned long long gu64;
#define RLX_AGENT __ATOMIC_RELAXED, __HIP_MEMORY_SCOPE_AGENT
#define LDS_WAIT() asm volatile("s_waitcnt lgkmcnt(0)" ::: "memory")
#define VM_WAIT() asm volatile("s_waitcnt vmcnt(0)" ::: "memory")
__device__ __forceinline__ unsigned long long rt() { return __builtin_amdgcn_s_memrealtime(); }
__device__ __forceinline__ unsigned f2bf(float f) { unsigned u = __builtin_bit_cast(unsigned, f); return (u + 0x7fffu + ((u >> 16) & 1u)) >> 16; }
__device__ __forceinline__ unsigned pk2(float lo, float hi) { return f2bf(lo) | (f2bf(hi) << 16); }
#define XB_TMO      128
#define XB_XCNT(j)  (256  + 64 * (j))
#define XB_XSUB(j)  (1280 + 64 * (j))
#define XB_XGEN(j)  (2304 + 64 * (j))
#define XB_TOP      3328
#define XB_TOPGEN   3392
#define XCD_BAR_WORDS 3456
#ifndef XB_SCOPE
#define XB_SCOPE "agent"
#endif
#define XB_SPIN_CAP (1u << 18)

__device__ __forceinline__ unsigned xb_ld(unsigned* p)              { return __hip_atomic_load(p, __ATOMIC_RELAXED, __HIP_MEMORY_SCOPE_AGENT); }
__device__ __forceinline__ unsigned xb_add(unsigned* p, unsigned v) { return __hip_atomic_fetch_add(p, v, __ATOMIC_RELAXED, __HIP_MEMORY_SCOPE_AGENT); }
__device__ __forceinline__ unsigned xb_xcc_id() { return (unsigned)__builtin_amdgcn_s_getreg((3 << 11) | 20) & 0xFu; }
#define XB_SPIN(cond, bar) do { unsigned _sp = 0; while (cond) { __builtin_amdgcn_s_sleep(1); \
    if ((++_sp & 255u) == 0u) { if (xb_ld(&(bar)[XB_TMO])) break; if (_sp > XB_SPIN_CAP) { atomicAdd(&(bar)[XB_TMO], 1u); break; } } } } while (0)

struct XcdBarrier {
    unsigned* bar; unsigned x;
    volatile LAS unsigned* st;
};

__device__ __forceinline__ XcdBarrier xcd_barrier_post(unsigned* bar, volatile LAS unsigned* st) {
    XcdBarrier b; b.bar = bar; b.x = xb_xcc_id(); b.st = st;
    if (threadIdx.x == 0) (void)xb_add(&bar[XB_XCNT(b.x)], 1u);
    return b;
}
__device__ __forceinline__ void xcd_barrier_complete(unsigned* bar, unsigned x, unsigned& nloc, unsigned& nx) {
    const unsigned G = gridDim.x * gridDim.y * gridDim.z;
    unsigned sum, cnt, mine, sp = 0u;
    for (;;) {
        sum = 0u; cnt = 0u; mine = 0u;
#pragma unroll
        for (unsigned j = 0; j < 16; ++j) { const unsigned c = xb_ld(&bar[XB_XCNT(j)]); sum += c; cnt += (c > 0u) ? 1u : 0u; mine = (j == x) ? c : mine; }
        if (sum == G) break;
        __builtin_amdgcn_s_sleep(1);
        if ((++sp & 255u) == 0u) { if (xb_ld(&bar[XB_TMO])) break; if (sp > XB_SPIN_CAP) { atomicAdd(&bar[XB_TMO], 1u); break; } }
    }
    nloc = mine > 0u ? mine : 1u; nx = cnt > 0u ? cnt : 1u;
}

__device__ __forceinline__ void xcd_barrier(const XcdBarrier& b) {
    asm volatile("s_waitcnt vmcnt(0)" ::: "memory");
    __syncthreads();
    if (threadIdx.x == 0) {
        unsigned* bar = b.bar;
        __builtin_amdgcn_s_waitcnt(0);
        unsigned nloc = b.st[0], nx = b.st[1];
        if (nloc == 0u) { xcd_barrier_complete(bar, b.x, nloc, nx); b.st[0] = nloc; b.st[1] = nx; }
        const unsigned old = xb_add(&bar[XB_XSUB(b.x)], 1u);
        const unsigned gen = old / nloc;
        if (old + 1u == (gen + 1u) * nloc) {
#ifdef XB_RELEASE_FENCE
            __builtin_amdgcn_fence(__ATOMIC_RELEASE, XB_SCOPE);
#endif
            asm volatile("s_waitcnt vmcnt(0)" ::: "memory");
            const unsigned og = xb_add(&bar[XB_TOP], 1u);
            const unsigned tg = og / nx;
            if (og + 1u == (tg + 1u) * nx) xb_add(&bar[XB_TOPGEN], 1u);
            else XB_SPIN(xb_ld(&bar[XB_TOPGEN]) == tg, bar);
            __builtin_amdgcn_fence(__ATOMIC_ACQUIRE, XB_SCOPE);
            xb_add(&bar[XB_XGEN(b.x)], 1u);
            asm volatile("s_waitcnt vmcnt(0)" ::: "memory");
        } else {
            XB_SPIN(xb_ld(&bar[XB_XGEN(b.x)]) == gen, bar);
            __builtin_amdgcn_fence(__ATOMIC_ACQUIRE, XB_SCOPE);
            asm volatile("s_waitcnt vmcnt(0)" ::: "memory");
        }
    }
    __syncthreads();
}

constexpr int NWAVES = 8;
constexpr int TOK = 16384, DM = 2048, SEQ = 8192, INC = 11264;
constexpr float EPS = 1e-6f;
#ifndef MK_PER_PHASE
#define MK_PER_PHASE 0
#endif
constexpr int N_PHASES = 10;
#ifndef PHASE_MASK
#define PHASE_MASK 0x3ff
#endif

constexpr size_t MiB = 1u << 20;
constexpr size_t WS_CTL = 0, CTL_ZERO_BYTES = 1 * MiB;
constexpr size_t WS_WMAIN = 2 * MiB;
constexpr size_t WS_WKV = 38 * MiB;
constexpr size_t WS_WRO = 50 * MiB;
constexpr size_t WS_WPO = 58 * MiB;
constexpr size_t WS_WOUT = 62 * MiB;
constexpr size_t WS_WQ = 70 * MiB;
constexpr size_t WS_LINT = 78 * MiB;
constexpr size_t WS_KEYS = 79 * MiB;
constexpr size_t WS_H = 80 * MiB;
constexpr size_t WS_Q = 144 * MiB;
constexpr size_t WS_K = 176 * MiB;
constexpr size_t WS_H8 = 208 * MiB;
constexpr size_t WS_VT = 240 * MiB;
#ifndef P5_EARLY
#define P5_EARLY 1
#endif
constexpr size_t WS_GRET = P5_EARLY ? 80 * MiB : 144 * MiB;
constexpr size_t WS_GPOOL = P5_EARLY ? 112 * MiB : 240 * MiB;
constexpr size_t WS_UT = 432 * MiB;
constexpr size_t WS_VTAB = 400 * MiB;
constexpr size_t WS_GR = 304 * MiB;
constexpr size_t WS_PIN = 368 * MiB;
constexpr size_t WS_ST = 400 * MiB;
constexpr size_t WS_POOLED = 464 * MiB;
constexpr size_t WS_RETN = 464 * MiB;
constexpr size_t WS_X1 = 400 * MiB;
constexpr size_t WS_SCR = 272 * MiB;
constexpr size_t WS_END = 528 * MiB;
#ifndef GATES_FP8
#define GATES_FP8 1
#endif
#ifndef P9_SLICED
#define P9_SLICED 1
#endif
constexpr int CW_BAR = 4096;
constexpr int CW_SUMSQ = 65536;

constexpr int LDS_BYTES = 147456;
constexpr int MISC_OFF = 143360;

struct Frame {
    LAS unsigned char* lds;
    int tid, lane, wave, G, vcu;
};
__device__ __forceinline__ float wave_sum(float v) {
#pragma unroll
    for (int o = 1; o < 64; o <<= 1) v += __shfl_xor(v, o);
    return v;
}
typedef GAS const v4u gcv4u;
typedef GAS v4u gv4u;
typedef GAS const f32x4 gcf4;
typedef GAS f32x4 gf4;
__device__ __forceinline__ float bflo(unsigned u) { return __builtin_bit_cast(float, u << 16); }
__device__ __forceinline__ float bfhi(unsigned u) { return __builtin_bit_cast(float, u & 0xffff0000u); }
__device__ __forceinline__ float log2_gamma(int h) { return pg8::log2_gamma(h); }

constexpr float U_SCALE = 256.0f, V_SCALE = 32.0f, H8_SCALE = 16.0f, WG8_SCALE = 512.0f;
__device__ __forceinline__ unsigned pk4_fp8(f32x4 a) { int p = __builtin_amdgcn_cvt_pk_fp8_f32(a[0], a[1], 0, false); p = __builtin_amdgcn_cvt_pk_fp8_f32(a[2], a[3], p, true); return (unsigned)p; }
__device__ __forceinline__ void win_rows(int c, int& rmain, int& rkv) {
    rmain = -1; rkv = -1;
    if (c < 2048) { const int isk = c >> 10, cc = c & 1023, hh = cc >> 7, r = cc & 127, half = r >> 6, i = r & 63;
        rmain = isk * 1024 + hh * 128 + 2 * i + half;
    }
    else if (c < 4096) rkv = c - 2048;
    else if (c < 6144) rmain = 2048 + (c - 4096);
    else if (c < 7168) rmain = 4096 + (c - 6144);
    else rmain = 5120 + (c - 7168);
}
struct P0Item { const float* W; const float* ksc; bf16* WT; bf16* WT2; int ldw, k0, n0, ldt, row_off, mode; float f8; };
__device__ __forceinline__ void p0_item_load(const P0Item& I, int lane, f32x4 (&v)[8]) {
#pragma unroll
    for (int i = 0; i < 8; ++i) { const int kk = 8 * i + (lane >> 3), nn = 4 * (lane & 7); v[i] = *(gcf4*)(I.W + (size_t)(I.k0 + kk) * I.ldw + I.n0 + nn); }
}
__device__ __forceinline__ void p0_item_store(const P0Item& I, int lane, const f32x4 (&v)[8], LAS float* scr) {
#pragma unroll
    for (int i = 0; i < 8; ++i) { const int kk = 8 * i + (lane >> 3), nn = 4 * (lane & 7); f32x4 x = v[i]; if (I.ksc) x = x * I.ksc[I.k0 + kk];
        scr[kk * 33 + nn] = x[0]; scr[kk * 33 + nn + 1] = x[1]; scr[kk * 33 + nn + 2] = x[2]; scr[kk * 33 + nn + 3] = x[3]; }
    LDS_WAIT(); asm volatile("" ::: "memory");
    const int c = lane & 7;
#pragma unroll
    for (int j = 0; j < 4; ++j) { const int n = (lane >> 3) + 8 * j; const LAS float* s = scr + (8 * c) * 33 + n;
        v4u o; o.x = pk2(s[0 * 33], s[1 * 33]); o.y = pk2(s[2 * 33], s[3 * 33]); o.z = pk2(s[4 * 33], s[5 * 33]); o.w = pk2(s[6 * 33], s[7 * 33]);
        if (I.mode == 0) {
            if (I.f8 > 0.f) { const f32x4 lo4 = (f32x4){s[0 * 33], s[1 * 33], s[2 * 33], s[3 * 33]} * I.f8, hi4 = (f32x4){s[4 * 33], s[5 * 33], s[6 * 33], s[7 * 33]} * I.f8;
                st8_wt((unsigned char*)I.WT + (size_t)(I.row_off + I.n0 + n) * I.ldt + I.k0 + 8 * c, (unsigned long long)pk4_fp8(lo4) | ((unsigned long long)pk4_fp8(hi4) << 32)); }
            else st16_wt(I.WT + (size_t)(I.row_off + I.n0 + n) * I.ldt + I.k0 + 8 * c, o); }
        else { int r1, r2; win_rows(I.n0 + n, r1, r2);
            const int g0 = r1 < 2048 ? 0 : r1 < 4096 ? 2048 : r1 < 5120 ? 4096 : 5120;
            const bool f8row = r1 >= 0 && (r1 < 2048 ? (MAIN_FP8 & 1) != 0 : r1 < 4096 ? (MAIN_FP8 & 2) != 0 : r1 < 5120 ? (MAIN_FP8 & 4) != 0 : GATES_FP8 != 0);
            if (f8row) {
                const f32x4 lo4 = (f32x4){s[0 * 33], s[1 * 33], s[2 * 33], s[3 * 33]} * WG8_SCALE, hi4 = (f32x4){s[4 * 33], s[5 * 33], s[6 * 33], s[7 * 33]} * WG8_SCALE;
                st8_wt((unsigned char*)(I.WT + (size_t)g0 * I.ldt) + (size_t)(r1 - g0) * 2048 + I.k0 + 8 * c, (unsigned long long)pk4_fp8(lo4) | ((unsigned long long)pk4_fp8(hi4) << 32)); }
            else if (r1 >= 0) st16_wt(I.WT + (size_t)r1 * I.ldt + I.k0 + 8 * c, o);
            if (r2 >= 0) {
                if (KV_FP8) { const f32x4 lo4 = (f32x4){s[0 * 33], s[1 * 33], s[2 * 33], s[3 * 33]} * WG8_SCALE, hi4 = (f32x4){s[4 * 33], s[5 * 33], s[6 * 33], s[7 * 33]} * WG8_SCALE;
                    st8_wt((unsigned char*)I.WT2 + (size_t)r2 * 2048 + I.k0 + 8 * c, (unsigned long long)pk4_fp8(lo4) | ((unsigned long long)pk4_fp8(hi4) << 32)); }
                else st16_wt(I.WT2 + (size_t)r2 * I.ldt + I.k0 + 8 * c, o); } } }
    LDS_WAIT(); asm volatile("" ::: "memory");
}
__device__ __forceinline__ void rms_rows_to_bf16(int lane, int m0, int mstep, const float* x, const float* w, bf16* h, unsigned char* h8) {
    const GAS f32x4* wr = (const GAS f32x4*)w + 2 * lane;
    f32x4 wv[8], v[8];
#pragma unroll
    for (int j = 0; j < 4; ++j) { wv[2 * j] = wr[128 * j]; wv[2 * j + 1] = wr[128 * j + 1]; }
    if (m0 < TOK) { const GAS f32x4* xr = (const GAS f32x4*)(x + (size_t)m0 * DM) + 2 * lane;
#pragma unroll
        for (int j = 0; j < 4; ++j) { v[2 * j] = xr[128 * j]; v[2 * j + 1] = xr[128 * j + 1]; } }
    for (int m = m0; m < TOK; m += mstep) {
        f32x4 c[8]; float s = 0.f;
#pragma unroll
        for (int j = 0; j < 8; ++j) { c[j] = v[j]; s += (v[j].x * v[j].x + v[j].y * v[j].y) + (v[j].z * v[j].z + v[j].w * v[j].w); }
        if (m + mstep < TOK) { const GAS f32x4* xr = (const GAS f32x4*)(x + (size_t)(m + mstep) * DM) + 2 * lane;
#pragma unroll
            for (int j = 0; j < 4; ++j) { v[2 * j] = xr[128 * j]; v[2 * j + 1] = xr[128 * j + 1]; } }
        const float rstd = __builtin_amdgcn_rsqf(wave_sum(s) * (1.f / DM) + EPS);
        bf16* orow = h + (size_t)m * DM; unsigned char* o8row = h8 + (size_t)m * DM;
#pragma unroll
        for (int j = 0; j < 4; ++j) { const f32x4 wa = wv[2 * j], wb = wv[2 * j + 1], a = c[2 * j], b = c[2 * j + 1];
            v4u o; o.x = pk2(a.x * rstd * wa.x, a.y * rstd * wa.y); o.y = pk2(a.z * rstd * wa.z, a.w * rstd * wa.w); o.z = pk2(b.x * rstd * wb.x, b.y * rstd * wb.y); o.w = pk2(b.z * rstd * wb.z, b.w * rstd * wb.w);
            st16_wt(orow + 512 * j + 8 * lane, o);
            if (GATES_FP8) st8_wt(o8row + 512 * j + 8 * lane, (unsigned long long)pk4_fp8(a * (rstd * H8_SCALE) * wa) | ((unsigned long long)pk4_fp8(b * (rstd * H8_SCALE) * wb) << 32)); }
    }
}
struct P0Args { const float *x, *norm1_w, *w_in, *w_ret_o, *w_pool_lin, *w_pool_o, *w_out, *norm2_w, *peer_w_q, *sub_keys;
    bf16 *Wmain, *Wkv, *Wro, *Wpo, *Wout, *Wq, *linT, *keys, *h; unsigned char* h8; };
__device__ __forceinline__ void p0_prologue(const Frame& F, const P0Args& a) {
    LAS float* scr = (LAS float*)(F.lds + F.wave * 16384);
    const int gw = F.vcu * NWAVES + F.wave, NGW = F.G * NWAVES;
    constexpr int I_IN = 32 * 352, I_SQ = 32 * 64, I_PO = 16 * 64, I_LIN = 4 * 4 * 8;
    constexpr int NITEMS = I_IN + 3 * I_SQ + I_PO + I_LIN;
    auto item_of = [&](int it) {
        P0Item I; int r = it; I.ksc = nullptr; I.WT2 = nullptr; I.row_off = 0; I.mode = 0; I.f8 = 0.f;
        if (r < I_IN) { I.W = a.w_in; I.ldw = INC; I.k0 = 64 * (r / 352); I.n0 = 32 * (r % 352); I.WT = a.Wmain; I.WT2 = a.Wkv; I.ldt = DM; I.mode = 1; return I; } r -= I_IN;
        if (r < I_SQ) { I.W = a.w_ret_o; I.ldw = DM; I.k0 = 64 * (r / 64); I.n0 = 32 * (r % 64); I.WT = a.Wro; I.ldt = DM; if (MIX_FP8) I.f8 = pg8::WB8_SCALE; return I; } r -= I_SQ;
        if (r < I_SQ) { I.W = a.w_out; I.ldw = DM; I.k0 = 64 * (r / 64); I.n0 = 32 * (r % 64); I.WT = a.Wout; I.ldt = DM; if (OUT_FP8) I.f8 = pg8::WO8_SCALE; return I; } r -= I_SQ;
        if (r < I_SQ) { I.W = a.peer_w_q; I.ldw = DM; I.k0 = 64 * (r / 64); I.n0 = 32 * (r % 64); I.WT = a.Wq; I.ldt = DM; I.ksc = a.norm2_w; return I; } r -= I_SQ;
        if (r < I_PO) { I.W = a.w_pool_o; I.ldw = DM; I.k0 = 64 * (r / 64); I.n0 = 32 * (r % 64); I.WT = a.Wpo; I.ldt = (MIX_FP8 && P6_CHAIN) ? 2048 : 1024; if (MIX_FP8) I.f8 = pg8::WB8_SCALE; return I; } r -= I_PO;
        { const int g = r >> 5; I.W = a.w_pool_lin + (size_t)g * 65536; I.ldw = 256; I.k0 = 64 * ((r >> 3) & 3); I.n0 = 32 * (r & 7); I.WT = a.linT; I.ldt = 256; I.row_off = g * 256; return I; }
    };
    {
        f32x4 v[8]; int it = gw; P0Item cur;
        if (it < NITEMS) { cur = item_of(it); p0_item_load(cur, F.lane, v); }
        for (; it < NITEMS; it += NGW) {
            f32x4 vc[8];
#pragma unroll
            for (int i = 0; i < 8; ++i) vc[i] = v[i];
            const P0Item now = cur;
            if (it + NGW < NITEMS) { cur = item_of(it + NGW); p0_item_load(cur, F.lane, v); }
            p0_item_store(now, F.lane, vc, scr);
        }
    }
    rms_rows_to_bf16(F.lane, gw, NGW, a.x, a.norm1_w, a.h, a.h8);
    for (int i = (gw * 64 + F.lane) * 2; i < 2 * 128 * 128; i += NGW * 64 * 2) st4_wt(a.keys + i, pk2(a.sub_keys[i], a.sub_keys[i + 1]));
}

constexpr int P2_PITCH = 272;
constexpr int P2_VOFF = 128 * P2_PITCH;
__device__ __forceinline__ void p2_kv_load(const Frame& F, int uu, const bf16* k, const bf16* vT, v4u (&rv)[8], v4u (&r)[4]) {
    const int bh = uu / 63, n = uu - bh * 63;
    const bf16* vb = vT + ((size_t)bh * 256) * 8192 + 128 * n;
#pragma unroll
    for (int i = 0; i < 8; ++i) { const int idx = F.tid + 512 * i, row = idx >> 4, ch = idx & 15; rv[i] = *(gcv4u*)(vb + (size_t)row * 8192 + ch * 8); }
    const int j = F.tid & 127, dg = F.tid >> 7;
    const bf16* src = k + ((size_t)bh * 8192 + 128 * n + j) * 128 + 32 * dg;
#pragma unroll
    for (int c = 0; c < 4; ++c) r[c] = *(gcv4u*)(src + 8 * c);
}
__device__ __forceinline__ void p2_kv_phase(const Frame& F, const bf16* k, const bf16* vT, bf16* st) {
    const int w = F.wave, fr = F.lane & 15, fq = F.lane >> 4;
    LAS unsigned char* KT = F.lds; LAS unsigned char* VT = F.lds + P2_VOFF;
    v4u rv[8], r[4];
    int uu = F.vcu;
    if (uu < 16 * 63) p2_kv_load(F, uu, k, vT, rv, r);
#pragma unroll 1
    for (; uu < 16 * 63; uu += F.G) {
        const int bh = uu / 63, n = uu - bh * 63, hh = bh & 7;
        {   const int j = F.tid & 127, dg = F.tid >> 7;
            const float zz = __builtin_amdgcn_exp2f((float)(127 - j) * log2_gamma(hh));
#pragma unroll
            for (int c = 0; c < 4; ++c) { const unsigned wv[4] = {r[c].x, r[c].y, r[c].z, r[c].w};
#pragma unroll
                for (int q = 0; q < 4; ++q) { const unsigned pk = pk2(bflo(wv[q]) * zz, bfhi(wv[q]) * zz); const int d = 32 * dg + 8 * c + 2 * q;
                    *(LAS unsigned short*)(KT + d * P2_PITCH + 2 * j) = (unsigned short)pk; *(LAS unsigned short*)(KT + (d + 1) * P2_PITCH + 2 * j) = (unsigned short)(pk >> 16); } }
#pragma unroll
            for (int i = 0; i < 8; ++i) { const int idx = F.tid + 512 * i, row = idx >> 4, ch = idx & 15; *(LAS v4u*)(VT + row * P2_PITCH + ch * 16) = rv[i]; }
        }
        __syncthreads();
        if (uu + F.G < 16 * 63) p2_kv_load(F, uu + F.G, k, vT, rv, r);
        f32x4 acc[8][2];
#pragma unroll
        for (int dt = 0; dt < 8; ++dt) { acc[dt][0] = (f32x4){0.f, 0.f, 0.f, 0.f}; acc[dt][1] = (f32x4){0.f, 0.f, 0.f, 0.f}; }
#pragma unroll 2
        for (int ks = 0; ks < 4; ++ks) {
            bf16x8 vf[2], kf[8];
#pragma unroll
            for (int t = 0; t < 2; ++t) vf[t] = *(LAS const bf16x8*)(VT + (32 * w + 16 * t + fr) * P2_PITCH + (32 * ks + 8 * fq) * 2);
#pragma unroll
            for (int dt = 0; dt < 8; ++dt) kf[dt] = *(LAS const bf16x8*)(KT + (32 * (dt >> 1) + 8 * (fr >> 2) + 4 * (dt & 1) + (fr & 3)) * P2_PITCH + (32 * ks + 8 * fq) * 2);
#pragma unroll
            for (int dt = 0; dt < 8; ++dt)
#pragma unroll
                for (int t = 0; t < 2; ++t) acc[dt][t] = __builtin_amdgcn_mfma_f32_16x16x32_bf16(kf[dt], vf[t], acc[dt][t], 0, 0, 0);
        }
        bf16* so = st + ((size_t)(bh * 64 + n) * 256 + 32 * w + fr) * 128 + 8 * fq;
#pragma unroll
        for (int pp = 0; pp < 4; ++pp)
#pragma unroll
            for (int t = 0; t < 2; ++t) { const f32x4 v0 = acc[2 * pp][t], v1 = acc[2 * pp + 1][t];
                v4u o; o.x = pk2(v0[0], v0[1]); o.y = pk2(v0[2], v0[3]); o.z = pk2(v1[0], v1[1]); o.w = pk2(v1[2], v1[3]);
                st16_wt(so + (size_t)(16 * t) * 128 + 32 * pp, o); }
        __syncthreads();
    }
}
template <int W>
__device__ __forceinline__ void p2_pool_g(const Frame& F, const bf16* pin, bf16* pooled, int g) {
    const int NT = F.G * NWAVES * 64;
    for (int item = F.vcu * NWAVES * 64 + F.tid; item < TOK * 32; item += NT) {
        const int tok = item >> 5, ch = item & 31, s = tok & 8191, cnt = (s + 1 < W) ? s + 1 : W;
        const bf16* p = pin + (size_t)tok * 1024 + g * 256 + 8 * ch;
        v4u r[W];
#pragma unroll
        for (int t = 0; t < W; ++t) { const int tt = (t < cnt) ? t : 0; r[t] = *(gcv4u*)(p - (size_t)tt * 1024); }
        float sm[8];
#pragma unroll
        for (int q = 0; q < 8; ++q) sm[q] = 0.f;
#pragma unroll
        for (int t = 0; t < W; ++t) { const float m = (t < cnt) ? 1.f : 0.f;
            sm[0] += m * bflo(r[t].x); sm[1] += m * bfhi(r[t].x); sm[2] += m * bflo(r[t].y); sm[3] += m * bfhi(r[t].y); sm[4] += m * bflo(r[t].z); sm[5] += m * bfhi(r[t].z); sm[6] += m * bflo(r[t].w); sm[7] += m * bfhi(r[t].w); }
        const float ic = 1.0f / (float)cnt;
        v4u o; o.x = pk2(sm[0] * ic - bflo(r[0].x), sm[1] * ic - bfhi(r[0].x)); o.y = pk2(sm[2] * ic - bflo(r[0].y), sm[3] * ic - bfhi(r[0].y));
        o.z = pk2(sm[4] * ic - bflo(r[0].z), sm[5] * ic - bfhi(r[0].z)); o.w = pk2(sm[6] * ic - bflo(r[0].w), sm[7] * ic - bfhi(r[0].w));
        st16_wt(pooled + ((size_t)g * TOK + tok) * 256 + 8 * ch, o);
    }
}
__device__ __forceinline__ void p2_pool(const Frame& F, const bf16* pin, bf16* pooled) {
    p2_pool_g<2>(F, pin, pooled, 0); p2_pool_g<4>(F, pin, pooled, 1); p2_pool_g<8>(F, pin, pooled, 2); p2_pool_g<16>(F, pin, pooled, 3);
}

__device__ __forceinline__ void p3_scan(const Frame& F, bf16* st) {
    const int NT = F.G * NWAVES * 64;
    for (int vid = F.vcu * NWAVES * 64 + F.tid; vid < 131072; vid += NT) {
        const int bh = vid >> 13, vec = vid & 8191, hh = bh & 7;
        const float gc = __builtin_amdgcn_exp2f(128.0f * log2_gamma(hh));
        bf16* p = st + (size_t)bh * 64 * 32768 + 4 * vec;
        float R[4] = {0.f, 0.f, 0.f, 0.f};
        unsigned long long cur[8], nxt[8];
#pragma unroll
        for (int t = 0; t < 8; ++t) cur[t] = *(const GAS unsigned long long*)(p + (size_t)t * 32768);
#pragma unroll 1
        for (int n0 = 0; n0 < 64; n0 += 8) {
#pragma unroll
            for (int t = 0; t < 8; ++t) nxt[t] = (n0 + 8 + t < 63) ? *(const GAS unsigned long long*)(p + (size_t)(n0 + 8 + t) * 32768) : 0ull;
#pragma unroll
            for (int t = 0; t < 8; ++t) {
                st8_wt(p + (size_t)(n0 + t) * 32768, (unsigned long long)pk2(R[0], R[1]) | ((unsigned long long)pk2(R[2], R[3]) << 32));
                const unsigned lo = (unsigned)cur[t], hi = (unsigned)(cur[t] >> 32);
                R[0] = gc * R[0] + bflo(lo); R[1] = gc * R[1] + bfhi(lo); R[2] = gc * R[2] + bflo(hi); R[3] = gc * R[3] + bfhi(hi);
            }
#pragma unroll
            for (int t = 0; t < 8; ++t) cur[t] = nxt[t];
        }
    }
}

constexpr int P4_PITCH = 272;
__device__ __forceinline__ void p4_unit(const Frame& F, int uu, const bf16* q, const bf16* k, const bf16* vT, const bf16* st, const bf16* grs, bf16* retn) {
    const int bh = uu >> 6, n = uu & 63, hh = bh & 7, b = bh >> 3;
    const int w = F.wave, wr = w >> 2, wc = w & 3, fr = F.lane & 15, fq = F.lane >> 4;
    const float lg = log2_gamma(hh);
    LAS unsigned char* P = F.lds;
    LAS float* stats = (LAS float*)(F.lds + 128 * P4_PITCH);
    const bf16* Qb = q + ((size_t)bh * 8192 + 128 * n) * 128;
    const bf16* Kb = k + ((size_t)bh * 8192 + 128 * n) * 128;
    {
        f32x4 sa[4][2];
#pragma unroll
        for (int it = 0; it < 4; ++it) { sa[it][0] = (f32x4){0.f, 0.f, 0.f, 0.f}; sa[it][1] = (f32x4){0.f, 0.f, 0.f, 0.f}; }
#pragma unroll
        for (int ks = 0; ks < 4; ++ks) {
            bf16x8 qf[4], kf[2];
#pragma unroll
            for (int it = 0; it < 4; ++it) qf[it] = *(GAS const bf16x8*)(Qb + (size_t)(64 * wr + 16 * it + fr) * 128 + 32 * ks + 8 * fq);
#pragma unroll
            for (int jt = 0; jt < 2; ++jt) kf[jt] = *(GAS const bf16x8*)(Kb + (size_t)(32 * wc + 16 * jt + fr) * 128 + 32 * ks + 8 * fq);
#pragma unroll
            for (int it = 0; it < 4; ++it)
#pragma unroll
                for (int jt = 0; jt < 2; ++jt) sa[it][jt] = __builtin_amdgcn_mfma_f32_16x16x32_bf16(kf[jt], qf[it], sa[it][jt], 0, 0, 0);
        }
#pragma unroll
        for (int it = 0; it < 4; ++it)
#pragma unroll
            for (int jt = 0; jt < 2; ++jt) {
                const int i = 64 * wr + 16 * it + fr, j0 = 32 * wc + 16 * jt + 4 * fq;
                float pv[4];
#pragma unroll
                for (int r = 0; r < 4; ++r) { const int dlt = i - (j0 + r); pv[r] = (dlt >= 0) ? sa[it][jt][r] * __builtin_amdgcn_exp2f((float)dlt * lg) : 0.f; }
                *(LAS unsigned long long*)(P + i * P4_PITCH + j0 * 2) = (unsigned long long)pk2(pv[0], pv[1]) | ((unsigned long long)pk2(pv[2], pv[3]) << 32);
            }
    }
    __syncthreads();
    f32x4 acc[4][4];
#pragma unroll
    for (int it = 0; it < 4; ++it)
#pragma unroll
        for (int et = 0; et < 4; ++et) acc[it][et] = (f32x4){0.f, 0.f, 0.f, 0.f};
    const bf16* RTb = st + ((size_t)(bh * 64 + n)) * 32768;
    const bf16* vTb = vT + ((size_t)bh * 256) * 8192 + 128 * n;
    int esrc[4];
#pragma unroll
    for (int et = 0; et < 4; ++et) esrc[et] = 64 * wc + 32 * (et >> 1) + 8 * (fr >> 2) + 4 * (et & 1) + (fr & 3);
#pragma unroll
    for (int ks = 0; ks < 4; ++ks) {
        bf16x8 qf[4], rf[4];
#pragma unroll
        for (int it = 0; it < 4; ++it) qf[it] = *(GAS const bf16x8*)(Qb + (size_t)(64 * wr + 16 * it + fr) * 128 + 32 * ks + 8 * fq);
#pragma unroll
        for (int et = 0; et < 4; ++et) rf[et] = *(GAS const bf16x8*)(RTb + (size_t)esrc[et] * 128 + 32 * ks + 8 * fq);
#pragma unroll
        for (int it = 0; it < 4; ++it)
#pragma unroll
            for (int et = 0; et < 4; ++et) acc[it][et] = __builtin_amdgcn_mfma_f32_16x16x32_bf16(rf[et], qf[it], acc[it][et], 0, 0, 0);
    }
#pragma unroll
    for (int it = 0; it < 4; ++it) { const float xi = __builtin_amdgcn_exp2f((float)(64 * wr + 16 * it + fr + 1) * lg);
#pragma unroll
        for (int et = 0; et < 4; ++et) acc[it][et] = acc[it][et] * xi; }
#pragma unroll
    for (int ks = 0; ks < 4; ++ks) {
        bf16x8 pf[4], vf[4];
#pragma unroll
        for (int it = 0; it < 4; ++it) pf[it] = *(LAS const bf16x8*)(P + (64 * wr + 16 * it + fr) * P4_PITCH + (32 * ks + 8 * fq) * 2);
#pragma unroll
        for (int et = 0; et < 4; ++et) vf[et] = *(GAS const bf16x8*)(vTb + (size_t)esrc[et] * 8192 + 32 * ks + 8 * fq);
#pragma unroll
        for (int it = 0; it < 4; ++it)
#pragma unroll
            for (int et = 0; et < 4; ++et) acc[it][et] = __builtin_amdgcn_mfma_f32_16x16x32_bf16(vf[et], pf[it], acc[it][et], 0, 0, 0);
    }
#pragma unroll
    for (int it = 0; it < 4; ++it) {
        float s1 = 0.f, s2 = 0.f;
#pragma unroll
        for (int et = 0; et < 4; ++et)
#pragma unroll
            for (int r = 0; r < 4; ++r) { const float v = acc[it][et][r]; s1 += v; s2 += v * v; }
        s1 += __shfl_xor(s1, 16); s1 += __shfl_xor(s1, 32); s2 += __shfl_xor(s2, 16); s2 += __shfl_xor(s2, 32);
        if (fq == 0) { const int i = 64 * wr + 16 * it + fr; stats[(i * 4 + wc) * 2] = s1; stats[(i * 4 + wc) * 2 + 1] = s2; }
    }
    __syncthreads();
#pragma unroll
    for (int it = 0; it < 4; ++it) {
        const int i = 64 * wr + 16 * it + fr;
        float s1 = 0.f, s2 = 0.f;
#pragma unroll
        for (int c = 0; c < 4; ++c) { s1 += stats[(i * 4 + c) * 2]; s2 += stats[(i * 4 + c) * 2 + 1]; }
        const float mu = s1 * (1.f / 256.f), var = s2 * (1.f / 256.f) - mu * mu, rstd = __builtin_amdgcn_rsqf(fmaxf(var, 0.f) + EPS);
        const size_t tok = (size_t)b * 8192 + 128 * n + i;
#pragma unroll
        for (int t = 0; t < 2; ++t) {
            const size_t off = tok * 2048 + hh * 256 + 64 * wc + 32 * t + 8 * fq;
            const v4u g = *(gcv4u*)(grs + off);
            const f32x4 a0 = acc[it][2 * t], a1 = acc[it][2 * t + 1];
            v4u o;
            o.x = pk2((a0[0] - mu) * rstd * bflo(g.x), (a0[1] - mu) * rstd * bfhi(g.x)); o.y = pk2((a0[2] - mu) * rstd * bflo(g.y), (a0[3] - mu) * rstd * bfhi(g.y));
            o.z = pk2((a1[0] - mu) * rstd * bflo(g.z), (a1[1] - mu) * rstd * bfhi(g.z)); o.w = pk2((a1[2] - mu) * rstd * bflo(g.w), (a1[3] - mu) * rstd * bfhi(g.w));
            st16_wt(retn + off, o);
        }
    }
    __syncthreads();
}

constexpr int P4_QOFF = 0, P4_KOFF = 34816, P4_VOFF = 69632, P4_SOFF = 139264;
#ifndef P4_KS_UNR
#define P4_KS_UNR 2
#endif
__device__ __forceinline__ void p4_unit2(const Frame& F, int uu, int uu_next, v4u (&rq)[4], v4u (&rk)[4], const bf16* q, const bf16* k, const bf16* vT, const bf16* st, const bf16* grs, bf16* retn) {
    const int bh = uu >> 6, n = uu & 63, hh = bh & 7, b = bh >> 3;
    const int tid = F.tid, w = F.wave, wr = w >> 2, wc = w & 3, fr = F.lane & 15, fq = F.lane >> 4;
    const float lg = log2_gamma(hh);
    LAS unsigned char* LQ = F.lds + P4_QOFF; LAS unsigned char* LK = F.lds + P4_KOFF; LAS unsigned char* LV = F.lds + P4_VOFF;
    LAS float* stats = (LAS float*)(F.lds + P4_SOFF);
    const bf16* Qb = q + ((size_t)bh * 8192 + 128 * n) * 128;
    const bf16* Kb = k + ((size_t)bh * 8192 + 128 * n) * 128;
    const bf16* RTb = st + ((size_t)(bh * 64 + n)) * 32768;
    const bf16* vTb = vT + ((size_t)bh * 256) * 8192 + 128 * n;
    {
        v4u rr[8];
#pragma unroll
        for (int i = 0; i < 8; ++i) { const int idx = tid + 512 * i; rr[i] = *(gcv4u*)(RTb + idx * 8); }
#pragma unroll
        for (int i = 0; i < 4; ++i) { const int idx = tid + 512 * i, row = idx >> 4, ch = idx & 15; *(LAS v4u*)(LQ + row * 272 + ch * 16) = rq[i]; *(LAS v4u*)(LK + row * 272 + ch * 16) = rk[i]; }
#pragma unroll
        for (int i = 0; i < 8; ++i) { const int idx = tid + 512 * i, row = idx >> 4, ch = idx & 15; *(LAS v4u*)(LV + row * 272 + ch * 16) = rr[i]; }
    }
    __syncthreads();
    f32x4 sa[4][2];
#pragma unroll
    for (int it = 0; it < 4; ++it) { sa[it][0] = (f32x4){0.f, 0.f, 0.f, 0.f}; sa[it][1] = (f32x4){0.f, 0.f, 0.f, 0.f}; }
#pragma unroll
    for (int ks = 0; ks < 4; ++ks) {
        bf16x8 qf[4], kf[2];
#pragma unroll
        for (int it = 0; it < 4; ++it) qf[it] = *(LAS const bf16x8*)(LQ + (64 * wr + 16 * it + fr) * 272 + (32 * ks + 8 * fq) * 2);
#pragma unroll
        for (int jt = 0; jt < 2; ++jt) kf[jt] = *(LAS const bf16x8*)(LK + (32 * wc + 16 * jt + fr) * 272 + (32 * ks + 8 * fq) * 2);
#pragma unroll
        for (int it = 0; it < 4; ++it)
#pragma unroll
            for (int jt = 0; jt < 2; ++jt) sa[it][jt] = __builtin_amdgcn_mfma_f32_16x16x32_bf16(kf[jt], qf[it], sa[it][jt], 0, 0, 0);
    }
    v4u rv[8];
#pragma unroll
    for (int i = 0; i < 8; ++i) { const int idx = tid + 512 * i, row = idx >> 4, ch = idx & 15; rv[i] = *(gcv4u*)(vTb + (size_t)row * 8192 + ch * 8); }
    __syncthreads();
#pragma unroll
    for (int it = 0; it < 4; ++it)
#pragma unroll
        for (int jt = 0; jt < 2; ++jt) {
            const int i = 64 * wr + 16 * it + fr, j0 = 32 * wc + 16 * jt + 4 * fq;
            float pv[4];
#pragma unroll
            for (int r = 0; r < 4; ++r) { const int dlt = i - (j0 + r); pv[r] = (dlt >= 0) ? sa[it][jt][r] * __builtin_amdgcn_exp2f((float)dlt * lg) : 0.f; }
            *(LAS unsigned long long*)(LK + i * 272 + j0 * 2) = (unsigned long long)pk2(pv[0], pv[1]) | ((unsigned long long)pk2(pv[2], pv[3]) << 32);
        }
    f32x4 acc[4][4];
#pragma unroll
    for (int it = 0; it < 4; ++it)
#pragma unroll
        for (int et = 0; et < 4; ++et) acc[it][et] = (f32x4){0.f, 0.f, 0.f, 0.f};
    int esrc[4];
#pragma unroll
    for (int et = 0; et < 4; ++et) esrc[et] = 64 * wc + 32 * (et >> 1) + 8 * (fr >> 2) + 4 * (et & 1) + (fr & 3);
#pragma unroll P4_KS_UNR
    for (int ks = 0; ks < 4; ++ks) {
        bf16x8 qf[4], rf[4];
#pragma unroll
        for (int it = 0; it < 4; ++it) qf[it] = *(LAS const bf16x8*)(LQ + (64 * wr + 16 * it + fr) * 272 + (32 * ks + 8 * fq) * 2);
#pragma unroll
        for (int et = 0; et < 4; ++et) rf[et] = *(LAS const bf16x8*)(LV + esrc[et] * 272 + (32 * ks + 8 * fq) * 2);
#pragma unroll
        for (int it = 0; it < 4; ++it)
#pragma unroll
            for (int et = 0; et < 4; ++et) acc[it][et] = __builtin_amdgcn_mfma_f32_16x16x32_bf16(rf[et], qf[it], acc[it][et], 0, 0, 0);
    }
#pragma unroll
    for (int it = 0; it < 4; ++it) { const float xi = __builtin_amdgcn_exp2f((float)(64 * wr + 16 * it + fr + 1) * lg);
#pragma unroll
        for (int et = 0; et < 4; ++et) acc[it][et] = acc[it][et] * xi; }
    __syncthreads();
#pragma unroll
    for (int i = 0; i < 8; ++i) { const int idx = tid + 512 * i, row = idx >> 4, ch = idx & 15; *(LAS v4u*)(LV + row * 272 + ch * 16) = rv[i]; }
    __syncthreads();
    if (uu_next < 1024) {
        const int bh2 = uu_next >> 6, n2 = uu_next & 63;
        const bf16* Qn = q + ((size_t)bh2 * 8192 + 128 * n2) * 128; const bf16* Kn = k + ((size_t)bh2 * 8192 + 128 * n2) * 128;
#pragma unroll
        for (int i = 0; i < 4; ++i) { const int idx = tid + 512 * i; rq[i] = *(gcv4u*)(Qn + idx * 8); rk[i] = *(gcv4u*)(Kn + idx * 8); }
    }
#pragma unroll P4_KS_UNR
    for (int ks = 0; ks < 4; ++ks) {
        bf16x8 pf[4], vf[4];
#pragma unroll
        for (int it = 0; it < 4; ++it) pf[it] = *(LAS const bf16x8*)(LK + (64 * wr + 16 * it + fr) * 272 + (32 * ks + 8 * fq) * 2);
#pragma unroll
        for (int et = 0; et < 4; ++et) vf[et] = *(LAS const bf16x8*)(LV + esrc[et] * 272 + (32 * ks + 8 * fq) * 2);
#pragma unroll
        for (int it = 0; it < 4; ++it)
#pragma unroll
            for (int et = 0; et < 4; ++et) acc[it][et] = __builtin_amdgcn_mfma_f32_16x16x32_bf16(vf[et], pf[it], acc[it][et], 0, 0, 0);
    }
#pragma unroll
    for (int it = 0; it < 4; ++it) {
        float s1 = 0.f, s2 = 0.f;
#pragma unroll
        for (int et = 0; et < 4; ++et)
#pragma unroll
            for (int r = 0; r < 4; ++r) { const float v = acc[it][et][r]; s1 += v; s2 += v * v; }
        s1 += __shfl_xor(s1, 16); s1 += __shfl_xor(s1, 32); s2 += __shfl_xor(s2, 16); s2 += __shfl_xor(s2, 32);
        if (fq == 0) { const int i = 64 * wr + 16 * it + fr; stats[(i * 4 + wc) * 2] = s1; stats[(i * 4 + wc) * 2 + 1] = s2; }
    }
    __syncthreads();
    v4u gq[4][2];
#pragma unroll
    for (int it = 0; it < 4; ++it)
#pragma unroll
        for (int t = 0; t < 2; ++t) gq[it][t] = *(gcv4u*)(grs + ((size_t)b * 8192 + 128 * n + 64 * wr + 16 * it + fr) * 2048 + hh * 256 + 64 * wc + 32 * t + 8 * fq);
#pragma unroll
    for (int it = 0; it < 4; ++it) {
        const int i = 64 * wr + 16 * it + fr;
        float s1 = 0.f, s2 = 0.f;
#pragma unroll
        for (int c = 0; c < 4; ++c) { s1 += stats[(i * 4 + c) * 2]; s2 += stats[(i * 4 + c) * 2 + 1]; }
        const float mu = s1 * (1.f / 256.f), var = s2 * (1.f / 256.f) - mu * mu, rstd = __builtin_amdgcn_rsqf(fmaxf(var, 0.f) + EPS);
        const size_t tok = (size_t)b * 8192 + 128 * n + i;
#pragma unroll
        for (int t = 0; t < 2; ++t) {
            const size_t off = tok * 2048 + hh * 256 + 64 * wc + 32 * t + 8 * fq;
            const v4u g = gq[it][t];
            const f32x4 a0 = acc[it][2 * t], a1 = acc[it][2 * t + 1];
            v4u o;
            if (MIX_FP8) { const float rs8 = rstd * pg8::R8_SCALE;
                const f32x4 lo4 = (f32x4){(a0[0] - mu) * rs8 * bflo(g.x), (a0[1] - mu) * rs8 * bfhi(g.x), (a0[2] - mu) * rs8 * bflo(g.y), (a0[3] - mu) * rs8 * bfhi(g.y)};
                const f32x4 hi4 = (f32x4){(a1[0] - mu) * rs8 * bflo(g.z), (a1[1] - mu) * rs8 * bfhi(g.z), (a1[2] - mu) * rs8 * bflo(g.w), (a1[3] - mu) * rs8 * bfhi(g.w)};
                st8_wt((unsigned char*)retn + off, (unsigned long long)pk4_fp8(lo4) | ((unsigned long long)pk4_fp8(hi4) << 32)); }
            else {
            o.x = pk2((a0[0] - mu) * rstd * bflo(g.x), (a0[1] - mu) * rstd * bfhi(g.x)); o.y = pk2((a0[2] - mu) * rstd * bflo(g.y), (a0[3] - mu) * rstd * bfhi(g.y));
            o.z = pk2((a1[0] - mu) * rstd * bflo(g.z), (a1[1] - mu) * rstd * bfhi(g.z)); o.w = pk2((a1[2] - mu) * rstd * bflo(g.w), (a1[3] - mu) * rstd * bfhi(g.w));
            st16_wt(retn + off, o); }
        }
    }
    __syncthreads();
}

__device__ __forceinline__ void p4_phase2(const Frame& F, const bf16* q, const bf16* k, const bf16* vT, const bf16* st, const bf16* grs, bf16* retn) {
    v4u rq[4], rk[4];
    int uu = F.vcu;
    if (uu < 1024) {
        const int bh = uu >> 6, n = uu & 63;
        const bf16* Qb = q + ((size_t)bh * 8192 + 128 * n) * 128; const bf16* Kb = k + ((size_t)bh * 8192 + 128 * n) * 128;
#pragma unroll
        for (int i = 0; i < 4; ++i) { const int idx = F.tid + 512 * i; rq[i] = *(gcv4u*)(Qb + idx * 8); rk[i] = *(gcv4u*)(Kb + idx * 8); }
    }
#pragma unroll 1
    for (; uu < 1024; uu += F.G) p4_unit2(F, uu, uu + F.G, rq, rk, q, k, vT, st, grs, retn);
}
constexpr int TAB_LDS_OFF = 131072;
__device__ __forceinline__ void p6_tables(const Frame& F, const float* u, const float* v, const float* n2w, unsigned char* ut, unsigned char* vt, int r_lo, int r_hi) {
    const int gw = F.vcu * NWAVES + F.wave, NGW = F.G * NWAVES;
    int lane_ = (int)__builtin_amdgcn_mbcnt_hi(~0u, __builtin_amdgcn_mbcnt_lo(~0u, 0u)); asm volatile("" : "+v"(lane_));
    asm volatile("" : "+s"(n2w));
    LAS unsigned* img = (LAS unsigned*)(F.lds + TAB_LDS_OFF + F.wave * 1024);
    f32x4 wv[8];
#pragma unroll
    for (int i = 0; i < 8; ++i) wv[i] = *(gcf4*)(n2w + 256 * i + 4 * lane_) * U_SCALE;
    f32x4 nx[8];
    const int rb = r_lo + gw;
    if (rb < r_hi) { const float* src0 = ((rb >= 16384) ? v : u) + (size_t)(rb & 16383) * 2048 + 4 * lane_;
#pragma unroll
        for (int i = 0; i < 8; ++i) nx[i] = *(gcf4*)(src0 + 256 * i); }
    for (int r = rb; r < r_hi; r += NGW) {
        const bool isv = r >= 16384; const int rr = r & 16383;
        unsigned wq[8];
#pragma unroll
        for (int i = 0; i < 8; ++i) wq[i] = pk4_fp8(isv ? nx[i] * V_SCALE : nx[i] * wv[i]);
        if (r + NGW < r_hi) { const int r2 = r + NGW; const float* src2 = ((r2 >= 16384) ? v : u) + (size_t)(r2 & 16383) * 2048 + 4 * lane_;
#pragma unroll
            for (int i = 0; i < 8; ++i) nx[i] = *(gcf4*)(src2 + 256 * i); }
        unsigned char* dst = (isv ? vt : ut) + (size_t)(lane_ >> 3) * (16384 * 128) + (size_t)rr * 128 + 16 * (lane_ & 7);
#pragma unroll
        for (int h = 0; h < 2; ++h) {
#pragma unroll
            for (int k = 0; k < 4; ++k) img[64 * k + lane_] = wq[4 * h + k];
            const v4u o = *(LAS const v4u*)(img + 4 * lane_);
            st16_wt(dst + (size_t)h * (8 * 16384 * 128), o); }
    }
}

#ifndef P8_NB
#define P8_NB 4
#endif
constexpr int P8_SEG = 272;
constexpr int P8_KX_OFF = 512 * P8_SEG;
__device__ __forceinline__ int f2key(float f) { const int b = __builtin_bit_cast(int, f); return b ^ ((b >> 31) & 0x7fffffff); }
__device__ __forceinline__ float key2f(int k) { return __builtin_bit_cast(float, k ^ ((k >> 31) & 0x7fffffff)); }
__device__ __forceinline__ int imax(int a, int b) { return a > b ? a : b; }
__device__ __forceinline__ int imin(int a, int b) { return a < b ? a : b; }
#define TOPK_INS(L, xk) do { int _x = (xk); _Pragma("unroll") for (int _q = 0; _q < 16; ++_q) { const int _h = imax(L[_q], _x); _x = imin(L[_q], _x); L[_q] = _h; } } while (0)
#define BITONIC16(M) do { _Pragma("unroll") for (int _s = 8; _s >= 1; _s >>= 1) { _Pragma("unroll") for (int _i = 0; _i < 16; ++_i) if ((_i & _s) == 0) { const int _a = imax(M[_i], M[_i + _s]), _b = imin(M[_i], M[_i + _s]); M[_i] = _a; M[_i + _s] = _b; } } } while (0)
__device__ __forceinline__ float gelu_exact(float v) {
    const float av = __builtin_fabsf(v), t = __builtin_amdgcn_rcpf(av * 0.2316418882f + 1.0f);
    float q = t * 0.5307027145f + (-0.7265760135f); q = q * t + 0.7107068705f; q = q * t + (-0.142248368f); q = q * t + 0.127414796f; q = q * t;
    const float e = __builtin_amdgcn_exp2f((v * v) * (-0.72134752044f)), m = v * (q * e);
    return v < 0.f ? m : v - m;
}
typedef __bf16 bf16x2_t __attribute__((ext_vector_type(2)));
__device__ __forceinline__ float dot2bf(unsigned a, unsigned b, float c) { return __builtin_amdgcn_fdot2_f32_bf16(__builtin_bit_cast(bf16x2_t, a), __builtin_bit_cast(bf16x2_t, b), c, false); }

struct P8Args { const bf16 *qp, *keys, *x1b; const unsigned char *ut, *vt; const float *sumsq, *fw; float* out; };

__device__ __forceinline__ void p8_subtile(const Frame& F, int sub, const P8Args& a) {
    const int w = F.wave, lane = F.lane, fr = lane & 15, fq = lane >> 4, tid = F.tid;
    const int tok0 = sub * 16;
    LAS unsigned char* S = F.lds;
#ifndef P8_NO_A
    {
        f32x4 acc[2][8];
#pragma unroll
        for (int p = 0; p < 2; ++p)
#pragma unroll
            for (int kt = 0; kt < 8; ++kt) acc[p][kt] = (f32x4){0.f, 0.f, 0.f, 0.f};
        const bf16* qrow = a.qp + (size_t)(tok0 + 2 * w + (fr >> 3)) * 2048 + (fr & 7) * 256 + 8 * fq;
#pragma unroll
        for (int p = 0; p < 2; ++p)
#pragma unroll 1
            for (int ks = 0; ks < 4; ++ks) {
                const bf16x8 qf = *(GAS const bf16x8*)(qrow + p * 128 + 32 * ks);
#pragma unroll
                for (int kt = 0; kt < 8; ++kt) {
                    const bf16x8 kf = *(GAS const bf16x8*)(a.keys + (size_t)(p * 128 + 16 * kt + fr) * 128 + 32 * ks + 8 * fq);
                    acc[p][kt] = __builtin_amdgcn_mfma_f32_16x16x32_bf16(kf, qf, acc[p][kt], 0, 0, 0);
                }
            }
        const int row = 16 * w + fr;
#pragma unroll
        for (int p = 0; p < 2; ++p)
#pragma unroll
            for (int kt = 0; kt < 8; ++kt)
                *(LAS f32x4*)(S + (row * 4 + p * 2 + (kt >> 2)) * P8_SEG + (16 * (kt & 3) + 4 * fq) * 4) = acc[p][kt];
    }
#endif
    __syncthreads();
#ifndef P8_NO_B
    int T[16];
    {
        int L[16];
#pragma unroll
        for (int i = 0; i < 16; ++i) L[i] = (int)0x80000000;
        const int half = tid & 1;
#pragma unroll
        for (int c = 0; c < 16; ++c) {
            const f32x4 v = *(LAS const f32x4*)(S + tid * P8_SEG + c * 16);
#pragma unroll
            for (int j = 0; j < 4; ++j) { const int key = (f2key(v[j]) & ~127) | (half * 64 + 4 * c + j); TOPK_INS(L, key); }
        }
        int M[16];
#pragma unroll
        for (int i = 0; i < 16; ++i) M[i] = imax(L[i], __builtin_amdgcn_mov_dpp(L[15 - i], 0xB1, 0xF, 0xF, true));
        BITONIC16(M);
        float fa[16], fb[16];
        const bool q2 = (tid & 2) != 0;
#pragma unroll
        for (int i = 0; i < 16; ++i) { const int o = __builtin_amdgcn_mov_dpp(M[i], 0x4E, 0xF, 0xF, true); fa[i] = key2f(q2 ? o : M[i]); fb[i] = key2f(q2 ? M[i] : o); }
        if ((tid & 1) == 0) {
            LAS unsigned* kx = (LAS unsigned*)(S + P8_KX_OFF + (tid >> 2) * 32 + ((tid >> 1) & 1) * 16);
#pragma unroll
            for (int d = 0; d < 4; ++d) kx[d] = (unsigned)(M[4 * d] & 127) | ((unsigned)(M[4 * d + 1] & 127) << 8) | ((unsigned)(M[4 * d + 2] & 127) << 16) | ((unsigned)(M[4 * d + 3] & 127) << 24);
        }
#pragma unroll
        for (int i = 0; i < 16; ++i) T[i] = (int)0x80000000;
#pragma unroll
        for (int i = 0; i < 16; ++i)
#pragma unroll
            for (int j = 0; j < 16; ++j)
                if ((i + 1) * (j + 1) <= 16) { const int key = (f2key(fa[i] + fb[j]) & ~255) | (i * 16 + j); TOPK_INS(T, key); }
    }
    __syncthreads();
    {
        LAS int* eidxL = (LAS int*)S;
        LAS float* gateL = (LAS float*)(S + 8192);
        LAS const unsigned char* kx = (LAS const unsigned char*)(S + P8_KX_OFF + (tid >> 2) * 32);
        const float mx = key2f(T[0]);
        float ev[16], sum = 0.f;
#pragma unroll
        for (int r = 0; r < 16; ++r) { ev[r] = __builtin_amdgcn_exp2f((key2f(T[r]) - mx) * 1.4426950408889634f); sum += ev[r]; }
        const float inv = __builtin_amdgcn_rcpf(sum);
        const int q = tid & 3, row = tid >> 2;
#pragma unroll
        for (int r = 0; r < 16; ++r) if ((r >> 2) == q) {
            const int i = (T[r] >> 4) & 15, j = T[r] & 15;
            eidxL[row * 16 + r] = (int)kx[i] * 128 + (int)kx[16 + j];
            gateL[row * 16 + r] = ev[r] * inv;
        }
    }
#endif
    __syncthreads();
#ifndef P8_NO_C
    {
        LAS const int* eidxL = (LAS const int*)S;
        LAS const float* gateL = (LAS const float*)(S + 8192);
        typedef float f32x2v __attribute__((ext_vector_type(2)));
#pragma unroll 1
        for (int ti = 0; ti < 2; ++ti) {
            const int tt = 2 * w + ti; const size_t tok = (size_t)(tok0 + tt);
            const int e0 = eidxL[tt * 128 + lane], e1 = eidxL[tt * 128 + 64 + lane];
            unsigned xp[16];
#pragma unroll
            for (int h = 0; h < 2; ++h)
#pragma unroll
                for (int c = 0; c < 2; ++c) { const v4u t = *(gcv4u*)(a.x1b + tok * 2048 + 1024 * h + 16 * lane + 8 * c); xp[8 * h + 4 * c] = t.x; xp[8 * h + 4 * c + 1] = t.y; xp[8 * h + 4 * c + 2] = t.z; xp[8 * h + 4 * c + 3] = t.w; }
            const float rstd2 = __builtin_amdgcn_rsqf(wave_sum(lane < 32 ? a.sumsq[tok * 32 + lane] : 0.f) * (1.0f / 2048.0f) + EPS);
            float out[32];
#pragma unroll
            for (int i = 0; i < 32; ++i) out[i] = 0.f;
#define P8_LOAD8(buf, tab, rbx) do { _Pragma("unroll") for (int r = 0; r < P8_NB; ++r) { const int e = __builtin_amdgcn_readlane(ev, lbase + P8_NB * (rbx) + r); const unsigned char* base = (tab) + (size_t)e * 2048 + 16 * lane; \
                    buf[r][0] = *(gcv4u*)(base); buf[r][1] = *(gcv4u*)(base + 1024); } } while (0)
#pragma unroll 1
            for (int g = 0; g < 8; ++g) {
                const int ev = (g < 4) ? e0 : e1; const int lbase = (16 * g) & 63;
                float part[16];
#pragma unroll
                for (int rb = 0; rb < 16 / P8_NB; ++rb) {
                    v4u ub[P8_NB][2];
                    P8_LOAD8(ub, a.ut, rb);
#pragma unroll
                    for (int r = 0; r < P8_NB; ++r) { float p = 0.f;
#pragma unroll
                        for (int h = 0; h < 2; ++h) { const unsigned uw[4] = {ub[r][h].x, ub[r][h].y, ub[r][h].z, ub[r][h].w};
#pragma unroll
                            for (int d = 0; d < 4; ++d) {
                                p = __builtin_amdgcn_fdot2_f32_bf16(__builtin_amdgcn_cvt_scalef32_pk_bf16_fp8(uw[d], 1.0f / U_SCALE, false), __builtin_bit_cast(bf16x2_t, xp[8 * h + 2 * d]), p, false);
                                p = __builtin_amdgcn_fdot2_f32_bf16(__builtin_amdgcn_cvt_scalef32_pk_bf16_fp8(uw[d], 1.0f / U_SCALE, true), __builtin_bit_cast(bf16x2_t, xp[8 * h + 2 * d + 1]), p, false); } }
                        part[P8_NB * rb + r] = p; }
                    __builtin_amdgcn_sched_barrier(0);
                }
#pragma unroll
                for (int i = 0; i < 8; ++i) { const bool hi = (lane & 32) != 0; const float snd = hi ? part[i] : part[i + 8], kp = hi ? part[i + 8] : part[i]; part[i] = kp + __shfl_xor(snd, 32); }
#pragma unroll
                for (int i = 0; i < 4; ++i) { const bool hi = (lane & 16) != 0; const float snd = hi ? part[i] : part[i + 4], kp = hi ? part[i + 4] : part[i]; part[i] = kp + __shfl_xor(snd, 16); }
#pragma unroll
                for (int i = 0; i < 2; ++i) { const bool hi = (lane & 8) != 0; const float snd = hi ? part[i] : part[i + 2], kp = hi ? part[i + 2] : part[i]; part[i] = kp + __shfl_xor(snd, 8); }
                { const bool hi = (lane & 4) != 0; const float snd = hi ? part[0] : part[1], kp = hi ? part[1] : part[0]; part[0] = kp + __shfl_xor(snd, 4); }
                float av = part[0]; av += __shfl_xor(av, 1); av += __shfl_xor(av, 2);
                const float wv = gelu_exact(av * rstd2) * gateL[(tt * 8 + g) * 16 + (lane >> 2)] * (1.0f / V_SCALE);
#pragma unroll 1
                for (int rb = 0; rb < 16 / P8_NB; ++rb) {
                    v4u vb[P8_NB][2];
                    P8_LOAD8(vb, a.vt, rb);
#pragma unroll
                    for (int r = 0; r < P8_NB; ++r) { const float ws = __builtin_bit_cast(float, __builtin_amdgcn_readlane(__builtin_bit_cast(int, wv), 4 * (P8_NB * rb + r)));
#pragma unroll
                        for (int h = 0; h < 2; ++h) { const unsigned vw[4] = {vb[r][h].x, vb[r][h].y, vb[r][h].z, vb[r][h].w};
#pragma unroll
                            for (int d = 0; d < 4; ++d) { const f32x2v lo = __builtin_amdgcn_cvt_pk_f32_fp8(vw[d], false), hi2 = __builtin_amdgcn_cvt_pk_f32_fp8(vw[d], true);
                                out[16 * h + 4 * d + 0] += ws * lo.x; out[16 * h + 4 * d + 1] += ws * lo.y; out[16 * h + 4 * d + 2] += ws * hi2.x; out[16 * h + 4 * d + 3] += ws * hi2.y; } } }
                }
            }
            float ss = 0.f;
            float* orow = a.out + tok * 2048 + 16 * lane;
#pragma unroll
            for (int h = 0; h < 2; ++h)
#pragma unroll
                for (int j = 0; j < 8; ++j) { out[16 * h + 2 * j] += bflo(xp[8 * h + j]); out[16 * h + 2 * j + 1] += bfhi(xp[8 * h + j]); }
#pragma unroll
            for (int i = 0; i < 32; ++i) ss += out[i] * out[i];
            const float rs = __builtin_amdgcn_rsqf(wave_sum(ss) * (1.0f / 2048.0f) + EPS);
#pragma unroll
            for (int h = 0; h < 2; ++h)
#pragma unroll
                for (int d = 0; d < 4; ++d) { const f32x4 w0 = *(gcf4*)(a.fw + 1024 * h + 16 * lane + 4 * d);
                    st16f_wt(orow + 1024 * h + 4 * d, (f32x4){out[16 * h + 4 * d] * rs * w0[0], out[16 * h + 4 * d + 1] * rs * w0[1], out[16 * h + 4 * d + 2] * rs * w0[2], out[16 * h + 4 * d + 3] * rs * w0[3]}); }
        }
    }
#endif
    __syncthreads();
}

#ifndef P9_KS_UNROLL
#define P9_KS_UNROLL 4
#endif
#ifndef P9_SROT
#define P9_SROT 2
#endif
#ifndef P9_NBU
#define P9_NBU 16
#endif
#ifndef P9_NBV
#define P9_NBV 16
#endif
struct P9Args { const bf16 *qp, *keys, *x1b; const unsigned char *ut, *vt; const float *sumsq, *fw; float* out; int* eidxG; float* gateG; bf16* x2b; };
typedef unsigned u32x2v __attribute__((ext_vector_type(2)));
__device__ __forceinline__ float sum_rows(float x) {
    x += __builtin_bit_cast(float, __builtin_amdgcn_mov_dpp(__builtin_bit_cast(int, x), 0x128, 0xF, 0xF, true));
    const unsigned b = __builtin_bit_cast(unsigned, x); const u32x2v r = __builtin_amdgcn_permlane16_swap(b, b, false, false);
    x = __builtin_bit_cast(float, r[0]) + __builtin_bit_cast(float, r[1]);
    const unsigned c = __builtin_bit_cast(unsigned, x); const u32x2v q = __builtin_amdgcn_permlane32_swap(c, c, false, false);
    return __builtin_bit_cast(float, q[0]) + __builtin_bit_cast(float, q[1]);
}
__device__ __forceinline__ float wave_sum_l(float v, int lane) {
#pragma unroll
    for (int o = 1; o < 64; o <<= 1) v += __builtin_bit_cast(float, __builtin_amdgcn_ds_bpermute((lane ^ o) << 2, __builtin_bit_cast(int, v)));
    return v;
}
__device__ __forceinline__ float dpp_sum8(float p) {
    p += __builtin_bit_cast(float, __builtin_amdgcn_mov_dpp(__builtin_bit_cast(int, p), 0xB1, 0xF, 0xF, true));
    p += __builtin_bit_cast(float, __builtin_amdgcn_mov_dpp(__builtin_bit_cast(int, p), 0x4E, 0xF, 0xF, true));
    p += __builtin_bit_cast(float, __builtin_amdgcn_mov_dpp(__builtin_bit_cast(int, p), 0x141, 0xF, 0xF, true));
    return p;
}
__device__ __forceinline__ void p9_topk(const Frame& F, const P9Args& a, int tok0, int tl0) {
    int lane_ = F.lane; asm volatile("" : "+v"(lane_));
    const int w = F.wave, lane = lane_, fr = lane & 15, fq = lane >> 4, tid = w * 64 + lane;
    LAS unsigned char* S = F.lds;
    {
        f32x4 acc[2][8];
#pragma unroll
        for (int p = 0; p < 2; ++p)
#pragma unroll
            for (int kt = 0; kt < 8; ++kt) acc[p][kt] = (f32x4){0.f, 0.f, 0.f, 0.f};
        const bf16* qrow = a.qp + (size_t)(tok0 + 2 * w + (fr >> 3)) * 2048 + (fr & 7) * 256 + 8 * fq;
#pragma unroll
        for (int p = 0; p < 2; ++p)
#pragma unroll P9_KS_UNROLL
            for (int ks = 0; ks < 4; ++ks) {
                const bf16x8 qf = *(GAS const bf16x8*)(qrow + p * 128 + 32 * ks);
#pragma unroll
                for (int kt = 0; kt < 8; ++kt) {
                    const bf16x8 kf = *(GAS const bf16x8*)(a.keys + (size_t)(p * 128 + 16 * kt + fr) * 128 + 32 * ks + 8 * fq);
                    acc[p][kt] = __builtin_amdgcn_mfma_f32_16x16x32_bf16(kf, qf, acc[p][kt], 0, 0, 0);
                }
            }
        const int row = 16 * w + fr;
#pragma unroll
        for (int p = 0; p < 2; ++p)
#pragma unroll
            for (int kt = 0; kt < 8; ++kt)
                *(LAS f32x4*)(S + (row * 4 + p * 2 + (kt >> 2)) * P8_SEG + (16 * (kt & 3) + 4 * fq) * 4) = acc[p][kt];
    }
    __syncthreads();
    int T[16];
    {
        int L[16];
#pragma unroll
        for (int i = 0; i < 16; ++i) L[i] = (int)0x80000000;
        const int half = tid & 1;
#pragma unroll
        for (int c = 0; c < 16; ++c) {
            const f32x4 v = *(LAS const f32x4*)(S + tid * P8_SEG + c * 16);
#pragma unroll
            for (int j = 0; j < 4; ++j) { const int key = (f2key(v[j]) & ~127) | (half * 64 + 4 * c + j); TOPK_INS(L, key); }
        }
        int M[16];
#pragma unroll
        for (int i = 0; i < 16; ++i) M[i] = imax(L[i], __builtin_amdgcn_mov_dpp(L[15 - i], 0xB1, 0xF, 0xF, true));
        BITONIC16(M);
        float fa[16], fb[16];
        const bool q2 = (tid & 2) != 0;
#pragma unroll
        for (int i = 0; i < 16; ++i) { const int o = __builtin_amdgcn_mov_dpp(M[i], 0x4E, 0xF, 0xF, true); fa[i] = key2f(q2 ? o : M[i]); fb[i] = key2f(q2 ? M[i] : o); }
        if ((tid & 1) == 0) {
            LAS unsigned* kx = (LAS unsigned*)(S + P8_KX_OFF + (tid >> 2) * 32 + ((tid >> 1) & 1) * 16);
#pragma unroll
            for (int d = 0; d < 4; ++d) kx[d] = (unsigned)(M[4 * d] & 127) | ((unsigned)(M[4 * d + 1] & 127) << 8) | ((unsigned)(M[4 * d + 2] & 127) << 16) | ((unsigned)(M[4 * d + 3] & 127) << 24);
        }
#pragma unroll
        for (int i = 0; i < 16; ++i) T[i] = (int)0x80000000;
#pragma unroll
        for (int i = 0; i < 16; ++i)
#pragma unroll
            for (int j = 0; j < 16; ++j)
                if ((i + 1) * (j + 1) <= 16) { const int key = (f2key(fa[i] + fb[j]) & ~255) | (i * 16 + j); TOPK_INS(T, key); }
    }
    __syncthreads();
    {
        LAS const unsigned char* kx = (LAS const unsigned char*)(S + P8_KX_OFF + (tid >> 2) * 32);
        const float mx = key2f(T[0]);
        float ev[16], sum = 0.f;
#pragma unroll
        for (int r = 0; r < 16; ++r) { ev[r] = __builtin_amdgcn_exp2f((key2f(T[r]) - mx) * 1.4426950408889634f); sum += ev[r]; }
        const float inv = __builtin_amdgcn_rcpf(sum);
        const int q = tid & 3, row = tid >> 2;
#pragma unroll
        for (int r = 0; r < 16; ++r) if ((r >> 2) == q) {
            const int i = (T[r] >> 4) & 15, j = T[r] & 15;
            a.eidxG[(tl0 * 8 + row) * 16 + r] = (int)kx[i] * 128 + (int)kx[16 + j];
            a.gateG[(tl0 * 8 + row) * 16 + r] = ev[r] * inv;
        }
    }
    __syncthreads();
}
#define CE_DESC(M, i, j) do { const int _a = imax(M[i], M[j]), _b = imin(M[i], M[j]); M[i] = _a; M[j] = _b; } while (0)
#define SORT16_DESC(M) do { _Pragma("unroll") for (int _k = 2; _k <= 16; _k <<= 1) { _Pragma("unroll") for (int _j = _k >> 1; _j >= 1; _j >>= 1) { _Pragma("unroll") for (int _i = 0; _i < 16; ++_i) { \
        const int _l = _i ^ _j; if (_l > _i) { if ((_i & _k) == 0) CE_DESC(M, _i, _l); else CE_DESC(M, _l, _i); } } } } } while (0)
#define MERGE16(A, B) do { _Pragma("unroll") for (int _i = 0; _i < 16; ++_i) A[_i] = imax(A[_i], B[15 - _i]); BITONIC16(A); } while (0)
#define MERGE16_LANE(A, addr) do { int _p[16]; _Pragma("unroll") for (int _i = 0; _i < 16; ++_i) _p[_i] = __builtin_amdgcn_ds_bpermute(addr, A[15 - _i]); \
        _Pragma("unroll") for (int _i = 0; _i < 16; ++_i) A[_i] = imax(A[_i], _p[_i]); BITONIC16(A); } while (0)
constexpr int P9_KEYS_PITCH = 272, P9_KX_OFF2 = 256 * P9_KEYS_PITCH;
__device__ __forceinline__ void p9_load_keys(const Frame& F, const P9Args& a) {
    const int row = F.tid >> 1, half = F.tid & 1;
#pragma unroll
    for (int c = 0; c < 8; ++c) *(LAS v4u*)(F.lds + row * P9_KEYS_PITCH + half * 128 + 16 * c) = *(gcv4u*)(a.keys + (size_t)row * 128 + half * 64 + 8 * c);
    __syncthreads();
}
__device__ __forceinline__ void p9_topk2(const Frame& F, const P9Args& a, int tok0, int tl0) {
    int lane_ = F.lane; asm volatile("" : "+v"(lane_));
    const int w = F.wave, lane = lane_, fr = lane & 15, fq = lane >> 4;
    LAS unsigned char* KL = F.lds;
    const int a16 = (lane ^ 16) << 2, a32 = (lane ^ 32) << 2;
    int AB[2][16];
    const bf16* qrow = a.qp + (size_t)(tok0 + 2 * w + (fr >> 3)) * 2048 + (fr & 7) * 256 + 8 * fq;
#pragma unroll
    for (int p = 0; p < 2; ++p) {
        f32x4 acc[8];
#pragma unroll
        for (int kt = 0; kt < 8; ++kt) acc[kt] = (f32x4){0.f, 0.f, 0.f, 0.f};
        bf16x8 qf[4];
#pragma unroll
        for (int ks = 0; ks < 4; ++ks) qf[ks] = *(GAS const bf16x8*)(qrow + p * 128 + 32 * ks);
#pragma unroll
        for (int ks = 0; ks < 4; ++ks)
#pragma unroll
            for (int kt = 0; kt < 8; ++kt) {
                const bf16x8 kf = *(LAS const bf16x8*)(KL + (p * 128 + 16 * kt + fr) * P9_KEYS_PITCH + (32 * ks + 8 * fq) * 2);
                acc[kt] = __builtin_amdgcn_mfma_f32_16x16x32_bf16(kf, qf[ks], acc[kt], 0, 0, 0);
            }
        int lo[16], hi[16];
#pragma unroll
        for (int kt = 0; kt < 4; ++kt)
#pragma unroll
            for (int r = 0; r < 4; ++r) { lo[4 * kt + r] = (f2key(acc[kt][r]) & ~127) | (16 * kt + r) | (fq << 2); hi[4 * kt + r] = (f2key(acc[kt + 4][r]) & ~127) | (16 * (kt + 4) + r) | (fq << 2); }
        SORT16_DESC(lo); SORT16_DESC(hi);
        MERGE16(lo, hi);
        MERGE16_LANE(lo, a16);
        MERGE16_LANE(lo, a32);
#pragma unroll
        for (int i = 0; i < 16; ++i) AB[p][i] = lo[i];
    }
    LAS unsigned char* kxrow = F.lds + P9_KX_OFF2 + (16 * w + fr) * 32;
    if (fq < 2) {
#pragma unroll
        for (int d = 0; d < 4; ++d) { const int* L = (fq == 0) ? AB[0] : AB[1];
            ((LAS unsigned*)(kxrow + fq * 16))[d] = (unsigned)(L[4 * d] & 127) | ((unsigned)(L[4 * d + 1] & 127) << 8) | ((unsigned)(L[4 * d + 2] & 127) << 16) | ((unsigned)(L[4 * d + 3] & 127) << 24); }
    }
    float fa[16], fb[16];
#pragma unroll
    for (int i = 0; i < 16; ++i) { fa[i] = key2f(AB[0][i]); fb[i] = key2f(AB[1][i]); }
#define CAND(i, j) ((f2key(fa[i] + fb[j]) & ~255) | ((i) * 16 + (j)))
    int T[16], Y[16];
#pragma unroll
    for (int j = 0; j < 16; ++j) T[j] = CAND(0, j);
#pragma unroll
    for (int i = 8; i < 16; ++i) T[i] = imax(T[i], CAND(1, 15 - i));
    BITONIC16(T);
#pragma unroll
    for (int i = 0; i < 16; ++i) Y[i] = (int)0x80000000;
#pragma unroll
    for (int j = 0; j < 5; ++j) Y[j] = CAND(2, j);
#pragma unroll
    for (int j = 0; j < 4; ++j) Y[12 + j] = CAND(3, 3 - j);
    BITONIC16(Y); MERGE16(T, Y);
#pragma unroll
    for (int i = 0; i < 16; ++i) Y[i] = (int)0x80000000;
    Y[0] = CAND(4, 0); Y[1] = CAND(4, 1); Y[2] = CAND(4, 2); Y[3] = CAND(5, 0); Y[4] = CAND(5, 1); Y[5] = CAND(6, 0); Y[6] = CAND(6, 1); Y[7] = CAND(7, 0); Y[8] = CAND(7, 1);
    SORT16_DESC(Y); MERGE16(T, Y);
#pragma unroll
    for (int i = 0; i < 16; ++i) Y[i] = (i < 8) ? CAND(8 + i, 0) : (int)0x80000000;
    SORT16_DESC(Y); MERGE16(T, Y);
#undef CAND
    asm volatile("s_waitcnt lgkmcnt(0)" ::: "memory");
    {
        const float mx = key2f(T[0]);
        float ev[16], sum = 0.f;
#pragma unroll
        for (int r = 0; r < 16; ++r) { ev[r] = __builtin_amdgcn_exp2f((key2f(T[r]) - mx) * 1.4426950408889634f); sum += ev[r]; }
        const float inv = __builtin_amdgcn_rcpf(sum);
        const int row = 16 * w + fr;
        v4u eo = (v4u){0u, 0u, 0u, 0u}; f32x4 go = (f32x4){0.f, 0.f, 0.f, 0.f};
#pragma unroll
        for (int r = 0; r < 16; ++r) { const bool mine = (r >> 2) == fq; const int tk = mine ? T[r] : T[0];
            const int i = (tk >> 4) & 15, j = tk & 15;
            const unsigned eid = (unsigned)kxrow[i] * 128u + (unsigned)kxrow[16 + j];
            if (mine) { eo[r & 3] = eid; go[r & 3] = ev[r] * inv; } }
        st16_wt(a.eidxG + (tl0 * 8 + row) * 16 + 4 * fq, eo);
        st16f_wt(a.gateG + (tl0 * 8 + row) * 16 + 4 * fq, go);
    }
}
__device__ __forceinline__ void p9_gather(const Frame& F, const P9Args& a, int tokbase) {
    const int w = F.wave, tid = F.tid, lane = F.lane, c = lane & 7, j = lane >> 3;
    LAS float* aacc = (LAS float*)F.lds;
    LAS unsigned short* eL = (LAS unsigned short*)(F.lds + 32768);
    LAS float* ssL = (LAS float*)(F.lds + 49152);
    for (int i = tid; i < 8192; i += 512) { aacc[i] = 0.f; eL[i] = (unsigned short)a.eidxG[i]; }
    if (tid < 64) ssL[tid] = 0.f;
    __syncthreads();
    typedef float f32x2v __attribute__((ext_vector_type(2)));
    const int tl = 8 * w + j; const size_t tok = (size_t)(tokbase + tl);
    const int x4 = (lane ^ 4) << 2;
#define P9_IDX8(dst, bb) do { const v4u _t = *(LAS const v4u*)(eL + lb + 8 * (bb)); dst[0] = _t.x & 0xffffu; dst[1] = _t.x >> 16; dst[2] = _t.y & 0xffffu; dst[3] = _t.y >> 16; \
        dst[4] = _t.z & 0xffffu; dst[5] = _t.z >> 16; dst[6] = _t.w & 0xffffu; dst[7] = _t.w >> 16; } while (0)
#define P9_LD8(buf, tab, bb) do { unsigned _e[8]; P9_IDX8(_e, bb); _Pragma("unroll") for (int _i = 0; _i < 8; ++_i) buf[_i] = *(gcv4u*)((tab) + (_e[_i] * 128u + soff)); } while (0)
#define P9_UCOMP(buf, bb) do { float _p[8]; \
        _Pragma("unroll") for (int _i = 0; _i < 8; ++_i) { const unsigned _u[4] = {buf[_i].x, buf[_i].y, buf[_i].z, buf[_i].w}; float _s = 0.f; \
            _Pragma("unroll") for (int _d = 0; _d < 4; ++_d) { \
                _s = __builtin_amdgcn_fdot2_f32_bf16(__builtin_amdgcn_cvt_scalef32_pk_bf16_fp8(_u[_d], 1.0f / U_SCALE, false), __builtin_bit_cast(bf16x2_t, xq[2 * _d]), _s, false); \
                _s = __builtin_amdgcn_fdot2_f32_bf16(__builtin_amdgcn_cvt_scalef32_pk_bf16_fp8(_u[_d], 1.0f / U_SCALE, true), __builtin_bit_cast(bf16x2_t, xq[2 * _d + 1]), _s, false); } \
            _p[_i] = _s; } \
          \
        _Pragma("unroll") for (int _i = 0; _i < 4; ++_i) { const bool _h = (c & 4) != 0; const float _snd = _h ? _p[_i] : _p[_i + 4], _kp = _h ? _p[_i + 4] : _p[_i]; \
            _p[_i] = _kp + __builtin_bit_cast(float, __builtin_amdgcn_ds_bpermute(x4, __builtin_bit_cast(int, _snd))); } \
        _Pragma("unroll") for (int _i = 0; _i < 2; ++_i) { const bool _h = (c & 2) != 0; const float _snd = _h ? _p[_i] : _p[_i + 2], _kp = _h ? _p[_i + 2] : _p[_i]; \
            _p[_i] = _kp + __builtin_bit_cast(float, __builtin_amdgcn_mov_dpp(__builtin_bit_cast(int, _snd), 0x4E, 0xF, 0xF, true)); } \
        { const bool _h = (c & 1) != 0; const float _snd = _h ? _p[0] : _p[1], _kp = _h ? _p[1] : _p[0]; \
            _p[0] = _kp + __builtin_bit_cast(float, __builtin_amdgcn_mov_dpp(__builtin_bit_cast(int, _snd), 0xB1, 0xF, 0xF, true)); } \
        aacc[lb + 8 * (bb) + c] += _p[0]; } while (0)
#pragma unroll 1
    for (int s_ = 0; s_ < 16; ++s_) { const int s = (s_ + P9_SROT * (int)(blockIdx.x & 7)) & 15;
        int lb = tl * 128; asm volatile("" : "+v"(lb));
        unsigned soff = (unsigned)(s * (16384 * 128) + 16 * c); asm volatile("" : "+v"(soff));
        unsigned xq[8];
        { const v4u t0 = *(gcv4u*)(a.x1b + tok * 2048 + 128 * s + 16 * c), t1 = *(gcv4u*)(a.x1b + tok * 2048 + 128 * s + 16 * c + 8);
          xq[0] = t0.x; xq[1] = t0.y; xq[2] = t0.z; xq[3] = t0.w; xq[4] = t1.x; xq[5] = t1.y; xq[6] = t1.z; xq[7] = t1.w; }
        v4u bA[8], bB[8];
        P9_LD8(bA, a.ut, 0);
#pragma unroll 1
        for (int bb = 0; bb < 16; bb += 2) {
            P9_LD8(bB, a.ut, bb + 1);
            P9_UCOMP(bA, bb);
            if (bb + 2 < 16) P9_LD8(bA, a.ut, bb + 2);
            P9_UCOMP(bB, bb + 1);
        }
    }
#pragma unroll 1
    for (int ti = 0; ti < 8; ++ti) {
        const int tl2 = 8 * w + ti; const size_t tok2 = (size_t)(tokbase + tl2);
        const float rstd2 = __builtin_amdgcn_rsqf(wave_sum_l(lane < 32 ? a.sumsq[tok2 * 32 + lane] : 0.f, lane) * (1.0f / 2048.0f) + EPS);
#pragma unroll
        for (int hh = 0; hh < 2; ++hh) { const int k = lane + 64 * hh; aacc[tl2 * 128 + k] = gelu_exact(aacc[tl2 * 128 + k] * rstd2) * a.gateG[tl2 * 128 + k] * (1.0f / V_SCALE); }
    }
#define P9_VCOMP(buf, bb) do { const f32x4 _w0 = *(LAS const f32x4*)(aacc + lb + 8 * (bb)), _w1 = *(LAS const f32x4*)(aacc + lb + 8 * (bb) + 4); const float _wk[8] = {_w0[0], _w0[1], _w0[2], _w0[3], _w1[0], _w1[1], _w1[2], _w1[3]}; \
        _Pragma("unroll") for (int _i = 0; _i < 8; ++_i) { const unsigned _v[4] = {buf[_i].x, buf[_i].y, buf[_i].z, buf[_i].w}; \
            _Pragma("unroll") for (int _d = 0; _d < 4; ++_d) { const f32x2v _lo = __builtin_amdgcn_cvt_pk_f32_fp8(_v[_d], false), _hi = __builtin_amdgcn_cvt_pk_f32_fp8(_v[_d], true); \
                acc[4 * _d + 0] += _wk[_i] * _lo.x; acc[4 * _d + 1] += _wk[_i] * _lo.y; acc[4 * _d + 2] += _wk[_i] * _hi.x; acc[4 * _d + 3] += _wk[_i] * _hi.y; } } } while (0)
#pragma unroll 1
    for (int s_ = 0; s_ < 16; ++s_) { const int s = (s_ + P9_SROT * (int)(blockIdx.x & 7)) & 15;
        int lb = tl * 128; asm volatile("" : "+v"(lb));
        unsigned soff = (unsigned)(s * (16384 * 128) + 16 * c); asm volatile("" : "+v"(soff));
        float acc[16];
#pragma unroll
        for (int i = 0; i < 16; ++i) acc[i] = 0.f;
        v4u bA[8], bB[8];
        P9_LD8(bA, a.vt, 0);
#pragma unroll 1
        for (int bb = 0; bb < 16; bb += 2) {
            P9_LD8(bB, a.vt, bb + 1);
            P9_VCOMP(bA, bb);
            if (bb + 2 < 16) P9_LD8(bA, a.vt, bb + 2);
            P9_VCOMP(bB, bb + 1);
        }
        const v4u t0 = *(gcv4u*)(a.x1b + tok * 2048 + 128 * s + 16 * c), t1 = *(gcv4u*)(a.x1b + tok * 2048 + 128 * s + 16 * c + 8);
        const unsigned xw[8] = {t0.x, t0.y, t0.z, t0.w, t1.x, t1.y, t1.z, t1.w};
        float ss = 0.f;
#pragma unroll
        for (int i = 0; i < 8; ++i) { acc[2 * i] += bflo(xw[i]); acc[2 * i + 1] += bfhi(xw[i]); ss += acc[2 * i] * acc[2 * i] + acc[2 * i + 1] * acc[2 * i + 1]; }
        ss = dpp_sum8(ss);
        if (c == 0) ssL[tl] += ss;
        {
            bf16* o = a.x2b + tok * 2048 + 128 * s + 16 * c;
            v4u o0, o1; o0.x = pg8::cvt_pk_bf16(acc[0], acc[1]); o0.y = pg8::cvt_pk_bf16(acc[2], acc[3]); o0.z = pg8::cvt_pk_bf16(acc[4], acc[5]); o0.w = pg8::cvt_pk_bf16(acc[6], acc[7]);
            o1.x = pg8::cvt_pk_bf16(acc[8], acc[9]); o1.y = pg8::cvt_pk_bf16(acc[10], acc[11]); o1.z = pg8::cvt_pk_bf16(acc[12], acc[13]); o1.w = pg8::cvt_pk_bf16(acc[14], acc[15]);
            st16_wt(o, o0); st16_wt(o + 8, o1); }
    }
    asm volatile("s_waitcnt vmcnt(0)" ::: "memory");
#pragma unroll 1
    for (int ti = 0; ti < 8; ++ti) {
        const int tl = 8 * w + ti; const size_t tok = (size_t)(tokbase + tl);
        const float rs = __builtin_amdgcn_rsqf(ssL[tl] * (1.0f / 2048.0f) + EPS);
        float* orow = a.out + tok * 2048 + 8 * lane; const bf16* xrow = a.x2b + tok * 2048 + 8 * lane;
#pragma unroll
        for (int i = 0; i < 4; ++i) { const v4u v = *(gcv4u*)(xrow + 512 * i); const f32x4 w0 = *(gcf4*)(a.fw + 512 * i + 8 * lane), w1 = *(gcf4*)(a.fw + 512 * i + 8 * lane + 4);
            st16f_wt(orow + 512 * i, (f32x4){bflo(v.x) * rs * w0[0], bfhi(v.x) * rs * w0[1], bflo(v.y) * rs * w0[2], bfhi(v.y) * rs * w0[3]});
            st16f_wt(orow + 512 * i + 4, (f32x4){bflo(v.z) * rs * w1[0], bfhi(v.z) * rs * w1[1], bflo(v.w) * rs * w1[2], bfhi(v.w) * rs * w1[3]}); }
    }
    __syncthreads();
}

struct Args { const float* in[14]; float* out; unsigned char* ws; int ph_lo, ph_hi, dbg; };
__global__ void __launch_bounds__(NWAVES * 64, 2) hybrid_fwd(Args args) {
    extern __shared__ __attribute__((aligned(16))) unsigned char lds[];
    Frame F;
    F.lds = (LAS unsigned char*)lds;
    F.tid = threadIdx.x; F.lane = F.tid & 63; F.wave = __builtin_amdgcn_readfirstlane(F.tid >> 6);
    F.G = gridDim.x; { const int bx = blockIdx.x; F.vcu = (F.G % 8 == 0) ? (bx % 8) * (F.G / 8) + bx / 8 : bx; }
    unsigned char* ws = args.ws;
    gu32* ctl = (gu32*)(ws + WS_CTL);
    volatile LAS unsigned* MISC = (volatile LAS unsigned*)(F.lds + MISC_OFF);
    for (int u = F.tid; u < (LDS_BYTES - MISC_OFF) / 4; u += NWAVES * 64) ((LAS unsigned*)(F.lds + MISC_OFF))[u] = 0u;
    __syncthreads();
    XcdBarrier bar; bar.bar = (unsigned*)(ctl + CW_BAR); bar.x = 0; bar.st = nullptr;
    if (!MK_PER_PHASE) bar = xcd_barrier_post((unsigned*)(ctl + CW_BAR), MISC + 8);
#ifndef PHASE_REPEAT
#define PHASE_REPEAT -1
#endif
#ifndef P2_KV_REP
#define P2_KV_REP 1
#endif
#ifndef P2_POOL_REP
#define P2_POOL_REP 1
#endif
#ifndef P4_LDS
#define P4_LDS 1
#endif
#ifndef P4_REP
#define P4_REP 1
#endif
#ifndef P9_TOPK2
#define P9_TOPK2 1
#endif
#ifndef P9_TOPK_REP
#define P9_TOPK_REP 1
#endif
#ifndef TAB_STAGGER
#define TAB_STAGGER 1
#endif
#define GRID_BAR() do { if (!MK_PER_PHASE) xcd_barrier(bar); } while (0)
#if defined(DBG_TIME) || defined(DBG_T2)
    int n_stamp = 0;
#define STAMP() do { if (blockIdx.x == 0 && threadIdx.x == 0) { ((unsigned long long*)(ctl + 1100))[n_stamp] = __builtin_amdgcn_s_memrealtime(); ((unsigned long long*)(ctl + 1100))[16 + n_stamp] = __builtin_amdgcn_s_memtime(); } ++n_stamp; } while (0)
#else
#define STAMP() do {} while (0)
#endif
    const int lo = args.ph_lo, hi = args.ph_hi;
#ifdef START_ACQ
    if (threadIdx.x == 0) { __builtin_amdgcn_fence(__ATOMIC_ACQUIRE, "agent"); asm volatile("s_waitcnt vmcnt(0)" ::: "memory"); }
    __syncthreads();
#endif
#define IN(k) (((PHASE_MASK >> (k)) & 1) && lo <= (k) && (k) < hi)
#ifndef F8_ALIGN
#define F8_ALIGN true
#endif
#ifndef F8_SP2
#define F8_SP2 true
#endif
#ifdef DBG_ALLBAR
#define BOTH(k) IN(k)
#else
#define BOTH(k) (IN(k) && IN((k) + 1))
#endif
    const float* x = args.in[0]; const float* norm1_w = args.in[1]; const float* w_in = args.in[2]; const float* w_ret_o = args.in[3];
    const float* w_pool_lin = args.in[4]; const float* pool_scale = args.in[5]; const float* w_pool_o = args.in[6]; const float* w_out = args.in[7];
    const float* norm2_w = args.in[8]; const float* peer_w_q = args.in[9]; const float* sub_keys = args.in[10]; const float* peer_u = args.in[11];
    const float* peer_v = args.in[12]; const float* final_w = args.in[13];
    bf16* Wmain = (bf16*)(ws + WS_WMAIN); bf16* Wkv = (bf16*)(ws + WS_WKV); bf16* Wro = (bf16*)(ws + WS_WRO); bf16* Wpo = (bf16*)(ws + WS_WPO);
    bf16* Wout = (bf16*)(ws + WS_WOUT); bf16* Wq = (bf16*)(ws + WS_WQ); bf16* linT = (bf16*)(ws + WS_LINT); bf16* keysb = (bf16*)(ws + WS_KEYS);
    bf16* hb = (bf16*)(ws + WS_H); bf16* qb = (bf16*)(ws + WS_Q); bf16* kb = (bf16*)(ws + WS_K); bf16* vT = (bf16*)(ws + WS_VT);
    unsigned char* ut = ws + WS_UT; unsigned char* vtab = ws + WS_VTAB; bf16* grb = (bf16*)(ws + WS_GR); bf16* pinb = (bf16*)(ws + WS_PIN);
    bf16* stb = (bf16*)(ws + WS_ST); bf16* pooled = (bf16*)(ws + WS_POOLED);
    float* sumsq = (float*)(ws + WS_PIN);
    bf16* gretb = (bf16*)(ws + WS_GRET); bf16* gpoolb = (bf16*)(ws + WS_GPOOL); bf16* retn = (bf16*)(ws + WS_RETN);

#ifdef DBG_T2
    if (blockIdx.x == 0 && threadIdx.x == 0) ((unsigned long long*)(ctl + 1100))[15] = __builtin_amdgcn_s_memrealtime();
#endif
    if (lo == 0) GRID_BAR();
    STAMP();
    if (IN(0)) for (int rep_ = 0; rep_ < ((PHASE_REPEAT == 0) ? 2 : 1); ++rep_) {
        P0Args a{x, norm1_w, w_in, w_ret_o, w_pool_lin, w_pool_o, w_out, norm2_w, peer_w_q, sub_keys, Wmain, Wkv, Wro, Wpo, Wout, Wq, linT, keysb, hb, ws + WS_H8};
        p0_prologue(F, a);
        if (BOTH(0)) GRID_BAR();
        STAMP();
    }
    if (IN(1)) for (int rep_ = 0; rep_ < ((PHASE_REPEAT == 1) ? 2 : 1); ++rep_) {
#define P1_PART(bit, row0_, ncols_, pn0_) { constexpr bool f8 = (MAIN_FP8 & (bit)) != 0; \
          pg8::Gemm g{f8 ? (const pg8::bf16_t*)(ws + WS_H8) : hb, Wmain + (size_t)(row0_) * DM, TOK, (ncols_), f8 ? DM / 2 : DM}; pg8::StaticOrder S; S.init(TOK, (ncols_), F.G, (int)blockIdx.x); \
          pg8::EpiMain E{qb, kb, grb, pinb, f8 ? 1.0f / (H8_SCALE * WG8_SCALE) : 1.0f, (pn0_)}; \
          pg8::gemm_phase<pg8::EpiMain, pg8::StaticOrder, f8 ? F8_ALIGN : true, f8 ? F8_SP2 : true, f8>(F.lds, g, S, E); }
#if MAIN_FP8 == 0 || MAIN_FP8 == 7
        P1_PART(1, 0, 5120, 0)
#elif MAIN_FP8 == 4
        P1_PART(1, 0, 4096, 0) P1_PART(4, 4096, 1024, 16)
#elif MAIN_FP8 == 6
        P1_PART(1, 0, 2048, 0) P1_PART(2, 2048, 3072, 8)
#else
        P1_PART(1, 0, 2048, 0) P1_PART(2, 2048, 2048, 8) P1_PART(4, 4096, 1024, 16)
#endif
#undef P1_PART
        { pg8::Gemm g{Wkv, KV_FP8 ? (const pg8::bf16_t*)(ws + WS_H8) : hb, 2048, TOK, KV_FP8 ? DM / 2 : DM}; pg8::StaticOrder S; S.init(2048, TOK, F.G, (int)blockIdx.x);
          pg8::EpiKV E{vT, KV_FP8 ? 1.0f / (H8_SCALE * WG8_SCALE) : 1.0f};
          pg8::gemm_phase<pg8::EpiKV, pg8::StaticOrder, KV_FP8 ? F8_ALIGN : true, KV_FP8 ? F8_SP2 : true, KV_FP8 != 0>(F.lds, g, S, E); }
        if (BOTH(1)) GRID_BAR();
        STAMP();
    }
    if (IN(2)) for (int rep_ = 0; rep_ < ((PHASE_REPEAT == 2) ? 2 : 1); ++rep_) {
        for (int r2_ = 0; r2_ < P2_KV_REP; ++r2_) p2_kv_phase(F, kb, vT, stb);
        for (int r2_ = 0; r2_ < P2_POOL_REP; ++r2_) p2_pool(F, pinb, pooled);
        if (BOTH(2)) GRID_BAR();
        STAMP();
    }
    if (IN(3)) for (int rep_ = 0; rep_ < ((PHASE_REPEAT == 3) ? 2 : 1); ++rep_) {
        p3_scan(F, stb);
        { pg8::Gemm g{pooled, linT, 4 * TOK, 1024, 256}; pg8::DiagOrder S; S.init(F.G, (int)blockIdx.x);
          pg8::EpiPool E{pinb, pool_scale};
          pg8::gemm_phase<pg8::EpiPool, pg8::DiagOrder, true, true>(F.lds, g, S, E); }
        if (BOTH(3)) GRID_BAR();
        STAMP();
    }
    if (IN(4)) for (int rep_ = 0; rep_ < ((PHASE_REPEAT == 4) ? 2 : 1); ++rep_) {
        for (int r4_ = 0; r4_ < P4_REP; ++r4_) { if (P4_LDS) p4_phase2(F, qb, kb, vT, stb, grb, retn); else for (int uu = F.vcu; uu < 1024; uu += F.G) p4_unit(F, uu, qb, kb, vT, stb, grb, retn); }
        if (BOTH(4) && !P5_EARLY) GRID_BAR();
        STAMP();
    }
    if (IN(5)) for (int rep_ = 0; rep_ < ((PHASE_REPEAT == 5) ? 2 : 1); ++rep_) {
#ifdef L2_SWEEP
        {
            const gcv4u* src = (const gcv4u*)(ws + 2 * MiB + (size_t)blockIdx.x * (L2_SWEEP * 1024)) + threadIdx.x; v4u accv = (v4u){0u, 0u, 0u, 0u};
            for (int i = 0; i < L2_SWEEP * 1024 / (512 * 16); ++i) { const v4u t = src[(size_t)i * 512]; accv.x ^= t.x; accv.y ^= t.y; accv.z ^= t.z; accv.w ^= t.w; }
            if ((accv.x ^ accv.y ^ accv.z ^ accv.w) == 0x12345678u) ((unsigned*)ctl)[1000] = 1u;
            __syncthreads();
        }
#endif
#if GATES_FP8
        { pg8::Gemm g{(const pg8::bf16_t*)(ws + WS_H8), Wmain + (size_t)5120 * DM, TOK, 4096, DM / 2}; pg8::StaticOrder S; S.init(TOK, 4096, F.G, (int)blockIdx.x);
          pg8::EpiGates E{gretb, gpoolb, 1.0f / (H8_SCALE * WG8_SCALE), args.dbg};
          pg8::gemm_phase<pg8::EpiGates, pg8::StaticOrder, F8_ALIGN, F8_SP2, true>(F.lds, g, S, E); }
#else
        { pg8::Gemm g{hb, Wmain + (size_t)5120 * DM, TOK, 4096, DM}; pg8::StaticOrder S; S.init(TOK, 4096, F.G, (int)blockIdx.x);
          pg8::EpiGates E{gretb, gpoolb, 1.0f, args.dbg};
          pg8::gemm_phase<pg8::EpiGates, pg8::StaticOrder, true, true>(F.lds, g, S, E); }
#endif
        if (BOTH(5)) GRID_BAR();
        STAMP();
    }
    if (IN(6)) for (int rep_ = 0; rep_ < ((PHASE_REPEAT == 6) ? 2 : 1); ++rep_) {
#if TAB_STAGGER
        if (F.vcu & 1) p6_tables(F, peer_u, peer_v, norm2_w, ut, vtab, 0, 16384);
#endif
#if MIX_FP8 && P6_CHAIN
        { pg8::Gemm g{retn, Wro, TOK, DM, DM / 2, pinb, Wpo, 1024 / 2}; pg8::ChainOrder S; S.init(TOK, DM, F.G, (int)blockIdx.x);
          pg8::EpiChain E{(const unsigned char*)gretb, (const unsigned char*)gpoolb, ws + WS_H8, 1.0f / (pg8::R8_SCALE * pg8::WB8_SCALE)};
          pg8::gemm_phase<pg8::EpiChain, pg8::ChainOrder, F8_ALIGN, F8_SP2, true, true>(F.lds, g, S, E); }
#elif MIX_FP8
        { pg8::Gemm g{retn, Wro, TOK, DM, DM / 2}; pg8::StaticOrder S; S.init(TOK, DM, F.G, (int)blockIdx.x);
          pg8::EpiMix<0> E{grb, gretb, ws + WS_H8, 1.0f / (pg8::R8_SCALE * pg8::WB8_SCALE)};
          pg8::gemm_phase<pg8::EpiMix<0>, pg8::StaticOrder, F8_ALIGN, F8_SP2, true>(F.lds, g, S, E); }
        { pg8::Gemm g{pinb, Wpo, TOK, DM, 1024 / 2}; pg8::StaticOrder S; S.init(TOK, DM, F.G, (int)blockIdx.x);
          pg8::EpiMix<1> E{grb, gpoolb, ws + WS_H8, 1.0f / (pg8::R8_SCALE * pg8::WB8_SCALE)};
          pg8::gemm_phase<pg8::EpiMix<1>, pg8::StaticOrder, F8_ALIGN, F8_SP2, true>(F.lds, g, S, E); }
#else
        { pg8::Gemm g{retn, Wro, TOK, DM, DM}; pg8::StaticOrder S; S.init(TOK, DM, F.G, (int)blockIdx.x);
          pg8::EpiMix<0> E{grb, gretb, ws + WS_H8, 1.0f};
          pg8::gemm_phase<pg8::EpiMix<0>, pg8::StaticOrder, true, true>(F.lds, g, S, E); }
        { pg8::Gemm g{pinb, Wpo, TOK, DM, 1024}; pg8::StaticOrder S; S.init(TOK, DM, F.G, (int)blockIdx.x);
          pg8::EpiMix<1> E{grb, gpoolb, ws + WS_H8, 1.0f};
          pg8::gemm_phase<pg8::EpiMix<1>, pg8::StaticOrder, true, true>(F.lds, g, S, E); }
#endif
#if TAB_STAGGER
        if (!(F.vcu & 1)) p6_tables(F, peer_u, peer_v, norm2_w, ut, vtab, 0, 16384);
#endif
        if (BOTH(6)) GRID_BAR();
        STAMP();
    }
    if (IN(7)) for (int rep_ = 0; rep_ < ((PHASE_REPEAT == 7) ? 2 : 1); ++rep_) {
#if TAB_STAGGER
        if (F.vcu & 1) p6_tables(F, peer_u, peer_v, norm2_w, ut, vtab, 16384, 32768);
#endif
#if OUT_FP8
        { pg8::Gemm g{(const pg8::bf16_t*)(ws + WS_H8), Wout, TOK, DM, DM / 2}; pg8::StaticOrder S; S.init(TOK, DM, F.G, (int)blockIdx.x);
          pg8::EpiOut E{x, hb, sumsq, 1.0f / (pg8::M8_SCALE * pg8::WO8_SCALE)};
          pg8::gemm_phase<pg8::EpiOut, pg8::StaticOrder, F8_ALIGN, F8_SP2, true>(F.lds, g, S, E); }
#else
        { pg8::Gemm g{grb, Wout, TOK, DM, DM}; pg8::StaticOrder S; S.init(TOK, DM, F.G, (int)blockIdx.x);
          pg8::EpiOut E{x, hb, sumsq, 1.0f};
          pg8::gemm_phase<pg8::EpiOut, pg8::StaticOrder, true, true>(F.lds, g, S, E); }
#endif
#if TAB_STAGGER
        if (!(F.vcu & 1)) p6_tables(F, peer_u, peer_v, norm2_w, ut, vtab, 16384, 32768);
#endif
        if (BOTH(7)) GRID_BAR();
        STAMP();
    }
    if (IN(8)) for (int rep_ = 0; rep_ < ((PHASE_REPEAT == 8) ? 2 : 1); ++rep_) {
        { pg8::Gemm g{hb, Wq, TOK, DM, DM}; pg8::StaticOrder S; S.init(TOK, DM, F.G, (int)blockIdx.x);
          pg8::EpiQ E{grb, sumsq};
          pg8::gemm_phase<pg8::EpiQ, pg8::StaticOrder, true, true>(F.lds, g, S, E); }
#if !TAB_STAGGER
        p6_tables(F, peer_u, peer_v, norm2_w, ut, vtab, 0, 32768);
#endif
        if (BOTH(8)) GRID_BAR();
        STAMP();
    }
    if (IN(9)) for (int rep_ = 0; rep_ < ((PHASE_REPEAT == 9) ? 2 : 1); ++rep_) {
#if P9_SLICED
        Frame F9 = F; { F9.lane = (int)__builtin_amdgcn_mbcnt_hi(~0u, __builtin_amdgcn_mbcnt_lo(~0u, 0u)); F9.tid = F.wave * 64 + F9.lane; }
        P9Args a{grb, keysb, hb, ut, vtab, sumsq, final_w, args.out, (int*)(ws + WS_SCR) + (size_t)F.vcu * 8192, (float*)(ws + WS_SCR + 8 * MiB) + (size_t)F.vcu * 8192, grb};
        _Pragma("unroll 1") for (int grp = F.vcu; grp < TOK / 64; grp += F.G) {
#ifndef P9_NO_T
#if P9_TOPK2
            p9_load_keys(F9, a);
            for (int rt_ = 0; rt_ < P9_TOPK_REP; ++rt_)
            _Pragma("unroll 1") for (int sub = 0; sub < 4; ++sub) p9_topk2(F9, a, 64 * grp + 16 * sub, 16 * sub);
            __syncthreads();
#else
            for (int rt_ = 0; rt_ < P9_TOPK_REP; ++rt_)
            _Pragma("unroll 1") for (int sub = 0; sub < 4; ++sub) p9_topk(F9, a, 64 * grp + 16 * sub, 16 * sub);
#endif
#endif
#ifndef P9_NO_G
            p9_gather(F9, a, 64 * grp);
#endif
        }
#else
        P8Args a{grb, keysb, hb, ut, vtab, sumsq, final_w, args.out};
        for (int sub = F.vcu; sub < TOK / 16; sub += F.G) p8_subtile(F, sub, a);
#endif
    }
#ifdef DBG_T2
#ifndef DBG_T2_DIV
#define DBG_T2_DIV 1
#endif
    STAMP();
    {
        GRID_BAR();
        STAMP();
        if (blockIdx.x == 0 && threadIdx.x == 0) {
            asm volatile("s_waitcnt vmcnt(0)" ::: "memory");
            const unsigned long long* T = (const unsigned long long*)(ctl + 1100);
#ifdef DBG_CLK
            const float us = 1000.0f * (float)(T[16 + DBG_T2 + 1] - T[16 + DBG_T2]) / (float)(T[DBG_T2 + 1] - T[DBG_T2]);
#else
            const float us = (DBG_T2 == 21) ? (float)(T[11] - T[15]) * 0.01f : (DBG_T2 == 20) ? (float)(T[0] - T[15]) * 0.01f : (float)(T[DBG_T2 + 1] - T[DBG_T2]) * 0.01f;
#endif
            st4f_wt(args.out, floorf((us - (float)(DBG_T2_OFF)) * (1.0f / (float)(DBG_T2_DIV))));
        }
    }
#endif
#ifdef DBG_TIME
    STAMP();
    {
        GRID_BAR();
        for (size_t i = ((size_t)blockIdx.x * 512 + threadIdx.x) * 4; i < (size_t)TOK * DM; i += (size_t)gridDim.x * 512 * 4) *(gf4*)(args.out + i) = (f32x4){0.f, 0.f, 0.f, 0.f};
        GRID_BAR();
        if (blockIdx.x == 0 && threadIdx.x == 0) {
            const unsigned long long* T = (const unsigned long long*)(ctl + 1100);
            const float total = (float)(T[10] - T[0]);
            const float dt = (DBG_TIME == 10) ? (float)(T[10] - T[0]) * 0.00025f   : 100.0f * (float)(T[DBG_TIME + 1] - T[DBG_TIME]) / total;
            const float code = dt > 97.f ? 97.f : floorf(dt + 0.5f);
            args.out[0] = sqrtf((float)TOK * (float)DM * code);
        }
    }
#endif

#if defined(DUMP_OFF_MIB)
    if (hi == N_PHASES) {
        const bf16* src = (const bf16*)(ws + (size_t)DUMP_OFF_MIB * MiB);
        for (size_t i = ((size_t)blockIdx.x * 512 + threadIdx.x) * 8; i < (size_t)TOK * DM; i += (size_t)gridDim.x * 512 * 8) {
            const v4u t = *(gcv4u*)(src + i);
            *(gf4*)(args.out + i) = (f32x4){bflo(t.x), bfhi(t.x), bflo(t.y), bfhi(t.y)};
            *(gf4*)(args.out + i + 4) = (f32x4){bflo(t.z), bfhi(t.z), bflo(t.w), bfhi(t.w)};
        }
    }
#endif
#ifdef END_REL
    asm volatile("s_waitcnt vmcnt(0)" ::: "memory"); __syncthreads();
    if (threadIdx.x == 0) { __builtin_amdgcn_fence(__ATOMIC_RELEASE, "agent"); asm volatile("s_waitcnt vmcnt(0)" ::: "memory"); }
    __syncthreads();
#endif

#if defined(DBG_CHECK)
    if (lo == 20) {
        const int gw = F.vcu * NWAVES + F.wave, NGW = F.G * NWAVES;
        for (int row = gw; row < TOK; row += NGW) {
            for (int ct = 0; ct < 16; ++ct) {
                const int col = 256 * ct + ((row * 7 + ct * 13) & 255);
                const bf16* hr = hb + (size_t)row * DM + 8 * F.lane; const bf16* wr_ = Wmain + (size_t)(5120 + col) * DM + 8 * F.lane;
                float s = 0.f;
                for (int j = 0; j < 4; ++j) { const v4u a = *(gcv4u*)(hr + 512 * j), b = *(gcv4u*)(wr_ + 512 * j);
                    s += bflo(a.x) * bflo(b.x) + bfhi(a.x) * bfhi(b.x) + bflo(a.y) * bflo(b.y) + bfhi(a.y) * bfhi(b.y) + bflo(a.z) * bflo(b.z) + bfhi(a.z) * bfhi(b.z) + bflo(a.w) * bflo(b.w) + bfhi(a.w) * bfhi(b.w); }
                s = wave_sum(s);
                const float g = 1.0f / (1.0f + __expf(-s));
                const unsigned short gs = (col < 2048 ? gretb : gpoolb)[(size_t)row * 2048 + (col & 2047)];
                const float gv = bflo((unsigned)gs);
                if (F.lane == 0 && !(fabsf(g - gv) < 0.02f)) { atomicMin((unsigned*)ctl + 512, (unsigned)(row >> 8)); atomicAdd((unsigned*)ctl + 513, 1u); atomicAdd((unsigned*)ctl + 600 + (row >> 8), 1u); atomicAdd((unsigned*)ctl + 700 + ct, 1u); atomicAdd((unsigned*)ctl + 800 + ((row >> 4) & 15), 1u); if (!(fabsf(g - gv) < 0.2f)) { atomicAdd((unsigned*)ctl + 514, 1u); if (!(gv >= 0.f && gv <= 1.0f)) atomicAdd((unsigned*)ctl + 515, 1u); if (gv == 0.5f) atomicAdd((unsigned*)ctl + 516, 1u); } atomicAdd((unsigned*)ctl + 900 + (col & 255) / 8, 1u); }
            }
        }
    }
    if (lo == 21) {
        for (size_t i = ((size_t)blockIdx.x * 512 + threadIdx.x) * 4; i < (size_t)TOK * DM; i += (size_t)gridDim.x * 512 * 4) *(gf4*)(args.out + i) = (f32x4){0.f, 0.f, 0.f, 0.f};
        __syncthreads();
        if (blockIdx.x == 0 && threadIdx.x == 0) {
            const unsigned first = ((unsigned*)ctl)[512], cnt = ((unsigned*)ctl)[513];
            const unsigned* C = (const unsigned*)ctl;
            unsigned nrt = 0, nct = 0, maxct = 0, maxcti = 0, n16 = 0, mx16 = 0, mx16i = 0;
            for (int i = 0; i < 64; ++i) nrt += C[600 + i] ? 1u : 0u;
            for (int i = 0; i < 16; ++i) { nct += C[700 + i] ? 1u : 0u; if (C[700 + i] > maxct) { maxct = C[700 + i]; maxcti = i; } n16 += C[800 + i] ? 1u : 0u; if (C[800 + i] > mx16) { mx16 = C[800 + i]; mx16i = i; } }
            unsigned cv = 0;
            if (DBG_CHECK == 1) cv = cnt == 0 ? 0 : first + 1;
            if (DBG_CHECK == 2) cv = cnt >> DBG_SHIFT;
            if (DBG_CHECK == 3) cv = nrt;
            if (DBG_CHECK == 4) cv = nct;
            if (DBG_CHECK == 5) cv = maxcti + 1;
            if (DBG_CHECK == 6) cv = n16;
            if (DBG_CHECK == 7) cv = mx16i + 1;
            if (DBG_CHECK == 8) cv = (C[600 + DBG_ARG]) >> DBG_SHIFT;
            if (DBG_CHECK == 9) cv = (C[700 + DBG_ARG]) >> DBG_SHIFT;
            if (DBG_CHECK == 10) cv = C[514] >> DBG_SHIFT;
            if (DBG_CHECK == 11) { unsigned n = 0; for (int i = 0; i < 32; ++i) n += C[900 + i] ? 1u : 0u; cv = n; }
            if (DBG_CHECK == 12) cv = (C[800 + DBG_ARG]) >> DBG_SHIFT;
            if (DBG_CHECK == 13) cv = (C[900 + DBG_ARG]) >> DBG_SHIFT;
            if (DBG_CHECK == 14) { int second = -1; for (int i = 0; i < 16; ++i) if (C[800 + i] && (unsigned)i != mx16i) second = i; cv = (unsigned)(second + 1); }
            if (DBG_CHECK == 15) { unsigned m = 0; for (int i = 0; i < 16; ++i) if (C[700 + i]) m |= 1u << i; cv = (DBG_ARG == 0) ? (m & 63u) : (DBG_ARG == 1 ? ((m >> 6) & 63u) : (m >> 12)); }
            if (DBG_CHECK == 16) { unsigned m = 0; for (int i = 0; i < 32; ++i) if (C[900 + i]) m |= 1u << i; cv = (m >> (6 * DBG_ARG)) & 63u; }
            if (DBG_CHECK == 17) cv = C[515] >> DBG_SHIFT;
            if (DBG_CHECK == 18) cv = C[516] >> DBG_SHIFT;
            if (DBG_CHECK == 19) cv = C[514] >> DBG_SHIFT;
            float code = (float)(cv > 97 ? 97 : cv);
            args.out[0] = sqrtf((float)TOK * (float)DM * code);
        }
    }
#endif
#undef IN
#undef BOTH
#undef GRID_BAR
}

extern "C" void kernel_launch(void* const* d_in, const int* in_sizes, int n_in, void* d_out, int out_size, void* d_ws, size_t ws_size, hipStream_t stream) {
    static int grid = 0;
    if (grid == 0) {
        if (n_in != 14 || out_size != TOK * DM || ws_size < WS_END) { fprintf(stderr, "kernel_launch: unexpected shapes (n_in %d, out %d, ws %zu); nothing launched\n", n_in, out_size, ws_size); grid = -1; return; }
        int dev = 0, cus = 0, per_cu = 0;
        if (hipGetDevice(&dev) != hipSuccess || hipDeviceGetAttribute(&cus, hipDeviceAttributeMultiprocessorCount, dev) != hipSuccess) { grid = -1; return; }
        if (hipFuncSetAttribute((const void*)hybrid_fwd, hipFuncAttributeMaxDynamicSharedMemorySize, LDS_BYTES) != hipSuccess) { fprintf(stderr, "kernel_launch: hipFuncSetAttribute failed\n"); grid = -1; return; }
        if (hipOccupancyMaxActiveBlocksPerMultiprocessor(&per_cu, (const void*)hybrid_fwd, NWAVES * 64, LDS_BYTES) != hipSuccess || per_cu < 1)
            fprintf(stderr, "kernel_launch: note: occupancy query reports %d workgroups per CU\n", per_cu);
        (void)hipGetLastError();
        grid = cus;
    }
    if (grid < 0) return;
    if (hipMemsetAsync((char*)d_ws + WS_CTL, 0, CTL_ZERO_BYTES, stream) != hipSuccess) { fprintf(stderr, "kernel_launch: hipMemsetAsync failed\n"); return; }
    Args a{};
    for (int i = 0; i < 14; ++i) a.in[i] = (const float*)d_in[i];
    a.out = (float*)d_out; a.ws = (unsigned char*)d_ws;
#if MK_PER_PHASE
#if defined(DBG_CHECK)
    { const int order[] = {0, 1, 2, 3, 4, 5, 20, 6, 7, 8, 9, 21};
      hipMemsetAsync((char*)d_ws + 2048, 0xFF, 4, stream);
      for (int p : order) { a.ph_lo = p; a.ph_hi = p + 1; hipLaunchKernelGGL(hybrid_fwd, dim3(grid), dim3(NWAVES * 64), LDS_BYTES, stream, a); } }
#else
#ifndef HOST_REPEAT
#define HOST_REPEAT -1
#define HOST_REPS 1
#endif
#ifndef HOST_DBG
#define HOST_DBG 0
#endif
    for (int p = 0; p < N_PHASES; ++p) for (int r = 0; r < (p == HOST_REPEAT ? HOST_REPS : 1); ++r) { a.ph_lo = p; a.ph_hi = p + 1; a.dbg = (r > 0) ? HOST_DBG : 0; hipLaunchKernelGGL(hybrid_fwd, dim3(grid), dim3(NWAVES * 64), LDS_BYTES, stream, a); }
#endif
#else
    a.ph_lo = 0; a.ph_hi = N_PHASES;
    hipLaunchKernelGGL(hybrid_fwd, dim3(grid), dim3(NWAVES * 64), LDS_BYTES, stream, a);
#endif
    const hipError_t le = hipPeekAtLastError();
    if (le != hipSuccess) fprintf(stderr, "kernel_launch: launch failed: %s\n", hipGetErrorName(le));
}
```
